# Optimizing an MI355X kernel written in HIP

```python
import jax, jax.numpy as jnp
from jax import lax
import numpy as np

D_MODEL = 1024
BATCH = 2
SEQ = 8192
DEPTH = 4
DEC_BATCH = 32
DEC_SEQ = 1
PAST_LEN = 8192
PAGE_SIZE = 128

N_MIXERS = 3
EXPAND = 2
E_WIDTH = EXPAND * D_MODEL
CHUNK = 128
A_GROUPS = 8
CONV_W = 3
C_HEAD_DIM = 128
C_HEADS = E_WIDTH // C_HEAD_DIM
DIL_GROUPS = ((128, 1), (512, 4), (2048, 16))
N_DIL = len(DIL_GROUPS)
ROT_DIM = C_HEAD_DIM // 4
ROPE_THETA = 500000.0
EPS = 1e-6
N_A = (DEPTH + 2) // 3
N_B = (DEPTH + 1) // 3
N_C = DEPTH // 3

kernel_name = 'hybrid_chunkmlp_shortconv_dilatedswa_step'


def _rmsnorm(x, w):
    xf = x.astype(jnp.float32)
    y = xf * lax.rsqrt(jnp.mean(xf * xf, axis=-1, keepdims=True) + EPS)
    return (y * w.astype(jnp.float32)).astype(x.dtype)


def _layernorm(x, g, b):
    xf = x.astype(jnp.float32)
    xc = xf - jnp.mean(xf, axis=-1, keepdims=True)
    y = xc * lax.rsqrt(jnp.mean(xc * xc, axis=-1, keepdims=True) + EPS)
    return (y * g.astype(jnp.float32) + b.astype(jnp.float32)).astype(x.dtype)


def _chunk_mix(v, w_s, b_s):
    bsz, L, E = v.shape
    c = min(L, CHUNK)
    vc = v.reshape(bsz, L // c, c, A_GROUPS, E // A_GROUPS)
    w = jnp.tril(w_s[:, :c, :c])
    out = jnp.einsum('gij,bnjge->bnige', w, vc) + b_s[:, :c].T[None, None, :, :, None]
    return out.reshape(bsz, L, E)


def _mixer_a(h, w_in, ln_g, ln_b, w_s, b_s, w_out):
    z = h @ w_in
    u, v, g = jnp.split(z, 3, axis=-1)
    v = _layernorm(v, ln_g, ln_b)
    y = (u * _chunk_mix(v, w_s, b_s) * jax.nn.silu(g)) @ w_out
    return y, v


def _mixer_b(h, prev, w_in, conv_w, w_out):
    L = h.shape[1]
    z = h @ w_in
    bg, cg, xv, g = jnp.split(z, 4, axis=-1)
    uc = jnp.concatenate([prev, cg * xv], axis=1)
    conv = sum(conv_w[k] * uc[:, k:k + L] for k in range(CONV_W))
    y = (bg * conv * jax.nn.silu(g)) @ w_out
    return y, uc[:, -(CONV_W - 1):]


def _rope_partial(x, pos):
    half = ROT_DIM // 2
    inv = ROPE_THETA ** (-jnp.arange(half, dtype=jnp.float32) * (2.0 / ROT_DIM))
    ang = pos.astype(jnp.float32)[:, None] * inv[None, :]
    shp = (1, pos.shape[0]) + (1,) * (x.ndim - 3) + (half,)
    cos, sin = jnp.cos(ang).reshape(shp), jnp.sin(ang).reshape(shp)
    x1 = x[..., :half].astype(jnp.float32)
    x2 = x[..., half:ROT_DIM].astype(jnp.float32)
    rot = jnp.concatenate([x1 * cos - x2 * sin, x2 * cos + x1 * sin], axis=-1).astype(x.dtype)
    return jnp.concatenate([rot, x[..., ROT_DIM:]], axis=-1)


def _softmax_lse(s):
    m = jnp.max(s, axis=-1, keepdims=True)
    p = jnp.exp(s - m)
    den = jnp.sum(p, axis=-1, keepdims=True)
    return p / den, (m + jnp.log(den))[..., 0]


def _dilated_prompt(q, k, v, dil, win):
    B, S, H, hd = q.shape
    blk = win // dil
    span = dil * blk
    sp = -(-S // span) * span
    nb = sp // span

    def split(t):
        t = jnp.pad(t, ((0, 0), (0, sp - S), (0, 0), (0, 0))).reshape(B, sp // dil, dil, H, hd)
        return jnp.moveaxis(t, 2, 1).reshape(B, dil, nb, blk, H, hd)

    def with_prev(t):
        prev = jnp.pad(t[:, :, :-1], ((0, 0), (0, 0), (1, 0), (0, 0), (0, 0), (0, 0)))
        return jnp.concatenate([prev, t], axis=3)

    qb = split(q)
    kk, vv = with_prev(split(k)), with_prev(split(v))
    s = jnp.einsum('brnqhe,brnkhe->brnhqk', qb, kk).astype(jnp.float32) * (hd ** -0.5)
    ki = jnp.arange(2 * blk)[None, :]
    rel = (jnp.arange(blk)[:, None] + blk) - ki
    band = (rel >= 0) & (rel <= blk)
    first = (jnp.arange(nb)[:, None, None] > 0) | (ki >= blk)[None]
    mask = band[None] & first
    s = jnp.where(mask[:, None], s, -jnp.inf)
    p, lse = _softmax_lse(s)
    o = jnp.einsum('brnhqk,brnkhe->brnqhe', p.astype(vv.dtype), vv).astype(jnp.float32)

    def merge(t):
        t = t.reshape((B, dil, sp // dil) + t.shape[4:])
        return jnp.moveaxis(t, 1, 2).reshape((B, sp) + t.shape[3:])[:, :S]

    return merge(o), merge(jnp.moveaxis(lse, 3, 4))


def _dilated_sample(q, k_new, v_new, kv_buf, dil, win):
    Lb, T, hd = kv_buf.shape[1], q.shape[1], q.shape[-1]
    kc = jnp.concatenate([kv_buf[:, :, 0], k_new], axis=1)
    vc = jnp.concatenate([kv_buf[:, :, 1], v_new], axis=1)
    idx = Lb + jnp.arange(T)[:, None] - dil * jnp.arange(win // dil + 1)[None, :]
    valid = idx >= 0
    idx = jnp.maximum(idx, 0)
    kg, vg = kc[:, idx], vc[:, idx]
    s = jnp.einsum('bthe,btjhe->bthj', q, kg).astype(jnp.float32) * (hd ** -0.5)
    s = jnp.where(valid[None, :, None, :], s, -jnp.inf)
    p, lse = _softmax_lse(s)
    o = jnp.einsum('bthj,btjhe->bthe', p.astype(vg.dtype), vg).astype(jnp.float32)
    return o, lse


def _c_project(h, w_in, pos):
    bsz, L, _ = h.shape
    z = h @ w_in
    qkv = z[..., :3 * N_DIL * E_WIDTH].reshape(bsz, L, 3, N_DIL, C_HEADS, C_HEAD_DIM)
    q = _rope_partial(qkv[:, :, 0], pos)
    k = _rope_partial(qkv[:, :, 1], pos)
    return q, k, qkv[:, :, 2], z[..., 3 * N_DIL * E_WIDTH:]


def _c_finish(outs, lses, gate, w_out):
    wts = jax.nn.softmax(jnp.stack(lses, 0), axis=0)
    o = jnp.einsum('gblh,gblhe->blhe', wts, jnp.stack(outs, 0))
    bsz, L = gate.shape[:2]
    return (o.reshape(bsz, L, E_WIDTH).astype(gate.dtype) * jax.nn.silu(gate)) @ w_out


def setup_inputs(seed: int = 0) -> dict:
    key = jax.random.key(seed)
    ks = jax.random.split(key, 24)

    def nrm(k, shape, scale):
        return jax.random.normal(k, shape, jnp.float32) * scale

    E = E_WIDTH
    inp = {}
    inp['x_prompt'] = nrm(ks[0], (BATCH, SEQ, D_MODEL), 1.0)
    inp['x_sample'] = nrm(ks[1], (DEC_BATCH, DEC_SEQ, D_MODEL), 1.0)
    inp['state_conv'] = nrm(ks[2], (N_B, DEC_BATCH, CONV_W - 1, E), 1.0)
    for gi, (win, _) in enumerate(DIL_GROUPS):
        inp['cache_kv_w%d' % win] = nrm(ks[3 + gi], (N_C, DEC_BATCH, min(win, PAST_LEN), 2, C_HEADS, C_HEAD_DIM), 1.0)
    inp['norm_w'] = 1.0 + nrm(ks[6], (DEPTH, D_MODEL), 0.02)
    inp['final_norm_w'] = 1.0 + nrm(ks[7], (D_MODEL,), 0.02)
    inp['a_w_in'] = nrm(ks[8], (N_A, D_MODEL, 3 * E), D_MODEL ** -0.5)
    inp['a_ln_g'] = 1.0 + nrm(ks[9], (N_A, E), 0.02)
    inp['a_ln_b'] = nrm(ks[10], (N_A, E), 0.02)
    inp['a_w_s'] = nrm(ks[11], (N_A, A_GROUPS, CHUNK, CHUNK), CHUNK ** -0.5)
    inp['a_b_s'] = 1.0 + nrm(ks[12], (N_A, A_GROUPS, CHUNK), 0.1)
    inp['a_w_out'] = nrm(ks[13], (N_A, E, D_MODEL), E ** -0.5)
    inp['b_w_in'] = nrm(ks[14], (N_B, D_MODEL, 4 * E), D_MODEL ** -0.5)
    inp['b_conv_w'] = nrm(ks[15], (N_B, CONV_W, E), CONV_W ** -0.5)
    inp['b_w_out'] = nrm(ks[16], (N_B, E, D_MODEL), E ** -0.5)
    inp['c_w_in'] = nrm(ks[17], (N_C, D_MODEL, (3 * N_DIL + 1) * E), D_MODEL ** -0.5)
    inp['c_w_out'] = nrm(ks[18], (N_C, E, D_MODEL), E ** -0.5)
    return inp


def reference(x_prompt, x_sample, state_conv, cache_kv_w128, cache_kv_w512, cache_kv_w2048,
              norm_w, final_norm_w, a_w_in, a_ln_g, a_ln_b, a_w_s, a_b_s, a_w_out,
              b_w_in, b_conv_w, b_w_out, c_w_in, c_w_out):
    caches = (cache_kv_w128, cache_kv_w512, cache_kv_w2048)
    bsz, S, _ = x_prompt.shape
    T = x_sample.shape[1]
    pos_p = jnp.arange(S)
    pos_s = PAST_LEN + jnp.arange(T)
    hp, hs = x_prompt, x_sample
    v_rows, conv_p, conv_s = [], [], []
    kv_p = [[] for _ in DIL_GROUPS]
    kv_s = [[] for _ in DIL_GROUPS]
    for i in range(DEPTH):
        kind, j = i % N_MIXERS, i // N_MIXERS
        n_p, n_s = _rmsnorm(hp, norm_w[i]), _rmsnorm(hs, norm_w[i])
        if kind == 0:
            yp, _ = _mixer_a(n_p, a_w_in[j], a_ln_g[j], a_ln_b[j], a_w_s[j], a_b_s[j], a_w_out[j])
            ys, v_new = _mixer_a(n_s, a_w_in[j], a_ln_g[j], a_ln_b[j], a_w_s[j], a_b_s[j], a_w_out[j])
            v_rows.append(v_new)
        elif kind == 1:
            zeros = jnp.zeros((bsz, CONV_W - 1, E_WIDTH), n_p.dtype)
            yp, cp = _mixer_b(n_p, zeros, b_w_in[j], b_conv_w[j], b_w_out[j])
            ys, cs = _mixer_b(n_s, state_conv[j], b_w_in[j], b_conv_w[j], b_w_out[j])
            conv_p.append(cp)
            conv_s.append(cs)
        else:
            qp, kp, vp, gp = _c_project(n_p, c_w_in[j], pos_p)
            qs, ks_, vs_, gs = _c_project(n_s, c_w_in[j], pos_s)
            op, lp, osm, lsm = [], [], [], []
            for g, (win, dil) in enumerate(DIL_GROUPS):
                o, l = _dilated_prompt(qp[:, :, g], kp[:, :, g], vp[:, :, g], dil, win)
                op.append(o)
                lp.append(l)
                keep = min(win, S)
                kv_p[g].append(jnp.stack([kp[:, S - keep:, g], vp[:, S - keep:, g]], axis=2))
                o, l = _dilated_sample(qs[:, :, g], ks_[:, :, g], vs_[:, :, g], caches[g][j], dil, win)
                osm.append(o)
                lsm.append(l)
                kv_s[g].append(jnp.stack([ks_[:, :, g], vs_[:, :, g]], axis=2))
            yp = _c_finish(op, lp, gp, c_w_out[j])
            ys = _c_finish(osm, lsm, gs, c_w_out[j])
        hp = hp + yp
        hs = hs + ys
    y_prompt = _rmsnorm(hp, final_norm_w)
    y_sample = _rmsnorm(hs, final_norm_w)
    state_v_chunk_sample = jnp.stack(v_rows)
    state_conv_prompt = jnp.stack(conv_p)
    state_conv_sample = jnp.stack(conv_s)
    kvp = [jnp.stack(l) for l in kv_p]
    kvs = [jnp.stack(l) for l in kv_s]
    return (y_prompt, y_sample, state_v_chunk_sample, state_conv_prompt, state_conv_sample,
            kvp[0], kvs[0], kvp[1], kvs[1], kvp[2], kvs[2])
```

```cpp
#include <hip/hip_runtime.h>
#include <cstdio>
#include <cstdint>

#ifndef MK_SPLIT
#define MK_SPLIT 0
#endif

#define LAS __attribute__((address_space(3)))
#define GAS __attribute__((address_space(1)))
typedef unsigned short bf16;
typedef short bf16x8 __attribute__((ext_vector_type(8)));
typedef short s16x4 __attribute__((ext_vector_type(4)));
typedef float f32x2 __attribute__((ext_vector_type(2)));
typedef float f32x4 __attribute__((ext_vector_type(4)));
typedef float f32x16 __attribute__((ext_vector_type(16)));
typedef unsigned u32x2 __attribute__((ext_vector_type(2)));
typedef unsigned u32x4 __attribute__((ext_vector_type(4)));

constexpr int M_ = 16384, MS_ = 32, DM = 1024, EW = 2048, SEQ_ = 8192;
constexpr int N_AIN = 3 * EW, N_BIN = 4 * EW, N_CIN = 10 * EW;
constexpr float EPS_ = 1e-6f;
constexpr float LOG2E = 1.4426950408889634f;
constexpr float ATT_SCALE = 0.08838834764831845f;

constexpr size_t OFF_Y = 0, OFF_YS = 16777216, OFF_SV = 16809984, OFF_SCP = 16941056, OFF_SCS = 16949248;
constexpr size_t OFF_KV128P = 17080320, OFF_KV128S = 18128896, OFF_KV512P = 18259968, OFF_KV512S = 22454272, OFF_KV2048P = 22585344, OFF_KV2048S = 39362560;
constexpr size_t OUT_TOTAL = 39493632;

constexpr size_t MiB = 1u << 20;
constexpr size_t WS_CTL = 0, CTL_ZERO_BYTES = 1 * MiB;
constexpr size_t WS_ROPE = 1 * MiB;
constexpr size_t WS_WTRIL = 3 * MiB;
constexpr size_t WS_WA_IN0 = 4 * MiB, WS_WA_IN1 = 16 * MiB, WS_WB_IN = 28 * MiB, WS_WC_IN = 44 * MiB;
constexpr size_t WS_WA_OUT0 = 84 * MiB, WS_WA_OUT1 = 88 * MiB, WS_WB_OUT = 92 * MiB, WS_WC_OUT = 96 * MiB;
constexpr size_t WS_HP = 100 * MiB;
constexpr size_t WS_HB = 164 * MiB;
constexpr size_t WS_T = 196 * MiB;
constexpr size_t WS_SSQP = 260 * MiB;
constexpr size_t WS_LNP = 266 * MiB;
constexpr size_t WS_HS = 270 * MiB;
constexpr size_t WS_ZS = 271 * MiB;
constexpr size_t WS_TS = 274 * MiB;
constexpr size_t WS_LSE = 275 * MiB;
constexpr size_t WS_Z = 288 * MiB;
constexpr size_t WS_GATE = WS_Z + 576 * MiB;
constexpr size_t WS_OG = 928 * MiB;
constexpr size_t WS_END = 1120 * MiB;

constexpr int CW_BAR = 4096;

constexpr int LDS_BYTES = 147456;
constexpr int MISC_OFF = 140 * 1024;
constexpr int NWAVES = 8;
constexpr int NPH = 15;

__device__ __forceinline__ unsigned cvt_pk_bf16(float lo, float hi) { unsigned r; asm("v_cvt_pk_bf16_f32 %0, %1, %2" : "=v"(r) : "v"(lo), "v"(hi)); return r; }
__device__ __forceinline__ float bflo(unsigned w) { return __uint_as_float(w << 16); }
__device__ __forceinline__ float bfhi(unsigned w) { return __uint_as_float(w & 0xffff0000u); }
__device__ __forceinline__ float silu_f(float x) { return x * __builtin_amdgcn_rcpf(1.0f + __builtin_amdgcn_exp2f(-x * LOG2E)); }
__device__ __forceinline__ float wave_sum(float v) {
#pragma unroll
    for (int o = 1; o < 64; o <<= 1) v += __shfl_xor(v, o);
    return v;
}
__device__ __forceinline__ float wave_max(float v) {
#pragma unroll
    for (int o = 1; o < 64; o <<= 1) v = fmaxf(v, __shfl_xor(v, o));
    return v;
}
#define LDS_WAIT() asm volatile("s_waitcnt lgkmcnt(0)" ::: "memory")
#define VM_WAIT() asm volatile("s_waitcnt vmcnt(0)" ::: "memory")

namespace pg8 {
constexpr int BM = 256, BK = 64, HALF = 128, HTB = HALF * BK * 2, STAGE_BYTES = 8 * HTB, NXCD = 8, WGM = 8;
__host__ __device__ __forceinline__ int lds_byte(int r, int c) { const int st = (r >> 4) * 2 + (c >> 5), rr = r & 15, cc = c & 31, ob = rr * 64 + cc * 2; return st * 1024 + (ob ^ (((ob >> 9) & 1) << 5)); }
__host__ __device__ __forceinline__ void stage_rc(int b, int& R, int& C) { const int st = b / 1024, sb = b % 1024, swz = sb ^ (((sb >> 9) & 1) << 5); R = (st >> 1) * 16 + swz / 64; C = (st & 1) * 32 + (swz % 64) / 2; }
__host__ __device__ __forceinline__ int perm32(int rho) { const int n = rho >> 4, i = rho & 15; return 8 * (i >> 2) + 4 * n + (i & 3); }

struct Unit { int pm, pn; };
struct Gemm { const bf16* A; const bf16* Bt; int M, N, K; };

struct StaticOrder {
    int nM, nN, nwg, G, c;
    __host__ __device__ void init(int M, int N, int G_, int c_) { nM = M / BM; nN = N / BM; nwg = nM * nN; G = G_; c = c_; }
    __host__ __device__ bool next(int i, Unit& u) const {
        const long L = (long)i * G + c; if (L >= nwg) return false;
        int wgid = (int)L; { const int q = nwg / NXCD, r = nwg % NXCD, xcd = wgid % NXCD, off = wgid / NXCD; wgid = (xcd < r ? xcd * (q + 1) : r * (q + 1) + (xcd - r) * q) + off; }
        const int nig = WGM * nN, gid = wgid / nig, fm = gid * WGM, gsz = (nM - fm) < WGM ? (nM - fm) : WGM;
        u.pm = fm + ((wgid % nig) % gsz); u.pn = (wgid % nig) / gsz; return true;
    }
    __device__ __forceinline__ void a_ready(const Unit&) const {}
    __device__ __forceinline__ void done(const Unit&) const {}
};

template <class Epi, class Sched, bool ALIGN_EPI = false, bool SP2 = false>
__device__ __forceinline__ void gemm_phase(LAS unsigned char* lds, const Gemm g, const Sched& S, const Epi& E) {
    const int tid = threadIdx.x, wid = __builtin_amdgcn_readfirstlane(tid >> 6), lane = tid & 63, wr = wid >> 2, wc = wid & 3, fr = lane & 15, fq = lane >> 4;
    const int K = g.K, nt = K / BK;
    unsigned voffA[2], voffB[2];
#pragma unroll
    for (int i = 0; i < 2; ++i) { int R, C; stage_rc(tid * 16 + i * 8192, R, C); const int Rb = Epi::PERM ? ((R & ~31) + perm32(R & 31)) : R;
        voffA[i] = (unsigned)(R * K + C) * 2u; voffB[i] = (unsigned)(Rb * K + C) * 2u; }
    const size_t kstep = (size_t)(BK * 2);
    const size_t hstep = (size_t)HALF * K * 2;
    const size_t tstep = 2 * hstep;
    const unsigned ldsw = (unsigned)wid * 1024u;
    const int aoff = lds_byte(wr * 64 + fr, fq * 8), boff = lds_byte(wc * 32 + fr, fq * 8);
#define PG8_SA(b, h) (((b) * 2 + (h)) * HTB)
#define PG8_SB(b, h) ((4 + (b) * 2 + (h)) * HTB)
#define PG8_STAGE(bufoff, gbase, voff) do { _Pragma("unroll") for (int _i = 0; _i < 2; ++_i) \
        __builtin_amdgcn_global_load_lds((const unsigned*)((const char*)(gbase) + (voff)[_i]), (LAS unsigned*)(lds + (bufoff) + ldsw + _i * 8192), 16, 0, 0); } while (0)
#define PG8_LDA(dst, b, h) do { _Pragma("unroll") for (int m = 0; m < 4; ++m) _Pragma("unroll") for (int k = 0; k < 2; ++k) dst[m][k] = *(const LAS bf16x8*)(lds + PG8_SA(b, h) + aoff + m * 2048 + k * 1024); } while (0)
#define PG8_LDB(dst, b, h) do { _Pragma("unroll") for (int n = 0; n < 2; ++n) _Pragma("unroll") for (int k = 0; k < 2; ++k) dst[n][k] = *(const LAS bf16x8*)(lds + PG8_SB(b, h) + boff + n * 2048 + k * 1024); } while (0)
#define PG8_MMA(ai, bj, At, Bt) do { __builtin_amdgcn_s_setprio(1); _Pragma("unroll") for (int m = 0; m < 4; ++m) _Pragma("unroll") for (int n = 0; n < 2; ++n) _Pragma("unroll") for (int k = 0; k < 2; ++k) \
        acc[ai][bj][m][n] = __builtin_amdgcn_mfma_f32_16x16x32_bf16(Bt[n][k], At[m][k], acc[ai][bj][m][n], 0, 0, 0); __builtin_amdgcn_s_setprio(0); } while (0)
#define PG8_WAIT_V(n) asm volatile("s_waitcnt vmcnt(" #n ")" ::: "memory")
#define PG8_WAIT_L(n) asm volatile("s_waitcnt lgkmcnt(" #n ")" ::: "memory")
#define PG8_BAR __builtin_amdgcn_s_barrier()
#define PG8_SCHED __builtin_amdgcn_sched_barrier(0)
    Unit cur, nxt; int ui = 0;
    if (!S.next(0, cur)) return;
    f32x4 acc[2][2][4][2];
#pragma unroll
    for (int a = 0; a < 2; ++a)
#pragma unroll
        for (int b = 0; b < 2; ++b)
#pragma unroll
            for (int m = 0; m < 4; ++m)
#pragma unroll
                for (int n = 0; n < 2; ++n) acc[a][b][m][n] = (f32x4){0.f, 0.f, 0.f, 0.f};
    bf16x8 At[4][2], B0[2][2], B1[2][2];
    const char* cA = (const char*)g.A + (size_t)cur.pm * tstep; const char* cB = (const char*)g.Bt + (size_t)cur.pn * tstep;
    S.a_ready(cur);
    if constexpr (SP2) {
        PG8_STAGE(PG8_SB(0, 0), cB, voffB); PG8_STAGE(PG8_SB(0, 1), cB + hstep, voffB); PG8_STAGE(PG8_SA(0, 0), cA, voffA); PG8_STAGE(PG8_SA(0, 1), cA + hstep, voffA);
        if (wr == 1) PG8_BAR;
        PG8_WAIT_V(2); PG8_BAR;
        PG8_STAGE(PG8_SB(1, 0), cB + kstep, voffB); PG8_STAGE(PG8_SA(1, 0), cA + kstep, voffA); PG8_STAGE(PG8_SB(1, 1), cB + hstep + kstep, voffB);
        PG8_WAIT_V(6); PG8_BAR;
    } else {
        PG8_STAGE(PG8_SB(0, 0), cB, voffB); PG8_STAGE(PG8_SA(0, 0), cA, voffA); PG8_STAGE(PG8_SB(0, 1), cB + hstep, voffB); PG8_STAGE(PG8_SA(0, 1), cA + hstep, voffA);
        if (wr == 1) PG8_BAR;
        PG8_WAIT_V(4); PG8_BAR;
        PG8_STAGE(PG8_SB(1, 0), cB + kstep, voffB); PG8_STAGE(PG8_SA(1, 0), cA + kstep, voffA); PG8_STAGE(PG8_SB(1, 1), cB + hstep + kstep, voffB);
        PG8_WAIT_V(6); PG8_BAR;
    }
    for (;;) {
        const bool has_next = S.next(ui + 1, nxt);
        const char* nA = has_next ? (const char*)g.A + (size_t)nxt.pm * tstep : cA; const char* nB = has_next ? (const char*)g.Bt + (size_t)nxt.pn * tstep : cB;
        for (int t = 0; t < nt; t += 2) {
            const bool last = (t == nt - 2);
            const char* a1 = cA + (size_t)(t + 1) * kstep;
            const char* a2 = last ? nA : cA + (size_t)(t + 2) * kstep; const char* b2 = last ? nB : cB + (size_t)(t + 2) * kstep;
            const char* a3 = a2 + kstep; const char* b3 = b2 + kstep;
            if (last && has_next) S.a_ready(nxt);
            if constexpr (SP2) {
            PG8_LDB(B0, 0, 0); PG8_LDB(B1, 0, 1); PG8_SCHED; PG8_LDA(At, 0, 0); PG8_STAGE(PG8_SA(1, 1), a1 + hstep, voffA);
            PG8_WAIT_V(8); PG8_WAIT_L(0); PG8_BAR; PG8_MMA(0, 0, At, B0); PG8_MMA(0, 1, At, B1); PG8_BAR; PG8_SCHED;
            PG8_LDA(At, 0, 1); PG8_STAGE(PG8_SB(0, 0), b2, voffB); PG8_STAGE(PG8_SB(0, 1), b2 + hstep, voffB); PG8_STAGE(PG8_SA(0, 0), a2, voffA);
            PG8_WAIT_V(8); PG8_WAIT_L(0); PG8_BAR; PG8_MMA(1, 0, At, B0); PG8_MMA(1, 1, At, B1); PG8_BAR; PG8_SCHED;
            PG8_LDB(B0, 1, 0); PG8_LDB(B1, 1, 1); PG8_SCHED; PG8_LDA(At, 1, 0); PG8_STAGE(PG8_SA(0, 1), a2 + hstep, voffA);
            PG8_WAIT_V(8); PG8_WAIT_L(0); PG8_BAR; PG8_MMA(0, 0, At, B0); PG8_MMA(0, 1, At, B1); PG8_BAR; PG8_SCHED;
            PG8_LDA(At, 1, 1); PG8_STAGE(PG8_SB(1, 0), b3, voffB); PG8_STAGE(PG8_SB(1, 1), b3 + hstep, voffB); PG8_STAGE(PG8_SA(1, 0), a3, voffA);
            PG8_WAIT_V(8); PG8_WAIT_L(0); PG8_BAR; PG8_MMA(1, 0, At, B0); PG8_MMA(1, 1, At, B1); PG8_BAR; PG8_SCHED;
            } else {
            PG8_LDB(B0, 0, 0); PG8_SCHED; PG8_LDA(At, 0, 0); PG8_STAGE(PG8_SA(1, 1), a1 + hstep, voffA);
            PG8_WAIT_L(8); PG8_BAR; PG8_WAIT_L(0); PG8_MMA(0, 0, At, B0); PG8_BAR; PG8_SCHED;
            PG8_LDB(B1, 0, 1); PG8_STAGE(PG8_SB(0, 0), b2, voffB);
            PG8_BAR; PG8_WAIT_L(0); PG8_MMA(0, 1, At, B1); PG8_BAR;
            PG8_LDA(At, 0, 1); PG8_STAGE(PG8_SA(0, 0), a2, voffA);
            PG8_BAR; PG8_WAIT_L(0); PG8_MMA(1, 0, At, B0); PG8_BAR; PG8_SCHED;
            PG8_STAGE(PG8_SB(0, 1), b2 + hstep, voffB);
            PG8_WAIT_V(6); PG8_BAR; PG8_MMA(1, 1, At, B1); PG8_BAR;
            PG8_LDB(B0, 1, 0); PG8_SCHED; PG8_LDA(At, 1, 0); PG8_STAGE(PG8_SA(0, 1), a2 + hstep, voffA);
            PG8_WAIT_L(8); PG8_BAR; PG8_WAIT_L(0); PG8_MMA(0, 0, At, B0); PG8_BAR; PG8_SCHED;
            PG8_LDB(B1, 1, 1); PG8_STAGE(PG8_SB(1, 0), b3, voffB);
            PG8_BAR; PG8_WAIT_L(0); PG8_MMA(0, 1, At, B1); PG8_BAR;
            PG8_LDA(At, 1, 1); PG8_STAGE(PG8_SA(1, 0), a3, voffA);
            PG8_BAR; PG8_WAIT_L(0); PG8_MMA(1, 0, At, B0); PG8_BAR; PG8_SCHED;
            PG8_STAGE(PG8_SB(1, 1), b3 + hstep, voffB);
            PG8_WAIT_V(6); PG8_BAR; PG8_MMA(1, 1, At, B1); PG8_BAR;
            }
        }
        if constexpr (ALIGN_EPI) { if (wr == 0) PG8_BAR; }
        E(acc, cur, wr, wc, fr, fq); S.done(cur);
        if (!has_next) break;
#pragma unroll
        for (int a = 0; a < 2; ++a)
#pragma unroll
            for (int b = 0; b < 2; ++b)
#pragma unroll
                for (int m = 0; m < 4; ++m)
#pragma unroll
                    for (int n = 0; n < 2; ++n) acc[a][b][m][n] = (f32x4){0.f, 0.f, 0.f, 0.f};
        cur = nxt; cA = nA; cB = nB; ++ui;
        if constexpr (ALIGN_EPI) { if (wr == 1) PG8_BAR; }
    }
    PG8_WAIT_V(0);
    if constexpr (!ALIGN_EPI) { if (wr == 0) PG8_BAR; }
    PG8_BAR;
#undef PG8_SA
#undef PG8_SB
#undef PG8_STAGE
#undef PG8_LDA
#undef PG8_LDB
#undef PG8_MMA
#undef PG8_WAIT_V
#undef PG8_WAIT_L
#undef PG8_BAR
#undef PG8_SCHED
}

__device__ __forceinline__ float row_rstd(const float* ssqp, int row, int fq) {
    const f32x4 pp = *(const f32x4*)(ssqp + (size_t)row * 16 + 4 * fq);
    float s = (pp[0] + pp[1]) + (pp[2] + pp[3]);
    s += __shfl_xor(s, 16); s += __shfl_xor(s, 32);
    return __builtin_amdgcn_rsqf(s * (1.0f / DM) + EPS_);
}

struct EpiIn {
    static constexpr bool PERM = true;
    bf16* Z; int ldz; const float* ssqp; float* lnp; int st_lo, st_hi;
    __device__ __forceinline__ void operator()(const f32x4 (&acc)[2][2][4][2], const Unit& u, int wr, int wc, int fr, int fq) const {
        const int row0 = u.pm * BM + wr * 64 + fr, col0 = u.pn * BM + wc * 32 + 8 * fq;
        const bool do_st = (u.pn >= st_lo) && (u.pn < st_hi);
#pragma unroll
        for (int ai = 0; ai < 2; ++ai)
#pragma unroll
            for (int m = 0; m < 4; ++m) {
                const int row = row0 + ai * HALF + m * 16;
                const float rstd = row_rstd(ssqp, row, fq);
                bf16* rowp = Z + (size_t)row * ldz + col0;
                float ps = 0.f, pq = 0.f;
#pragma unroll
                for (int bj = 0; bj < 2; ++bj) {
                    const f32x4 v0 = acc[ai][bj][m][0] * rstd, v1 = acc[ai][bj][m][1] * rstd;
                    u32x4 w; w.x = cvt_pk_bf16(v0[0], v0[1]); w.y = cvt_pk_bf16(v0[2], v0[3]); w.z = cvt_pk_bf16(v1[0], v1[1]); w.w = cvt_pk_bf16(v1[2], v1[3]);
                    *(u32x4*)(rowp + bj * HALF) = w;
                    if (do_st) {
                        ps += ((v0[0] + v0[1]) + (v0[2] + v0[3])) + ((v1[0] + v1[1]) + (v1[2] + v1[3]));
                        pq += ((v0[0] * v0[0] + v0[1] * v0[1]) + (v0[2] * v0[2] + v0[3] * v0[3])) + ((v1[0] * v1[0] + v1[1] * v1[1]) + (v1[2] * v1[2] + v1[3] * v1[3]));
                    }
                }
                if (do_st) {
                    ps += __shfl_xor(ps, 16); ps += __shfl_xor(ps, 32); pq += __shfl_xor(pq, 16); pq += __shfl_xor(pq, 32);
                    if (fq == 0) *(f32x2*)(lnp + ((size_t)row * 32 + (u.pn - st_lo) * 4 + wc) * 2) = (f32x2){ps, pq};
                }
            }
    }
};

struct EpiOut {
    static constexpr bool PERM = true;
    const float* res; float* hp; bf16* hb; float* ssqn;
    __device__ __forceinline__ void operator()(const f32x4 (&acc)[2][2][4][2], const Unit& u, int wr, int wc, int fr, int fq) const {
        const int row0 = u.pm * BM + wr * 64 + fr, col0 = u.pn * BM + wc * 32 + 8 * fq;
#pragma unroll
        for (int ai = 0; ai < 2; ++ai)
#pragma unroll
            for (int m = 0; m < 4; ++m) {
                const int row = row0 + ai * HALF + m * 16;
                const size_t off = (size_t)row * DM + col0;
                float sq = 0.f;
#pragma unroll
                for (int bj = 0; bj < 2; ++bj) {
                    const f32x4 r0 = *(const f32x4*)(res + off + bj * HALF), r1 = *(const f32x4*)(res + off + bj * HALF + 4);
                    const f32x4 v0 = acc[ai][bj][m][0] + r0, v1 = acc[ai][bj][m][1] + r1;
                    *(f32x4*)(hp + off + bj * HALF) = v0; *(f32x4*)(hp + off + bj * HALF + 4) = v1;
                    u32x4 w; w.x = cvt_pk_bf16(v0[0], v0[1]); w.y = cvt_pk_bf16(v0[2], v0[3]); w.z = cvt_pk_bf16(v1[0], v1[1]); w.w = cvt_pk_bf16(v1[2], v1[3]);
                    *(u32x4*)(hb + off + bj * HALF) = w;
                    sq += ((v0[0] * v0[0] + v0[1] * v0[1]) + (v0[2] * v0[2] + v0[3] * v0[3])) + ((v1[0] * v1[0] + v1[1] * v1[1]) + (v1[2] * v1[2] + v1[3] * v1[3]));
                }
                sq += __shfl_xor(sq, 16); sq += __shfl_xor(sq, 32);
                if (fq == 0) ssqn[(size_t)row * 16 + u.pn * 4 + wc] = sq;
            }
    }
};

struct EpiCin {
    static constexpr bool PERM = true;
    bf16* QKV; bf16* GATE; const float* ssqp; const float* rope; float* out;
    __device__ __forceinline__ void operator()(const f32x4 (&acc)[2][2][4][2], const Unit& u, int wr, int wc, int fr, int fq) const {
        const int row0 = u.pm * BM + wr * 64 + fr;
        if (u.pn >= 72) {
            const int col0 = (u.pn - 72) * BM + wc * 32 + 8 * fq;
#pragma unroll
            for (int ai = 0; ai < 2; ++ai)
#pragma unroll
                for (int m = 0; m < 4; ++m) {
                    const int row = row0 + ai * HALF + m * 16;
                    const float rstd = row_rstd(ssqp, row, fq);
                    bf16* rowp = GATE + (size_t)row * EW + col0;
#pragma unroll
                    for (int bj = 0; bj < 2; ++bj) {
                        const f32x4 v0 = acc[ai][bj][m][0] * rstd, v1 = acc[ai][bj][m][1] * rstd;
                        u32x4 w; w.x = cvt_pk_bf16(v0[0], v0[1]); w.y = cvt_pk_bf16(v0[2], v0[3]); w.z = cvt_pk_bf16(v1[0], v1[1]); w.w = cvt_pk_bf16(v1[2], v1[3]);
                        *(u32x4*)(rowp + bj * HALF) = w;
                    }
                }
            return;
        }
        const int which = u.pn / 24, g = (u.pn % 24) >> 3, hp2 = u.pn & 7;
        const int dsh = 2 * g, lsh = 13 - dsh, dmask = (1 << dsh) - 1, win = 128 << dsh;
        const int b = u.pm >> 5;
        const size_t kvoff = (g == 0) ? OFF_KV128P : (g == 1 ? OFF_KV512P : OFF_KV2048P);
        const bool do_rope = (which < 2) && (wc == 0);
#pragma unroll
        for (int ai = 0; ai < 2; ++ai)
#pragma unroll
            for (int m = 0; m < 4; ++m) {
                const int row = row0 + ai * HALF + m * 16;
                const int t = row & (SEQ_ - 1);
                const int sp = ((t & dmask) << lsh) | (t >> dsh);
                const float rstd = row_rstd(ssqp, row, fq);
                f32x4 cs0 = (f32x4){1.f, 0.f, 1.f, 0.f}, cs1 = cs0;
                if (do_rope) { const float* rp = rope + ((size_t)t * 16 + 4 * fq) * 2; cs0 = *(const f32x4*)rp; cs1 = *(const f32x4*)(rp + 4); }
                const bool kvrow = (which >= 1) && (t >= SEQ_ - win);
#pragma unroll
                for (int bj = 0; bj < 2; ++bj) {
                    const int h = 2 * hp2 + bj;
                    f32x4 v0 = acc[ai][bj][m][0] * rstd, v1 = acc[ai][bj][m][1] * rstd;
                    if (do_rope) {
                        const f32x4 a = v0, c = v1;
                        v0[0] = a[0] * cs0[0] - a[1] * cs0[1]; v0[1] = a[1] * cs0[0] + a[0] * cs0[1];
                        v0[2] = a[2] * cs0[2] - a[3] * cs0[3]; v0[3] = a[3] * cs0[2] + a[2] * cs0[3];
                        v1[0] = c[0] * cs1[0] - c[1] * cs1[1]; v1[1] = c[1] * cs1[0] + c[0] * cs1[1];
                        v1[2] = c[2] * cs1[2] - c[3] * cs1[3]; v1[3] = c[3] * cs1[2] + c[2] * cs1[3];
                    }
                    u32x4 w; w.x = cvt_pk_bf16(v0[0], v0[1]); w.y = cvt_pk_bf16(v0[2], v0[3]); w.z = cvt_pk_bf16(v1[0], v1[1]); w.w = cvt_pk_bf16(v1[2], v1[3]);
                    bf16* dst = QKV + ((((size_t)(which * 3 + g) * 2 + b) * 16 + h) * SEQ_ + sp) * 128 + wc * 32 + 8 * fq;
                    *(u32x4*)dst = w;
                    if (kvrow) {
                        float* ob = out + kvoff + ((((size_t)b * win + (t - (SEQ_ - win))) * 2 + (which - 1)) * 16 + h) * 128;
                        if (do_rope) {
                            *(f32x4*)(ob + 4 * fq) = (f32x4){v0[0], v0[2], v1[0], v1[2]};
                            *(f32x4*)(ob + 16 + 4 * fq) = (f32x4){v0[1], v0[3], v1[1], v1[3]};
                        } else {
                            *(f32x4*)(ob + wc * 32 + 8 * fq) = v0; *(f32x4*)(ob + wc * 32 + 8 * fq + 4) = v1;
                        }
                    }
                }
            }
    }
};
}

#define XB_TMO      128
#define XB_XCNT(j)  (256  + 64 * (j))
#define XB_XSUB(j)  (1280 + 64 * (j))
#define XB_XGEN(j)  (2304 + 64 * (j))
#define XB_TOP      3328
#define XB_TOPGEN   3392
#define XCD_BAR_WORDS 3456
#define XB_SPIN_CAP (1u << 18)

__device__ __forceinline__ unsigned xb_ld(unsigned* p)              { return __hip_atomic_load(p, __ATOMIC_RELAXED, __HIP_MEMORY_SCOPE_AGENT); }
__device__ __forceinline__ unsigned xb_add(unsigned* p, unsigned v) { return __hip_atomic_fetch_add(p, v, __ATOMIC_RELAXED, __HIP_MEMORY_SCOPE_AGENT); }
__device__ __forceinline__ unsigned xb_xcc_id() { return (unsigned)__builtin_amdgcn_s_getreg((3 << 11) | 20) & 0xFu; }
#define XB_SPIN(cond, bar) do { unsigned _sp = 0; while (cond) { __builtin_amdgcn_s_sleep(1); \
    if ((++_sp & 255u) == 0u) { if (xb_ld(&(bar)[XB_TMO])) break; if (_sp > XB_SPIN_CAP) { atomicAdd(&(bar)[XB_TMO], 1u); break; } } } } while (0)

struct XcdBarrier { unsigned* bar; unsigned x; volatile LAS unsigned* st; };

__device__ __forceinline__ XcdBarrier xcd_barrier_post(unsigned* bar, volatile LAS unsigned* st) {
    XcdBarrier b; b.bar = bar; b.x = xb_xcc_id(); b.st = st;
    if (threadIdx.x == 0) (void)xb_add(&bar[XB_XCNT(b.x)], 1u);
    return b;
}
__device__ __forceinline__ void xcd_barrier_complete(unsigned* bar, unsigned x, unsigned& nloc, unsigned& nx) {
    const unsigned G = gridDim.x * gridDim.y * gridDim.z;
    unsigned sum, cnt, mine, sp = 0u;
    for (;;) {
        sum = 0u; cnt = 0u; mine = 0u;
#pragma unroll
        for (unsigned j = 0; j < 16; ++j) { const unsigned c = xb_ld(&bar[XB_XCNT(j)]); sum += c; cnt += (c > 0u) ? 1u : 0u; mine = (j == x) ? c : mine; }
        if (sum == G) break;
        __builtin_amdgcn_s_sleep(1);
        if ((++sp & 255u) == 0u) { if (xb_ld(&bar[XB_TMO])) break; if (sp > XB_SPIN_CAP) { atomicAdd(&bar[XB_TMO], 1u); break; } }
    }
    nloc = mine > 0u ? mine : 1u; nx = cnt > 0u ? cnt : 1u;
}
__device__ __forceinline__ void xcd_barrier(const XcdBarrier& b) {
    asm volatile("s_waitcnt vmcnt(0)" ::: "memory");
    __syncthreads();
    if (threadIdx.x == 0) {
        unsigned* bar = b.bar;
        __builtin_amdgcn_s_waitcnt(0);
        unsigned nloc = b.st[0], nx = b.st[1];
        if (nloc == 0u) { xcd_barrier_complete(bar, b.x, nloc, nx); b.st[0] = nloc; b.st[1] = nx; }
        const unsigned old = xb_add(&bar[XB_XSUB(b.x)], 1u);
        const unsigned gen = old / nloc;
        if (old + 1u == (gen + 1u) * nloc) {
            __builtin_amdgcn_fence(__ATOMIC_RELEASE, "agent");
            asm volatile("s_waitcnt vmcnt(0)" ::: "memory");
            const unsigned og = xb_add(&bar[XB_TOP], 1u);
            const unsigned tg = og / nx;
            if (og + 1u == (tg + 1u) * nx) xb_add(&bar[XB_TOPGEN], 1u);
            else XB_SPIN(xb_ld(&bar[XB_TOPGEN]) == tg, bar);
            __builtin_amdgcn_fence(__ATOMIC_ACQUIRE, "agent");
            xb_add(&bar[XB_XGEN(b.x)], 1u);
            asm volatile("s_waitcnt vmcnt(0)" ::: "memory");
        } else {
            XB_SPIN(xb_ld(&bar[XB_XGEN(b.x)]) == gen, bar);
            __builtin_amdgcn_fence(__ATOMIC_ACQUIRE, "agent");
            asm volatile("s_waitcnt vmcnt(0)" ::: "memory");
        }
    }
    __syncthreads();
}

struct Args { const float* in[19]; float* out; unsigned char* ws; int ph_lo, ph_hi; };

__device__ __forceinline__ void p0_transpose_item(const float* W, int K, int N, bf16* WT, const float* scale, bool ropeperm, LAS float* scr, int kb, int nb, int lane) {
    const int k0 = 64 * kb, n0 = 32 * nb;
#pragma unroll 8
    for (int i = 0; i < 32; ++i) { const int kk = 2 * i + (lane >> 5); float v = W[(size_t)(k0 + kk) * N + n0 + (lane & 31)]; if (scale) v *= scale[k0 + kk]; scr[kk * 33 + (lane & 31)] = v; }
    LDS_WAIT(); asm volatile("" ::: "memory");
    const int c = lane & 7;
#pragma unroll
    for (int j = 0; j < 4; ++j) { const int n = (lane >> 3) + 8 * j; const int sn = ropeperm ? ((n >> 1) + ((n & 1) << 4)) : n; const LAS float* s = scr + (8 * c) * 33 + sn;
        u32x4 o; o.x = cvt_pk_bf16(s[0 * 33], s[1 * 33]); o.y = cvt_pk_bf16(s[2 * 33], s[3 * 33]); o.z = cvt_pk_bf16(s[4 * 33], s[5 * 33]); o.w = cvt_pk_bf16(s[6 * 33], s[7 * 33]);
        *(u32x4*)(WT + (size_t)(n0 + n) * K + k0 + 8 * c) = o; }
    LDS_WAIT(); asm volatile("" ::: "memory");
}

__device__ __forceinline__ void p0_prologue(const Args& a, LAS unsigned char* lds, int G) {
    const int tid = threadIdx.x, lane = tid & 63, wave = tid >> 6;
    unsigned char* ws = a.ws;
    LAS float* scr = (LAS float*)(lds + wave * 16384);
    const int gw = blockIdx.x * NWAVES + wave, NGW = G * NWAVES;
    constexpr int I_AIN = (DM / 64) * (N_AIN / 32), I_BIN = (DM / 64) * (N_BIN / 32), I_CIN = (DM / 64) * (N_CIN / 32), I_OUT = (EW / 64) * (DM / 32);
    constexpr int NITEMS = 2 * I_AIN + I_BIN + I_CIN + 4 * I_OUT;
    for (int it = gw; it < NITEMS; it += NGW) {
        int r = it;
        if (r < I_AIN) { p0_transpose_item(a.in[8], DM, N_AIN, (bf16*)(ws + WS_WA_IN0), a.in[6], false, scr, r / (N_AIN / 32), r % (N_AIN / 32), lane); continue; } r -= I_AIN;
        if (r < I_AIN) { p0_transpose_item(a.in[8] + (size_t)DM * N_AIN, DM, N_AIN, (bf16*)(ws + WS_WA_IN1), a.in[6] + 3 * DM, false, scr, r / (N_AIN / 32), r % (N_AIN / 32), lane); continue; } r -= I_AIN;
        if (r < I_BIN) { p0_transpose_item(a.in[14], DM, N_BIN, (bf16*)(ws + WS_WB_IN), a.in[6] + 1 * DM, false, scr, r / (N_BIN / 32), r % (N_BIN / 32), lane); continue; } r -= I_BIN;
        if (r < I_CIN) { const int nb = r % (N_CIN / 32);
            const bool ropeperm = (nb * 32 < 2 * 3 * EW) && ((nb & 3) == 0);
            p0_transpose_item(a.in[17], DM, N_CIN, (bf16*)(ws + WS_WC_IN), a.in[6] + 2 * DM, ropeperm, scr, r / (N_CIN / 32), nb, lane); continue; } r -= I_CIN;
        const int which = r / I_OUT; r -= which * I_OUT;
        const float* src = which == 0 ? a.in[13] : (which == 1 ? a.in[13] + (size_t)EW * DM : (which == 2 ? a.in[16] : a.in[18]));
        bf16* dst = (bf16*)(ws + (which == 0 ? WS_WA_OUT0 : (which == 1 ? WS_WA_OUT1 : (which == 2 ? WS_WB_OUT : WS_WC_OUT))));
        p0_transpose_item(src, EW, DM, dst, nullptr, false, scr, r / (DM / 32), r % (DM / 32), lane);
    }
    {
        const float* x = a.in[0]; bf16* hb = (bf16*)(ws + WS_HB); float* ssq0 = (float*)(ws + WS_SSQP);
        for (int m = gw; m < M_; m += NGW) {
            const f32x4* xr = (const f32x4*)(x + (size_t)m * DM) + lane;
            f32x4 v[4]; float s = 0.f;
#pragma unroll
            for (int j = 0; j < 4; ++j) { v[j] = xr[64 * j]; s += (v[j][0] * v[j][0] + v[j][1] * v[j][1]) + (v[j][2] * v[j][2] + v[j][3] * v[j][3]); }
            s = wave_sum(s);
            u32x2* o8 = (u32x2*)(hb + (size_t)m * DM) + lane;
#pragma unroll
            for (int j = 0; j < 4; ++j) { u32x2 w; w.x = cvt_pk_bf16(v[j][0], v[j][1]); w.y = cvt_pk_bf16(v[j][2], v[j][3]); o8[64 * j] = w; }
            if (lane < 16) ssq0[(size_t)m * 16 + lane] = (lane == 0) ? s : 0.f;
        }
    }
    const int gt = blockIdx.x * (NWAVES * 64) + tid, NGT = G * NWAVES * 64;
    { const float* xs = a.in[1]; float* hs = (float*)(ws + WS_HS); for (int i = gt; i < MS_ * DM; i += NGT) hs[i] = xs[i]; }
    { f32x2* rope = (f32x2*)(ws + WS_ROPE);
      for (int i = gt; i < (SEQ_ + 1) * 16; i += NGT) { const int pos = i >> 4, k = i & 15;
          const float inv = (float)pow(500000.0, -(double)k / 16.0); const float ang = (float)pos * inv;
          rope[i] = (f32x2){(float)cos((double)ang), (float)sin((double)ang)}; } }
    { const float* wsrc = a.in[11]; bf16* wt = (bf16*)(ws + WS_WTRIL);
      for (int i = gt; i < 2 * 8 * 128 * 128 / 2; i += NGT) { const int e = 2 * i, ii = (e >> 7) & 127, jj = e & 127;
          const float v0 = (jj <= ii) ? wsrc[e] : 0.f, v1 = (jj + 1 <= ii) ? wsrc[e + 1] : 0.f;
          ((unsigned*)wt)[i] = cvt_pk_bf16(v0, v1); } }
}

__device__ __forceinline__ void sample_in_gemm(LAS unsigned char* lds, const float* hs, const bf16* Wt, int N, float* zs, int G) {
    const int tid = threadIdx.x, lane = tid & 63, wave = tid >> 6, fr = lane & 15, fq = lane >> 4;
    constexpr int PITCH = 2064;
    LAS float* rs = (LAS float*)(lds + 32 * PITCH);
    {
        const int row = tid >> 4, c0 = (tid & 15) * 64;
        const f32x4* src = (const f32x4*)(hs + (size_t)row * DM + c0);
        float s = 0.f;
#pragma unroll
        for (int i = 0; i < 8; ++i) { const f32x4 a0 = src[2 * i], a1 = src[2 * i + 1];
            s += ((a0[0] * a0[0] + a0[1] * a0[1]) + (a0[2] * a0[2] + a0[3] * a0[3])) + ((a1[0] * a1[0] + a1[1] * a1[1]) + (a1[2] * a1[2] + a1[3] * a1[3]));
            u32x4 w; w.x = cvt_pk_bf16(a0[0], a0[1]); w.y = cvt_pk_bf16(a0[2], a0[3]); w.z = cvt_pk_bf16(a1[0], a1[1]); w.w = cvt_pk_bf16(a1[2], a1[3]);
            *(LAS u32x4*)(lds + row * PITCH + (c0 + 8 * i) * 2) = w; }
        s += __shfl_xor(s, 1); s += __shfl_xor(s, 2); s += __shfl_xor(s, 4); s += __shfl_xor(s, 8);
        if ((tid & 15) == 0) rs[row] = __builtin_amdgcn_rsqf(s * (1.0f / DM) + EPS_);
    }
    __syncthreads();
    const int ntiles = N / 16;
    for (int nt = blockIdx.x + G * wave; nt < ntiles; nt += G * NWAVES) {
        f32x4 acc0 = (f32x4){0.f, 0.f, 0.f, 0.f}, acc1 = acc0;
        const bf16* bp = Wt + (size_t)(nt * 16 + fr) * DM + 8 * fq;
        const LAS unsigned char* ap = lds + fr * PITCH + fq * 16;
#pragma unroll 8
        for (int k = 0; k < DM / 32; ++k) {
            const bf16x8 b = *(const bf16x8*)(bp + 32 * k);
            const bf16x8 a0 = *(const LAS bf16x8*)(ap + k * 64), a1 = *(const LAS bf16x8*)(ap + 16 * PITCH + k * 64);
            acc0 = __builtin_amdgcn_mfma_f32_16x16x32_bf16(b, a0, acc0, 0, 0, 0);
            acc1 = __builtin_amdgcn_mfma_f32_16x16x32_bf16(b, a1, acc1, 0, 0, 0);
        }
        const float r0 = rs[fr], r1 = rs[16 + fr];
        *(f32x4*)(zs + (size_t)fr * N + nt * 16 + 4 * fq) = acc0 * r0;
        *(f32x4*)(zs + (size_t)(16 + fr) * N + nt * 16 + 4 * fq) = acc1 * r1;
    }
    __syncthreads();
}
__device__ __forceinline__ void sample_out_gemm(const bf16* ts, const bf16* Wt, float* hs, int G) {
    const int tid = threadIdx.x, lane = tid & 63, wave = tid >> 6, fr = lane & 15, fq = lane >> 4;
    for (int nt = blockIdx.x + G * wave; nt < DM / 16; nt += G * NWAVES) {
        f32x4 acc0 = (f32x4){0.f, 0.f, 0.f, 0.f}, acc1 = acc0;
        const bf16* bp = Wt + (size_t)(nt * 16 + fr) * EW + 8 * fq;
        const bf16* ap = ts + (size_t)fr * EW + 8 * fq;
#pragma unroll 8
        for (int k = 0; k < EW / 32; ++k) {
            const bf16x8 b = *(const bf16x8*)(bp + 32 * k);
            const bf16x8 a0 = *(const bf16x8*)(ap + 32 * k), a1 = *(const bf16x8*)(ap + 16 * EW + 32 * k);
            acc0 = __builtin_amdgcn_mfma_f32_16x16x32_bf16(b, a0, acc0, 0, 0, 0);
            acc1 = __builtin_amdgcn_mfma_f32_16x16x32_bf16(b, a1, acc1, 0, 0, 0);
        }
        f32x4* p0 = (f32x4*)(hs + (size_t)fr * DM + nt * 16 + 4 * fq); f32x4* p1 = (f32x4*)(hs + (size_t)(16 + fr) * DM + nt * 16 + 4 * fq);
        *p0 = *p0 + acc0; *p1 = *p1 + acc1;
    }
}

__device__ __forceinline__ void mix_a_phase(LAS unsigned char* lds, const Args& a, int layerA, int G) {
    const int tid = threadIdx.x, lane = tid & 63, wave = __builtin_amdgcn_readfirstlane(tid >> 6), fr = lane & 15, fq = lane >> 4, wr = wave >> 2, wc = wave & 3;
    unsigned char* ws = a.ws;
    const bf16* Z = (const bf16*)(ws + WS_Z); bf16* T = (bf16*)(ws + WS_T);
    const float* lnp = (const float*)(ws + WS_LNP);
    const float* lg = a.in[9] + layerA * EW; const float* lb = a.in[10] + layerA * EW;
    const float* bs = a.in[12] + layerA * 8 * 128;
    const bf16* wtril = (const bf16*)(ws + WS_WTRIL) + (size_t)layerA * 8 * 128 * 128;
    constexpr int VP = 272;
    LAS unsigned char* vT = lds;
    LAS f32x2* stat = (LAS f32x2*)(lds + 256 * VP);
    for (int u = blockIdx.x; u < 1024; u += G) {
        const int c = u >> 3, g = u & 7;
        {
            const int j = tid >> 2, q4 = tid & 3;
            const f32x4* p = (const f32x4*)(lnp + ((size_t)(128 * c + j) * 32 + q4 * 8) * 2);
            float s = 0.f, ss = 0.f;
#pragma unroll
            for (int i = 0; i < 4; ++i) { const f32x4 x = p[i]; s += x[0] + x[2]; ss += x[1] + x[3]; }
            s += __shfl_xor(s, 1); s += __shfl_xor(s, 2); ss += __shfl_xor(ss, 1); ss += __shfl_xor(ss, 2);
            const float mean = s * (1.0f / EW); const float var = fmaxf(ss * (1.0f / EW) - mean * mean, 0.f);
            if (q4 == 0) stat[j] = (f32x2){mean, __builtin_amdgcn_rsqf(var + EPS_)};
        }
        __syncthreads();
#pragma unroll
        for (int it = 0; it < 2; ++it) {
            const int item = tid + it * 512, ec = item & 31, jb = item >> 5;
            const f32x4 g0 = *(const f32x4*)(lg + 256 * g + 8 * ec), g1 = *(const f32x4*)(lg + 256 * g + 8 * ec + 4);
            const f32x4 b0 = *(const f32x4*)(lb + 256 * g + 8 * ec), b1 = *(const f32x4*)(lb + 256 * g + 8 * ec + 4);
            float vals[4][8];
#pragma unroll
            for (int rr = 0; rr < 4; ++rr) {
                const int j = 4 * jb + rr;
                const u32x4 raw = *(const u32x4*)(Z + (size_t)(128 * c + j) * N_AIN + EW + 256 * g + 8 * ec);
                const f32x2 st = stat[j];
                vals[rr][0] = (bflo(raw.x) - st.x) * st.y * g0[0] + b0[0]; vals[rr][1] = (bfhi(raw.x) - st.x) * st.y * g0[1] + b0[1];
                vals[rr][2] = (bflo(raw.y) - st.x) * st.y * g0[2] + b0[2]; vals[rr][3] = (bfhi(raw.y) - st.x) * st.y * g0[3] + b0[3];
                vals[rr][4] = (bflo(raw.z) - st.x) * st.y * g1[0] + b1[0]; vals[rr][5] = (bfhi(raw.z) - st.x) * st.y * g1[1] + b1[1];
                vals[rr][6] = (bflo(raw.w) - st.x) * st.y * g1[2] + b1[2]; vals[rr][7] = (bfhi(raw.w) - st.x) * st.y * g1[3] + b1[3];
            }
#pragma unroll
            for (int q = 0; q < 8; ++q) {
                const int e = 8 * ec + q, c32 = e & 31, slot = (e & ~31) + 16 * ((c32 >> 2) & 1) + 4 * (c32 >> 3) + (c32 & 3);
                u32x2 w; w.x = cvt_pk_bf16(vals[0][q], vals[1][q]); w.y = cvt_pk_bf16(vals[2][q], vals[3][q]);
                *(LAS u32x2*)(vT + slot * VP + (4 * jb) * 2) = w;
            }
        }
        __syncthreads();
        f32x4 acc[4][4];
#pragma unroll
        for (int m = 0; m < 4; ++m)
#pragma unroll
            for (int n = 0; n < 4; ++n) acc[m][n] = (f32x4){0.f, 0.f, 0.f, 0.f};
        const bf16* wg = wtril + (size_t)g * 128 * 128 + (size_t)(64 * wr + fr) * 128 + 8 * fq;
        const int kmax = wr ? 4 : 2;
        for (int k = 0; k < kmax; ++k) {
            bf16x8 af[4], bfv[4];
#pragma unroll
            for (int m = 0; m < 4; ++m) af[m] = *(const bf16x8*)(wg + (size_t)(16 * m) * 128 + 32 * k);
#pragma unroll
            for (int n = 0; n < 4; ++n) bfv[n] = *(const LAS bf16x8*)(vT + (64 * wc + 16 * n + fr) * VP + (32 * k + 8 * fq) * 2);
#pragma unroll
            for (int m = 0; m < 4; ++m)
#pragma unroll
                for (int n = 0; n < 4; ++n) acc[m][n] = __builtin_amdgcn_mfma_f32_16x16x32_bf16(bfv[n], af[m], acc[m][n], 0, 0, 0);
        }
#pragma unroll
        for (int m = 0; m < 4; ++m) {
            const int i = 64 * wr + 16 * m + fr; const size_t row = (size_t)128 * c + i;
            const float bsv = bs[g * 128 + i];
#pragma unroll
            for (int np = 0; np < 2; ++np) {
                const int e0 = 256 * g + 64 * wc + 32 * np + 8 * fq;
                const u32x4 uu = *(const u32x4*)(Z + row * N_AIN + e0), gg = *(const u32x4*)(Z + row * N_AIN + 2 * EW + e0);
                const f32x4 x0 = acc[m][2 * np] + bsv, x1 = acc[m][2 * np + 1] + bsv;
                u32x4 w;
                w.x = cvt_pk_bf16(bflo(uu.x) * x0[0] * silu_f(bflo(gg.x)), bfhi(uu.x) * x0[1] * silu_f(bfhi(gg.x)));
                w.y = cvt_pk_bf16(bflo(uu.y) * x0[2] * silu_f(bflo(gg.y)), bfhi(uu.y) * x0[3] * silu_f(bfhi(gg.y)));
                w.z = cvt_pk_bf16(bflo(uu.z) * x1[0] * silu_f(bflo(gg.z)), bfhi(uu.z) * x1[1] * silu_f(bfhi(gg.z)));
                w.w = cvt_pk_bf16(bflo(uu.w) * x1[2] * silu_f(bflo(gg.w)), bfhi(uu.w) * x1[3] * silu_f(bfhi(gg.w)));
                *(u32x4*)(T + row * EW + e0) = w;
            }
        }
        __syncthreads();
    }
    const int gw = blockIdx.x * NWAVES + wave;
    if (gw < MS_) {
        const int b = gw; const float* zs = (const float*)(ws + WS_ZS) + (size_t)b * N_AIN;
        const float* wsrc = a.in[11] + (size_t)layerA * 8 * 128 * 128;
        f32x4 v[8]; float s = 0.f;
#pragma unroll
        for (int i = 0; i < 8; ++i) { v[i] = *(const f32x4*)(zs + EW + 256 * i + 4 * lane); s += (v[i][0] + v[i][1]) + (v[i][2] + v[i][3]); }
        const float mean = wave_sum(s) * (1.0f / EW); float q = 0.f;
#pragma unroll
        for (int i = 0; i < 8; ++i) { v[i] = v[i] - mean; q += (v[i][0] * v[i][0] + v[i][1] * v[i][1]) + (v[i][2] * v[i][2] + v[i][3] * v[i][3]); }
        const float rstd = __builtin_amdgcn_rsqf(wave_sum(q) * (1.0f / EW) + EPS_);
        float* sv = a.out + OFF_SV + ((size_t)layerA * MS_ + b) * EW; bf16* ts = (bf16*)(ws + WS_TS) + (size_t)b * EW;
#pragma unroll
        for (int i = 0; i < 8; ++i) {
            const int e = 256 * i + 4 * lane;
            const f32x4 vn = v[i] * rstd * *(const f32x4*)(lg + e) + *(const f32x4*)(lb + e);
            *(f32x4*)(sv + e) = vn;
            const float w00 = wsrc[(size_t)i * 128 * 128], b00 = bs[i * 128];
            const f32x4 uu = *(const f32x4*)(zs + e), gg = *(const f32x4*)(zs + 2 * EW + e);
            u32x2 w; w.x = cvt_pk_bf16(uu[0] * (w00 * vn[0] + b00) * silu_f(gg[0]), uu[1] * (w00 * vn[1] + b00) * silu_f(gg[1]));
            w.y = cvt_pk_bf16(uu[2] * (w00 * vn[2] + b00) * silu_f(gg[2]), uu[3] * (w00 * vn[3] + b00) * silu_f(gg[3]));
            *(u32x2*)(ts + e) = w;
        }
    }
}

__device__ __forceinline__ void conv_b_phase(const Args& a, int G) {
    const int tid = threadIdx.x;
    unsigned char* ws = a.ws;
    const bf16* Z = (const bf16*)(ws + WS_Z); bf16* T = (bf16*)(ws + WS_T);
    const float* cw = a.in[15];
    const int NIT = (M_ / 32) * 256;
    for (int item = blockIdx.x * 512 + tid; item < NIT; item += G * 512) {
        const int cc = item & 255, rb = item >> 8, r0 = 32 * rb, c0 = 8 * cc;
        float w0[8], w1[8], w2[8];
#pragma unroll
        for (int q = 0; q < 8; ++q) { w0[q] = cw[c0 + q]; w1[q] = cw[EW + c0 + q]; w2[q] = cw[2 * EW + c0 + q]; }
        float p2[8], p1[8];
        if ((r0 & (SEQ_ - 1)) == 0) {
#pragma unroll
            for (int q = 0; q < 8; ++q) { p2[q] = 0.f; p1[q] = 0.f; }
        } else {
            const u32x4 ca = *(const u32x4*)(Z + (size_t)(r0 - 2) * N_BIN + EW + c0), xa = *(const u32x4*)(Z + (size_t)(r0 - 2) * N_BIN + 2 * EW + c0);
            const u32x4 cb = *(const u32x4*)(Z + (size_t)(r0 - 1) * N_BIN + EW + c0), xb = *(const u32x4*)(Z + (size_t)(r0 - 1) * N_BIN + 2 * EW + c0);
            p2[0] = bflo(ca.x) * bflo(xa.x); p2[1] = bfhi(ca.x) * bfhi(xa.x); p2[2] = bflo(ca.y) * bflo(xa.y); p2[3] = bfhi(ca.y) * bfhi(xa.y);
            p2[4] = bflo(ca.z) * bflo(xa.z); p2[5] = bfhi(ca.z) * bfhi(xa.z); p2[6] = bflo(ca.w) * bflo(xa.w); p2[7] = bfhi(ca.w) * bfhi(xa.w);
            p1[0] = bflo(cb.x) * bflo(xb.x); p1[1] = bfhi(cb.x) * bfhi(xb.x); p1[2] = bflo(cb.y) * bflo(xb.y); p1[3] = bfhi(cb.y) * bfhi(xb.y);
            p1[4] = bflo(cb.z) * bflo(xb.z); p1[5] = bfhi(cb.z) * bfhi(xb.z); p1[6] = bflo(cb.w) * bflo(xb.w); p1[7] = bfhi(cb.w) * bfhi(xb.w);
        }
#pragma unroll 4
        for (int rr = 0; rr < 32; ++rr) {
            const size_t row = (size_t)r0 + rr; const bf16* zr = Z + row * N_BIN + c0;
            const u32x4 bgv = *(const u32x4*)(zr), cgv = *(const u32x4*)(zr + EW), xvv = *(const u32x4*)(zr + 2 * EW), gv = *(const u32x4*)(zr + 3 * EW);
            float p0[8], bgf[8], gf[8];
            p0[0] = bflo(cgv.x) * bflo(xvv.x); p0[1] = bfhi(cgv.x) * bfhi(xvv.x); p0[2] = bflo(cgv.y) * bflo(xvv.y); p0[3] = bfhi(cgv.y) * bfhi(xvv.y);
            p0[4] = bflo(cgv.z) * bflo(xvv.z); p0[5] = bfhi(cgv.z) * bfhi(xvv.z); p0[6] = bflo(cgv.w) * bflo(xvv.w); p0[7] = bfhi(cgv.w) * bfhi(xvv.w);
            bgf[0] = bflo(bgv.x); bgf[1] = bfhi(bgv.x); bgf[2] = bflo(bgv.y); bgf[3] = bfhi(bgv.y); bgf[4] = bflo(bgv.z); bgf[5] = bfhi(bgv.z); bgf[6] = bflo(bgv.w); bgf[7] = bfhi(bgv.w);
            gf[0] = bflo(gv.x); gf[1] = bfhi(gv.x); gf[2] = bflo(gv.y); gf[3] = bfhi(gv.y); gf[4] = bflo(gv.z); gf[5] = bfhi(gv.z); gf[6] = bflo(gv.w); gf[7] = bfhi(gv.w);
            float o[8];
#pragma unroll
            for (int q = 0; q < 8; ++q) { o[q] = bgf[q] * (w0[q] * p2[q] + w1[q] * p1[q] + w2[q] * p0[q]) * silu_f(gf[q]); }
            u32x4 w; w.x = cvt_pk_bf16(o[0], o[1]); w.y = cvt_pk_bf16(o[2], o[3]); w.z = cvt_pk_bf16(o[4], o[5]); w.w = cvt_pk_bf16(o[6], o[7]);
            *(u32x4*)(T + row * EW + c0) = w;
            const int t = (int)(row & (SEQ_ - 1));
            if (t >= SEQ_ - 2) {
                float* sp = a.out + OFF_SCP + ((size_t)(row >> 13) * 2 + (t - (SEQ_ - 2))) * EW + c0;
                *(f32x4*)sp = (f32x4){p0[0], p0[1], p0[2], p0[3]}; *(f32x4*)(sp + 4) = (f32x4){p0[4], p0[5], p0[6], p0[7]};
            }
#pragma unroll
            for (int q = 0; q < 8; ++q) { p2[q] = p1[q]; p1[q] = p0[q]; }
        }
    }
    for (int item = blockIdx.x * 512 + tid; item < MS_ * EW; item += G * 512) {
        const int b = item >> 11, c = item & (EW - 1);
        const float* zs = (const float*)(ws + WS_ZS) + (size_t)b * N_BIN;
        const float* st = a.in[2] + (size_t)b * 2 * EW;
        const float pr0 = st[c], pr1 = st[EW + c], pn = zs[EW + c] * zs[2 * EW + c];
        const float conv = cw[c] * pr0 + cw[EW + c] * pr1 + cw[2 * EW + c] * pn;
        const float o = zs[c] * conv * silu_f(zs[3 * EW + c]);
        ((bf16*)(ws + WS_TS))[(size_t)b * EW + c] = (bf16)(cvt_pk_bf16(o, 0.f) & 0xffffu);
        float* so = a.out + OFF_SCS + (size_t)b * 2 * EW; so[c] = pr1; so[EW + c] = pn;
    }
}

namespace att {
#define KSWZ(row, colB) ((row) * 256 + ((colB) ^ (((row) & 7) << 4)))
__device__ __forceinline__ int crow(int r, int hi) { return (r & 3) + 8 * (r >> 2) + 4 * hi; }
__device__ __forceinline__ int v_st(int k, int c) { const int kk = (k & ~0xC) | ((k & 4) << 1) | ((k & 8) >> 1); return ((kk >> 3) * 4 + (c >> 5)) * 512 + ((kk & 7) * 32 + (c & 31)) * 2; }
__device__ __forceinline__ int v_rd_base(int lane) { return ((lane & 3) << 3) | (((lane >> 2) & 3) << 6) | (((lane >> 4) & 1) << 5) | (((lane >> 5) & 1) << 8); }
constexpr int v_rd_off(int d0, int ks, int half) { return d0 * 512 + ks * 4096 + half * 2048; }
template <int OFF> __device__ __forceinline__ s16x4 tr_read(int vb) { s16x4 r; asm volatile("ds_read_b64_tr_b16 %0, %1 offset:%2" : "=&v"(r) : "v"(vb), "i"(OFF) : "memory"); return r; }
constexpr int SHM_T = 16384;
constexpr int OST_OFF = 4 * SHM_T, OST_PITCH = 272, OST_WAVE = 32 * OST_PITCH;

__device__ __forceinline__ void qkt(f32x16& p0, f32x16& p1, const LAS unsigned char* Ks, const bf16x8 (&qr)[8], int r32, int hi) {
    p0 = (f32x16){}; p1 = (f32x16){};
#pragma unroll
    for (int d0 = 0; d0 < 8; ++d0) { const int cb = (d0 * 16 + hi * 8) * 2;
        const bf16x8 b0 = *(const LAS bf16x8*)(Ks + KSWZ(r32, cb));
        const bf16x8 b1 = *(const LAS bf16x8*)(Ks + KSWZ(32 + r32, cb));
        p0 = __builtin_amdgcn_mfma_f32_32x32x16_bf16(b0, qr[d0], p0, 0, 0, 0);
        p1 = __builtin_amdgcn_mfma_f32_32x32x16_bf16(b1, qr[d0], p1, 0, 0, 0); }
}
template <int D0> __device__ __forceinline__ void pv_one(f32x16& od, int vb, bf16x8 pa0, bf16x8 pa1, bf16x8 pa2, bf16x8 pa3) {
    const s16x4 l0 = tr_read<v_rd_off(D0, 0, 0)>(vb), h0 = tr_read<v_rd_off(D0, 0, 1)>(vb), l1 = tr_read<v_rd_off(D0, 1, 0)>(vb), h1 = tr_read<v_rd_off(D0, 1, 1)>(vb);
    const s16x4 l2 = tr_read<v_rd_off(D0, 2, 0)>(vb), h2 = tr_read<v_rd_off(D0, 2, 1)>(vb), l3 = tr_read<v_rd_off(D0, 3, 0)>(vb), h3 = tr_read<v_rd_off(D0, 3, 1)>(vb);
    asm volatile("s_waitcnt lgkmcnt(0)" ::: "memory"); __builtin_amdgcn_sched_barrier(0);
#define PKV(L, H) (bf16x8){L[0], L[1], L[2], L[3], H[0], H[1], H[2], H[3]}
    od = __builtin_amdgcn_mfma_f32_32x32x16_bf16(PKV(l0, h0), pa0, od, 0, 0, 0);
    od = __builtin_amdgcn_mfma_f32_32x32x16_bf16(PKV(l1, h1), pa1, od, 0, 0, 0);
    od = __builtin_amdgcn_mfma_f32_32x32x16_bf16(PKV(l2, h2), pa2, od, 0, 0, 0);
    od = __builtin_amdgcn_mfma_f32_32x32x16_bf16(PKV(l3, h3), pa3, od, 0, 0, 0);
#undef PKV
}
struct UnitInfo { int g, b, h, qbg, first, dsh; };
__device__ __forceinline__ UnitInfo decode(int U) { UnitInfo u; u.qbg = U & 31; u.h = (U >> 5) & 15; u.b = (U >> 9) & 1; u.g = U >> 10; u.dsh = 2 * u.g; u.first = ((u.qbg & ((32 >> u.dsh) - 1)) == 0) ? 1 : 0; return u; }
}

__device__ __forceinline__ void attn_c_phase(LAS unsigned char* lds, const Args& a, int G) {
    using namespace att;
    const int tid = threadIdx.x, lane = tid & 63, wave = __builtin_amdgcn_readfirstlane(tid >> 6), r32 = lane & 31, hi = lane >> 5;
    unsigned char* ws = a.ws;
    const bf16* QKV = (const bf16*)(ws + WS_Z); bf16* OG = (bf16*)(ws + WS_OG); float* LSE = (float*)(ws + WS_LSE);
    LAS unsigned char* V_lds = lds; LAS unsigned char* K_lds = lds + 2 * SHM_T;
    LAS unsigned char* ost = lds + OST_OFF + wave * OST_WAVE;
    constexpr float C = ATT_SCALE * LOG2E;
    const int sr = tid >> 4, sc = (tid & 15) * 8;
    const int vst0 = v_st(sr, sc), vst1 = v_st(32 + sr, sc), kst0 = KSWZ(sr, sc * 2), kst1 = KSWZ(32 + sr, sc * 2);
    const int vb0 = (int)(uintptr_t)V_lds + v_rd_base(lane);
    constexpr int NU = 3 * 2 * 16 * 32;
    const bool contig = (NU % G) == 0; const int upb = contig ? NU / G : (NU + G - 1) / G;
#define UNIT_ID(i) (contig ? (int)blockIdx.x * upb + (i) : (int)blockIdx.x + G * (i))
#define UNIT_OK(i) ((i) < upb && UNIT_ID(i) < NU)
    int lu = 0, lj = 0;
    if (UNIT_OK(0)) lj = decode(UNIT_ID(0)).first ? 2 : 0;
    bf16x8 ra_k0 = {}, ra_k1 = {}, ra_v0 = {}, ra_v1 = {}, rb_k0 = {}, rb_k1 = {}, rb_v0 = {}, rb_v1 = {};
#define ISSUE(K0, K1, V0, V1) do { if (UNIT_OK(lu)) { const UnitInfo _u = decode(UNIT_ID(lu)); \
        const size_t _hb = (((size_t)(_u.g) * 2 + _u.b) * 16 + _u.h) * SEQ_; const long _sp = (long)256 * _u.qbg - 128 + 64 * lj; \
        const bf16* _kp = QKV + ((size_t)(1 * 3) * 2 * 16 * SEQ_ + _hb + _sp) * 128; const bf16* _vp = QKV + ((size_t)(2 * 3) * 2 * 16 * SEQ_ + _hb + _sp) * 128; \
        K0 = *(const bf16x8*)(_kp + (size_t)sr * 128 + sc); K1 = *(const bf16x8*)(_kp + (size_t)(32 + sr) * 128 + sc); \
        V0 = *(const bf16x8*)(_vp + (size_t)sr * 128 + sc); V1 = *(const bf16x8*)(_vp + (size_t)(32 + sr) * 128 + sc); \
        lj += 1; if (lj == 6) { lu += 1; lj = 0; if (UNIT_OK(lu)) lj = decode(UNIT_ID(lu)).first ? 2 : 0; } } } while (0)
#define SWRITE(buf, K0, K1, V0, V1) do { *(LAS bf16x8*)(V_lds + (buf) * SHM_T + vst0) = V0; *(LAS bf16x8*)(V_lds + (buf) * SHM_T + vst1) = V1; \
        *(LAS bf16x8*)(K_lds + (buf) * SHM_T + kst0) = K0; *(LAS bf16x8*)(K_lds + (buf) * SHM_T + kst1) = K1; } while (0)
    if (UNIT_OK(0)) {
        ISSUE(ra_k0, ra_k1, ra_v0, ra_v1); ISSUE(rb_k0, rb_k1, rb_v0, rb_v1);
        SWRITE(0, ra_k0, ra_k1, ra_v0, ra_v1);
        bf16x8 qr[8];
        {   const UnitInfo u0 = decode(UNIT_ID(0));
            const bf16* qp = QKV + (((((size_t)u0.g) * 2 + u0.b) * 16 + u0.h) * SEQ_ + 256 * u0.qbg + 32 * wave + r32) * 128 + hi * 8;
#pragma unroll
            for (int d0 = 0; d0 < 8; ++d0) qr[d0] = *(const bf16x8*)(qp + d0 * 16);
        }
        __syncthreads();
        for (int ui = 0; UNIT_OK(ui); ++ui) {
            const UnitInfo u = decode(UNIT_ID(ui));
            const int j0 = u.first ? 2 : 0;
            const int jlo = (wave >> 1) > j0 ? (wave >> 1) : j0, jhi = (wave >> 1) + 2;
            float m_reg = -1e30f, l_reg = 0.f; f32x16 o[4] = {};
            for (int j = j0; j < 6; j += 2) {
#pragma unroll
                for (int par = 0; par < 2; ++par) {
                    const int jj = j + par;
                    if (par == 0) ISSUE(ra_k0, ra_k1, ra_v0, ra_v1); else ISSUE(rb_k0, rb_k1, rb_v0, rb_v1);
                    if (jj >= jlo && jj <= jhi) {
                        f32x16 p0, p1;
                        qkt(p0, p1, K_lds + par * SHM_T, qr, r32, hi);
                        if (jj == jhi && UNIT_OK(ui + 1)) {
                            const UnitInfo un = decode(UNIT_ID(ui + 1));
                            const bf16* qp = QKV + (((((size_t)un.g) * 2 + un.b) * 16 + un.h) * SEQ_ + 256 * un.qbg + 32 * wave + r32) * 128 + hi * 8;
#pragma unroll
                            for (int d0 = 0; d0 < 8; ++d0) qr[d0] = *(const bf16x8*)(qp + d0 * 16);
                        }
                        const int base = 64 * jj - 32 * wave - r32 + 4 * hi;
#pragma unroll
                        for (int r = 0; r < 16; ++r) { const int kx = base + (r & 3) + 8 * (r >> 2);
                            p0[r] = ((unsigned)kx <= 128u) ? p0[r] : -INFINITY; p1[r] = ((unsigned)(kx + 32) <= 128u) ? p1[r] : -INFINITY; }
                        float pmax = p0[0];
#pragma unroll
                        for (int r = 1; r < 16; ++r) pmax = fmaxf(pmax, p0[r]);
#pragma unroll
                        for (int r = 0; r < 16; ++r) pmax = fmaxf(pmax, p1[r]);
                        { auto rr = __builtin_amdgcn_permlane32_swap(__float_as_uint(pmax), __float_as_uint(pmax), false, false); pmax = fmaxf(__uint_as_float(rr[0]), __uint_as_float(rr[1])); }
                        const float mn = fmaxf(m_reg, pmax); const float alpha = __builtin_amdgcn_exp2f((m_reg - mn) * C); m_reg = mn;
                        const float mnC = -mn * C;
#pragma unroll
                        for (int r = 0; r < 16; ++r) { p0[r] = __builtin_amdgcn_exp2f(fmaf(p0[r], C, mnC)); p1[r] = __builtin_amdgcn_exp2f(fmaf(p1[r], C, mnC)); }
                        float ps = 0.f;
#pragma unroll
                        for (int r = 0; r < 16; ++r) ps += p0[r] + p1[r];
                        { auto rr = __builtin_amdgcn_permlane32_swap(__float_as_uint(ps), __float_as_uint(ps), false, false); ps = __uint_as_float(rr[0]) + __uint_as_float(rr[1]); }
                        l_reg = l_reg * alpha + ps;
#pragma unroll
                        for (int d = 0; d < 4; ++d)
#pragma unroll
                            for (int r = 0; r < 16; ++r) o[d][r] *= alpha;
                        bf16x8 pa0, pa1, pa2, pa3;
#define PK4(P, BASE, OUT) do { unsigned a0 = cvt_pk_bf16(P[BASE + 0], P[BASE + 1]), a1 = cvt_pk_bf16(P[BASE + 2], P[BASE + 3]); \
    unsigned b0 = cvt_pk_bf16(P[BASE + 4], P[BASE + 5]), b1 = cvt_pk_bf16(P[BASE + 6], P[BASE + 7]); \
    auto r0 = __builtin_amdgcn_permlane32_swap(a0, b0, false, false); auto r1 = __builtin_amdgcn_permlane32_swap(a1, b1, false, false); \
    u32x4 w = {r0[0], r1[0], r0[1], r1[1]}; OUT = __builtin_bit_cast(bf16x8, w); } while (0)
                        PK4(p0, 0, pa0); PK4(p0, 8, pa1); PK4(p1, 0, pa2); PK4(p1, 8, pa3);
#undef PK4
                        const int vb = vb0 + par * SHM_T;
                        pv_one<0>(o[0], vb, pa0, pa1, pa2, pa3); pv_one<1>(o[1], vb, pa0, pa1, pa2, pa3); pv_one<2>(o[2], vb, pa0, pa1, pa2, pa3); pv_one<3>(o[3], vb, pa0, pa1, pa2, pa3);
                    }
                    if (par == 0) SWRITE(1, rb_k0, rb_k1, rb_v0, rb_v1); else SWRITE(0, ra_k0, ra_k1, ra_v0, ra_v1);
                    __syncthreads();
                }
            }
            const float inv = __builtin_amdgcn_rcpf(l_reg);
#pragma unroll
            for (int d0 = 0; d0 < 4; ++d0)
#pragma unroll
                for (int i = 0; i < 4; ++i) {
                    u32x2 w; w.x = cvt_pk_bf16(o[d0][4 * i] * inv, o[d0][4 * i + 1] * inv); w.y = cvt_pk_bf16(o[d0][4 * i + 2] * inv, o[d0][4 * i + 3] * inv);
                    *(LAS u32x2*)(ost + r32 * OST_PITCH + (32 * d0 + 8 * i + 4 * hi) * 2) = w;
                }
            const int lsh = 13 - u.dsh, lmask = (1 << lsh) - 1;
            if (hi == 0) { const int sp = 256 * u.qbg + 32 * wave + r32; const int t = (sp >> lsh) + ((sp & lmask) << u.dsh);
                LSE[((size_t)u.g * M_ + (size_t)u.b * SEQ_ + t) * 16 + u.h] = m_reg * ATT_SCALE + __logf(l_reg); }
            LDS_WAIT(); asm volatile("" ::: "memory");
#pragma unroll
            for (int i = 0; i < 8; ++i) {
                const int ch = lane + 64 * i, row = ch >> 4, c16 = ch & 15;
                const u32x4 w = *(const LAS u32x4*)(ost + row * OST_PITCH + c16 * 16);
                const int sp = 256 * u.qbg + 32 * wave + row; const int t = (sp >> lsh) + ((sp & lmask) << u.dsh);
                *(u32x4*)(OG + ((size_t)u.g * M_ + (size_t)u.b * SEQ_ + t) * EW + u.h * 128 + c16 * 8) = w;
            }
            LDS_WAIT(); asm volatile("" ::: "memory");
        }
    }
    __syncthreads();
#undef ISSUE
#undef SWRITE
#undef UNIT_ID
#undef UNIT_OK
}

__device__ __forceinline__ void attn_c_sample(LAS unsigned char* lds, const Args& a, int G) {
    const int tid = threadIdx.x, lane = tid & 63, wave = __builtin_amdgcn_readfirstlane(tid >> 6);
    unsigned char* ws = a.ws;
    const float* rope = (const float*)(ws + WS_ROPE) + (size_t)SEQ_ * 16 * 2;
    constexpr int TSK = 768 * 4;
    for (int pp = blockIdx.x; pp < 256; pp += G) {
        __syncthreads();
        if (wave < 6) {
            const int pr = wave / 3, g = wave - 3 * pr, P = 2 * pp + pr, b = P >> 4, h = P & 15;
            LAS float* sm = (LAS float*)(lds + wave * TSK);
            LAS float* qs = sm, *ks = sm + 128, *vs = sm + 256, *psm = sm + 384, *os = sm + 512, *misc = sm + 640;
            const float* zs = (const float*)(ws + WS_ZS) + (size_t)b * N_CIN;
            const int dil = 1 << (2 * g), win = 128 << (2 * g);
            const float* cache = a.in[3 + g] + (size_t)b * win * 4096;
            float* kvs = a.out + (g == 0 ? OFF_KV128S : (g == 1 ? OFF_KV512S : OFF_KV2048S)) + (size_t)b * 4096 + h * 128;
            {
                const int cq = g * EW + h * 128 + 2 * lane;
                const f32x2 qv = *(const f32x2*)(zs + cq), kv = *(const f32x2*)(zs + 3 * EW + cq), vv = *(const f32x2*)(zs + 6 * EW + cq);
                if (lane < 16) { const float c = rope[2 * lane], s = rope[2 * lane + 1];
                    const float q1 = qv.x * c - qv.y * s, q2 = qv.y * c + qv.x * s, k1 = kv.x * c - kv.y * s, k2 = kv.y * c + kv.x * s;
                    qs[lane] = q1; qs[lane + 16] = q2; ks[lane] = k1; ks[lane + 16] = k2; kvs[lane] = k1; kvs[lane + 16] = k2; }
                else { qs[2 * lane] = qv.x; qs[2 * lane + 1] = qv.y; ks[2 * lane] = kv.x; ks[2 * lane + 1] = kv.y; kvs[2 * lane] = kv.x; kvs[2 * lane + 1] = kv.y; }
                vs[2 * lane] = vv.x; vs[2 * lane + 1] = vv.y; kvs[2048 + 2 * lane] = vv.x; kvs[2048 + 2 * lane + 1] = vv.y;
            }
            LDS_WAIT(); asm volatile("" ::: "memory");
            const float* k0p = cache + ((size_t)(dil * lane) * 2) * 2048 + h * 128; const float* k1p = cache + ((size_t)(dil * (lane + 64)) * 2) * 2048 + h * 128;
            float s0 = 0.f, s1 = 0.f;
#pragma unroll 8
            for (int dc = 0; dc < 32; ++dc) { const f32x4 q4 = *(const LAS f32x4*)(qs + 4 * dc); const f32x4 ka = *(const f32x4*)(k0p + 4 * dc), kb = *(const f32x4*)(k1p + 4 * dc);
                s0 += (q4[0] * ka[0] + q4[1] * ka[1]) + (q4[2] * ka[2] + q4[3] * ka[3]); s1 += (q4[0] * kb[0] + q4[1] * kb[1]) + (q4[2] * kb[2] + q4[3] * kb[3]); }
            float sn = qs[2 * lane] * ks[2 * lane] + qs[2 * lane + 1] * ks[2 * lane + 1]; sn = wave_sum(sn);
            s0 *= ATT_SCALE; s1 *= ATT_SCALE; sn *= ATT_SCALE;
            const float mx = fmaxf(wave_max(fmaxf(s0, s1)), sn);
            const float e0 = __expf(s0 - mx), e1 = __expf(s1 - mx), en = __expf(sn - mx);
            const float den = wave_sum(e0 + e1) + en;
            psm[lane] = e0; psm[lane + 64] = e1;
            LDS_WAIT(); asm volatile("" ::: "memory");
            f32x2 acc = (f32x2){en * vs[2 * lane], en * vs[2 * lane + 1]};
            const float* vp = cache + 2048 + h * 128 + 2 * lane;
#pragma unroll 16
            for (int i = 0; i < 128; ++i) { const f32x2 vv = *(const f32x2*)(vp + (size_t)(dil * i) * 4096); const float pi = psm[i]; acc.x += pi * vv.x; acc.y += pi * vv.y; }
            const float rden = 1.0f / den;
            os[2 * lane] = acc.x * rden; os[2 * lane + 1] = acc.y * rden;
            if (lane == 0) misc[0] = mx + __logf(den);
        }
        __syncthreads();
        if (wave < 2) {
            const int P = 2 * pp + wave, b = P >> 4, h = P & 15;
            LAS float* s0 = (LAS float*)(lds + (3 * wave + 0) * TSK), *s1 = (LAS float*)(lds + (3 * wave + 1) * TSK), *s2 = (LAS float*)(lds + (3 * wave + 2) * TSK);
            const float l0 = s0[640], l1 = s1[640], l2 = s2[640]; const float mx = fmaxf(l0, fmaxf(l1, l2));
            const float w0 = __expf(l0 - mx), w1 = __expf(l1 - mx), w2 = __expf(l2 - mx); const float rs = 1.0f / (w0 + w1 + w2);
            const float* zs = (const float*)(ws + WS_ZS) + (size_t)b * N_CIN + 9 * EW + h * 128;
            const float oa = (w0 * s0[512 + 2 * lane] + w1 * s1[512 + 2 * lane] + w2 * s2[512 + 2 * lane]) * rs;
            const float ob = (w0 * s0[512 + 2 * lane + 1] + w1 * s1[512 + 2 * lane + 1] + w2 * s2[512 + 2 * lane + 1]) * rs;
            ((unsigned*)(ws + WS_TS))[((size_t)b * EW + h * 128) / 2 + lane] = cvt_pk_bf16(oa * silu_f(zs[2 * lane]), ob * silu_f(zs[2 * lane + 1]));
        }
    }
    __syncthreads();
}

__device__ __forceinline__ void combine_c_phase(const Args& a, int G) {
    unsigned char* ws = a.ws;
    const bf16* OG = (const bf16*)(ws + WS_OG); const float* LSE = (const float*)(ws + WS_LSE); const bf16* GATE = (const bf16*)(ws + WS_GATE); bf16* T = (bf16*)(ws + WS_T);
    const int NIT = M_ * 256;
    for (int item = blockIdx.x * 512 + threadIdx.x; item < NIT; item += G * 512) {
        const int row = item >> 8, ch = item & 255, h = ch >> 4;
        const float l0 = LSE[((size_t)0 * M_ + row) * 16 + h], l1 = LSE[((size_t)1 * M_ + row) * 16 + h], l2 = LSE[((size_t)2 * M_ + row) * 16 + h];
        const float mx = fmaxf(l0, fmaxf(l1, l2)); float w0 = __expf(l0 - mx), w1 = __expf(l1 - mx), w2 = __expf(l2 - mx); const float rs = 1.0f / (w0 + w1 + w2); w0 *= rs; w1 *= rs; w2 *= rs;
        const size_t off = (size_t)row * EW + ch * 8;
        const u32x4 a0 = *(const u32x4*)(OG + off), a1 = *(const u32x4*)(OG + (size_t)M_ * EW + off), a2 = *(const u32x4*)(OG + (size_t)2 * M_ * EW + off), gg = *(const u32x4*)(GATE + off);
        u32x4 w;
        w.x = cvt_pk_bf16((w0 * bflo(a0.x) + w1 * bflo(a1.x) + w2 * bflo(a2.x)) * silu_f(bflo(gg.x)), (w0 * bfhi(a0.x) + w1 * bfhi(a1.x) + w2 * bfhi(a2.x)) * silu_f(bfhi(gg.x)));
        w.y = cvt_pk_bf16((w0 * bflo(a0.y) + w1 * bflo(a1.y) + w2 * bflo(a2.y)) * silu_f(bflo(gg.y)), (w0 * bfhi(a0.y) + w1 * bfhi(a1.y) + w2 * bfhi(a2.y)) * silu_f(bfhi(gg.y)));
        w.z = cvt_pk_bf16((w0 * bflo(a0.z) + w1 * bflo(a1.z) + w2 * bflo(a2.z)) * silu_f(bflo(gg.z)), (w0 * bfhi(a0.z) + w1 * bfhi(a1.z) + w2 * bfhi(a2.z)) * silu_f(bfhi(gg.z)));
        w.w = cvt_pk_bf16((w0 * bflo(a0.w) + w1 * bflo(a1.w) + w2 * bflo(a2.w)) * silu_f(bflo(gg.w)), (w0 * bfhi(a0.w) + w1 * bfhi(a1.w) + w2 * bfhi(a2.w)) * silu_f(bfhi(gg.w)));
        *(u32x4*)(T + off) = w;
    }
}

__device__ __forceinline__ void final_phase(const Args& a, int G) {
    const int tid = threadIdx.x, lane = tid & 63, wave = tid >> 6;
    unsigned char* ws = a.ws;
    const float* hp = (const float*)(ws + WS_HP); const float* ssq = (const float*)(ws + WS_SSQP) + (size_t)4 * M_ * 16; const float* fw = a.in[7];
    const int gw = blockIdx.x * NWAVES + wave, NGW = G * NWAVES;
    f32x4 wv[4];
#pragma unroll
    for (int j = 0; j < 4; ++j) wv[j] = *((const f32x4*)fw + lane + 64 * j);
    for (int m = gw; m < M_ + MS_; m += NGW) {
        const bool smp = m >= M_;
        const f32x4* xr = (const f32x4*)(smp ? (const float*)(ws + WS_HS) + (size_t)(m - M_) * DM : hp + (size_t)m * DM) + lane;
        f32x4 v[4]; float s = 0.f;
#pragma unroll
        for (int j = 0; j < 4; ++j) { v[j] = xr[64 * j]; s += (v[j][0] * v[j][0] + v[j][1] * v[j][1]) + (v[j][2] * v[j][2] + v[j][3] * v[j][3]); }
        if (smp) s = wave_sum(s);
        else { float p = (lane < 16) ? ssq[(size_t)m * 16 + lane] : 0.f; s = wave_sum(p); }
        const float rstd = __builtin_amdgcn_rsqf(s * (1.0f / DM) + EPS_);
        f32x4* o = (f32x4*)(a.out + (smp ? OFF_YS + (size_t)(m - M_) * DM : OFF_Y + (size_t)m * DM)) + lane;
#pragma unroll
        for (int j = 0; j < 4; ++j) o[64 * j] = v[j] * rstd * wv[j];
    }
}

__global__ void __launch_bounds__(NWAVES * 64, 2) hybrid_fwd(Args args) {
    extern __shared__ __attribute__((aligned(16))) unsigned char lds_raw[];
    LAS unsigned char* lds = (LAS unsigned char*)lds_raw;
    volatile LAS unsigned* MISC = (volatile LAS unsigned*)(lds + MISC_OFF);
    const int tid = threadIdx.x;
    const int G = gridDim.x;
    unsigned char* ws = args.ws;
    unsigned* ctl = (unsigned*)(ws + WS_CTL);
    if (tid < 32) MISC[tid] = 0u;
    __syncthreads();
    XcdBarrier bar; bar.bar = ctl + CW_BAR; bar.x = 0; bar.st = nullptr;
    if (!MK_SPLIT) bar = xcd_barrier_post(ctl + CW_BAR, MISC + 8);
    const int lo = args.ph_lo, hi = args.ph_hi;
#define IN(k) (lo <= (k) && (k) < hi)
#define SEAM(k) do { if (IN(k) && IN((k) + 1)) xcd_barrier(bar); } while (0)
    float* ssqp = (float*)(ws + WS_SSQP);
    bf16* HB = (bf16*)(ws + WS_HB); float* HP = (float*)(ws + WS_HP); bf16* T = (bf16*)(ws + WS_T); bf16* Z = (bf16*)(ws + WS_Z);
    float* HS = (float*)(ws + WS_HS); float* ZS = (float*)(ws + WS_ZS); bf16* TS = (bf16*)(ws + WS_TS);

    if (IN(0)) { p0_prologue(args, lds, G); } SEAM(0);

    if (IN(1)) {
        pg8::Gemm g{HB, (const bf16*)(ws + WS_WA_IN0), M_, N_AIN, DM}; pg8::StaticOrder S; S.init(M_, N_AIN, G, (int)blockIdx.x);
        pg8::EpiIn E{Z, N_AIN, ssqp, (float*)(ws + WS_LNP), 8, 16};
        pg8::gemm_phase<pg8::EpiIn, pg8::StaticOrder, true, true>(lds, g, S, E);
        sample_in_gemm(lds, HS, (const bf16*)(ws + WS_WA_IN0), N_AIN, ZS, G);
    } SEAM(1);
    if (IN(2)) { mix_a_phase(lds, args, 0, G); } SEAM(2);
    if (IN(3)) {
        pg8::Gemm g{T, (const bf16*)(ws + WS_WA_OUT0), M_, DM, EW}; pg8::StaticOrder S; S.init(M_, DM, G, (int)blockIdx.x);
        pg8::EpiOut E{args.in[0], HP, HB, ssqp + (size_t)1 * M_ * 16};
        pg8::gemm_phase<pg8::EpiOut, pg8::StaticOrder, true, true>(lds, g, S, E);
        sample_out_gemm(TS, (const bf16*)(ws + WS_WA_OUT0), HS, G);
    } SEAM(3);
    if (IN(4)) {
        pg8::Gemm g{HB, (const bf16*)(ws + WS_WB_IN), M_, N_BIN, DM}; pg8::StaticOrder S; S.init(M_, N_BIN, G, (int)blockIdx.x);
        pg8::EpiIn E{Z, N_BIN, ssqp + (size_t)1 * M_ * 16, nullptr, 1 << 30, 1 << 30};
        pg8::gemm_phase<pg8::EpiIn, pg8::StaticOrder, true, true>(lds, g, S, E);
        sample_in_gemm(lds, HS, (const bf16*)(ws + WS_WB_IN), N_BIN, ZS, G);
    } SEAM(4);
    if (IN(5)) { conv_b_phase(args, G); } SEAM(5);
    if (IN(6)) {
        pg8::Gemm g{T, (const bf16*)(ws + WS_WB_OUT), M_, DM, EW}; pg8::StaticOrder S; S.init(M_, DM, G, (int)blockIdx.x);
        pg8::EpiOut E{HP, HP, HB, ssqp + (size_t)2 * M_ * 16};
        pg8::gemm_phase<pg8::EpiOut, pg8::StaticOrder, true, true>(lds, g, S, E);
        sample_out_gemm(TS, (const bf16*)(ws + WS_WB_OUT), HS, G);
    } SEAM(6);
    if (IN(7)) {
        pg8::Gemm g{HB, (const bf16*)(ws + WS_WC_IN), M_, N_CIN, DM}; pg8::StaticOrder S; S.init(M_, N_CIN, G, (int)blockIdx.x);
        pg8::EpiCin E{Z, (bf16*)(ws + WS_GATE), ssqp + (size_t)2 * M_ * 16, (const float*)(ws + WS_ROPE), args.out};
        pg8::gemm_phase<pg8::EpiCin, pg8::StaticOrder, true, true>(lds, g, S, E);
        sample_in_gemm(lds, HS, (const bf16*)(ws + WS_WC_IN), N_CIN, ZS, G);
    } SEAM(7);
    if (IN(8)) { attn_c_phase(lds, args, G); attn_c_sample(lds, args, G); } SEAM(8);
    if (IN(9)) { combine_c_phase(args, G); } SEAM(9);
    if (IN(10)) {
        pg8::Gemm g{T, (const bf16*)(ws + WS_WC_OUT), M_, DM, EW}; pg8::StaticOrder S; S.init(M_, DM, G, (int)blockIdx.x);
        pg8::EpiOut E{HP, HP, HB, ssqp + (size_t)3 * M_ * 16};
        pg8::gemm_phase<pg8::EpiOut, pg8::StaticOrder, true, true>(lds, g, S, E);
        sample_out_gemm(TS, (const bf16*)(ws + WS_WC_OUT), HS, G);
    } SEAM(10);
    if (IN(11)) {
        pg8::Gemm g{HB, (const bf16*)(ws + WS_WA_IN1), M_, N_AIN, DM}; pg8::StaticOrder S; S.init(M_, N_AIN, G, (int)blockIdx.x);
        pg8::EpiIn E{Z, N_AIN, ssqp + (size_t)3 * M_ * 16, (float*)(ws + WS_LNP), 8, 16};
        pg8::gemm_phase<pg8::EpiIn, pg8::StaticOrder, true, true>(lds, g, S, E);
        sample_in_gemm(lds, HS, (const bf16*)(ws + WS_WA_IN1), N_AIN, ZS, G);
    } SEAM(11);
    if (IN(12)) { mix_a_phase(lds, args, 1, G); } SEAM(12);
    if (IN(13)) {
        pg8::Gemm g{T, (const bf16*)(ws + WS_WA_OUT1), M_, DM, EW}; pg8::StaticOrder S; S.init(M_, DM, G, (int)blockIdx.x);
        pg8::EpiOut E{HP, HP, HB, ssqp + (size_t)4 * M_ * 16};
        pg8::gemm_phase<pg8::EpiOut, pg8::StaticOrder, true, true>(lds, g, S, E);
        sample_out_gemm(TS, (const bf16*)(ws + WS_WA_OUT1), HS, G);
    } SEAM(13);
    if (IN(14)) { final_phase(args, G); }
#undef IN
#undef SEAM
}

extern "C" void kernel_launch(void* const* d_in, const int* in_sizes, int n_in, void* d_out, int out_size, void* d_ws, size_t ws_size, hipStream_t stream) {
    static int grid = 0;
    if (grid == 0) {
        if (n_in != 19 || (size_t)out_size != OUT_TOTAL || ws_size < WS_END) { fprintf(stderr, "kernel_launch: unexpected shapes: n_in %d out %d ws %zu\n", n_in, out_size, ws_size); grid = -1; return; }
        int dev = 0, cus = 0, per_cu = 0;
        if (hipGetDevice(&dev) != hipSuccess || hipDeviceGetAttribute(&cus, hipDeviceAttributeMultiprocessorCount, dev) != hipSuccess) { grid = -1; return; }
        if (hipFuncSetAttribute((const void*)hybrid_fwd, hipFuncAttributeMaxDynamicSharedMemorySize, LDS_BYTES) != hipSuccess) { fprintf(stderr, "kernel_launch: hipFuncSetAttribute failed\n"); grid = -1; return; }
        if (hipOccupancyMaxActiveBlocksPerMultiprocessor(&per_cu, (const void*)hybrid_fwd, NWAVES * 64, LDS_BYTES) != hipSuccess || per_cu < 1) { fprintf(stderr, "kernel_launch: occupancy query says %d\n", per_cu); }
        (void)hipGetLastError();
        grid = cus;
    }
    if (grid < 0) return;
    (void)hipMemsetAsync((char*)d_ws + WS_CTL, 0, CTL_ZERO_BYTES, stream);
    Args a{};
    for (int i = 0; i < 19; ++i) a.in[i] = (const float*)d_in[i];
    a.out = (float*)d_out; a.ws = (unsigned char*)d_ws;
#if MK_SPLIT
    for (int k = 0; k < NPH; ++k) { a.ph_lo = k; a.ph_hi = k + 1; hipLaunchKernelGGL(hybrid_fwd, dim3(grid), dim3(NWAVES * 64), LDS_BYTES, stream, a); }
#else
    a.ph_lo = 0; a.ph_hi = NPH;
    hipLaunchKernelGGL(hybrid_fwd, dim3(grid), dim3(NWAVES * 64), LDS_BYTES, stream, a);
#endif
    const hipError_t le = hipPeekAtLastError();
    if (le != hipSuccess) fprintf(stderr, "kernel_launch: launch failed: %s\n", hipGetErrorName(le));
}
```

```cpp
#include <hip/hip_runtime.h>
#include <cstdio>
#include <cstdint>

#ifndef MK_SPLIT
#define MK_SPLIT 0
#endif

#ifndef DUPMASK
#define DUPMASK 0
#endif
#define LAS __attribute__((address_space(3)))
#define GAS __attribute__((address_space(1)))
typedef unsigned short bf16;
typedef short bf16x8 __attribute__((ext_vector_type(8)));
typedef short s16x4 __attribute__((ext_vector_type(4)));
typedef float f32x2 __attribute__((ext_vector_type(2)));
typedef float f32x4 __attribute__((ext_vector_type(4)));
typedef float f32x16 __attribute__((ext_vector_type(16)));
typedef unsigned u32x2 __attribute__((ext_vector_type(2)));
typedef unsigned u32x4 __attribute__((ext_vector_type(4)));

constexpr int M_ = 16384, MS_ = 32, DM = 1024, EW = 2048, SEQ_ = 8192;
constexpr int N_AIN = 3 * EW, N_BIN = 4 * EW, N_CIN = 10 * EW;
constexpr float EPS_ = 1e-6f;
constexpr float LOG2E = 1.4426950408889634f;
constexpr float ATT_SCALE = 0.08838834764831845f;

constexpr size_t OFF_Y = 0, OFF_YS = 16777216, OFF_SV = 16809984, OFF_SCP = 16941056, OFF_SCS = 16949248;
constexpr size_t OFF_KV128P = 17080320, OFF_KV128S = 18128896, OFF_KV512P = 18259968, OFF_KV512S = 22454272, OFF_KV2048P = 22585344, OFF_KV2048S = 39362560;
constexpr size_t OUT_TOTAL = 39493632;

constexpr size_t MiB = 1u << 20;
constexpr size_t WS_CTL = 0, CTL_ZERO_BYTES = 32 * 1024;
constexpr size_t WS_ROPE = 1 * MiB;
constexpr size_t WS_WTRIL = 3 * MiB;
constexpr size_t WS_WA_IN0 = 4 * MiB, WS_WA_IN1 = 16 * MiB, WS_WB_IN = 28 * MiB, WS_WC_IN = 44 * MiB;
constexpr size_t WS_WA_OUT0 = 84 * MiB, WS_WA_OUT1 = 88 * MiB, WS_WB_OUT = 92 * MiB, WS_WC_OUT = 96 * MiB;
constexpr size_t WS_HP = 100 * MiB;
constexpr size_t WS_HB = 164 * MiB;
constexpr size_t WS_T = 196 * MiB;
constexpr size_t WS_SSQP = 260 * MiB;
constexpr size_t WS_LNP = 266 * MiB;
constexpr size_t WS_HS = 270 * MiB;
constexpr size_t WS_ZS = 271 * MiB;
constexpr size_t WS_TS = 274 * MiB;
constexpr size_t WS_LSE = 275 * MiB;
constexpr size_t WS_Z = 288 * MiB;
constexpr size_t WS_GATE = WS_Z + 576 * MiB;
constexpr size_t WS_OG = 928 * MiB;
constexpr size_t WS_END = 1120 * MiB;

constexpr int CW_BAR = 4096;

constexpr int LDS_BYTES = 147456;
constexpr int MISC_OFF = 140 * 1024;
constexpr int NWAVES = 8;
constexpr int NPH = 15;

__device__ __forceinline__ unsigned cvt_pk_bf16(float lo, float hi) { unsigned r; asm("v_cvt_pk_bf16_f32 %0, %1, %2" : "=v"(r) : "v"(lo), "v"(hi)); return r; }
__device__ __forceinline__ float bflo(unsigned w) { return __uint_as_float(w << 16); }
__device__ __forceinline__ float bfhi(unsigned w) { return __uint_as_float(w & 0xffff0000u); }
__device__ __forceinline__ float silu_f(float x) { return x * __builtin_amdgcn_rcpf(1.0f + __builtin_amdgcn_exp2f(-x * LOG2E)); }
__device__ __forceinline__ float wave_sum(float v) {
#pragma unroll
    for (int o = 1; o < 64; o <<= 1) v += __shfl_xor(v, o);
    return v;
}
__device__ __forceinline__ float wave_max(float v) {
#pragma unroll
    for (int o = 1; o < 64; o <<= 1) v = fmaxf(v, __shfl_xor(v, o));
    return v;
}
__device__ __forceinline__ int opaque_tid() { int t = threadIdx.x; asm volatile("" : "+v"(t)); return t; }
#define LDS_WAIT() asm volatile("s_waitcnt lgkmcnt(0)" ::: "memory")
#define VM_WAIT() asm volatile("s_waitcnt vmcnt(0)" ::: "memory")

namespace pg8 {
constexpr int BM = 256, BK = 64, HALF = 128, HTB = HALF * BK * 2, STAGE_BYTES = 8 * HTB, NXCD = 8, WGM = 8;
__host__ __device__ __forceinline__ int lds_byte(int r, int c) { const int st = (r >> 4) * 2 + (c >> 5), rr = r & 15, cc = c & 31, ob = rr * 64 + cc * 2; return st * 1024 + (ob ^ (((ob >> 9) & 1) << 5)); }
__host__ __device__ __forceinline__ void stage_rc(int b, int& R, int& C) { const int st = b / 1024, sb = b % 1024, swz = sb ^ (((sb >> 9) & 1) << 5); R = (st >> 1) * 16 + swz / 64; C = (st & 1) * 32 + (swz % 64) / 2; }
__host__ __device__ __forceinline__ int perm32(int rho) { const int n = rho >> 4, i = rho & 15; return 8 * (i >> 2) + 4 * n + (i & 3); }

struct Unit { int pm, pn; };
struct Gemm { const bf16* A; const bf16* Bt; int M, N, K; };

struct StaticOrder {
    int nM, nN, nwg, G, c;
    __host__ __device__ void init(int M, int N, int G_, int c_) { nM = M / BM; nN = N / BM; nwg = nM * nN; G = G_; c = c_; }
    __host__ __device__ __forceinline__ bool next(int i, Unit& u) const {
        const long L = (long)i * G + c; if (L >= nwg) return false;
        int wgid = (int)L; { const int q = nwg / NXCD, r = nwg % NXCD, xcd = wgid % NXCD, off = wgid / NXCD; wgid = (xcd < r ? xcd * (q + 1) : r * (q + 1) + (xcd - r) * q) + off; }
        const int nig = WGM * nN, gid = wgid / nig, fm = gid * WGM, gsz = (nM - fm) < WGM ? (nM - fm) : WGM;
        u.pm = fm + ((wgid % nig) % gsz); u.pn = (wgid % nig) / gsz; return true;
    }
    __device__ __forceinline__ void a_ready(const Unit&) const {}
    __device__ __forceinline__ void done(const Unit&) const {}
};

template <class Epi, class Sched, bool ALIGN_EPI = false, bool SP2 = false>
__device__ __forceinline__ void gemm_phase(LAS unsigned char* lds, const Gemm g, const Sched& S, const Epi& E) {
    const int tid = opaque_tid(), wid = __builtin_amdgcn_readfirstlane(tid >> 6), lane = tid & 63, wr = wid >> 2, wc = wid & 3, fr = lane & 15, fq = lane >> 4;
    const int K = g.K, nt = K / BK;
    unsigned voffA[2], voffB[2];
#pragma unroll
    for (int i = 0; i < 2; ++i) { int R, C; stage_rc(tid * 16 + i * 8192, R, C); const int Rb = Epi::PERM ? ((R & ~31) + perm32(R & 31)) : R;
        voffA[i] = (unsigned)(R * K + C) * 2u; voffB[i] = (unsigned)(Rb * K + C) * 2u; }
    const size_t kstep = (size_t)(BK * 2);
    const size_t hstep = (size_t)HALF * K * 2;
    const size_t tstep = 2 * hstep;
    const unsigned ldsw = (unsigned)wid * 1024u;
    const int aoff = lds_byte(wr * 64 + fr, fq * 8), boff = lds_byte(wc * 32 + fr, fq * 8);
#define PG8_SA(b, h) (((b) * 2 + (h)) * HTB)
#define PG8_SB(b, h) ((4 + (b) * 2 + (h)) * HTB)
#define PG8_STAGE(bufoff, gbase, voff) do { _Pragma("unroll") for (int _i = 0; _i < 2; ++_i) \
        __builtin_amdgcn_global_load_lds((const unsigned*)((const char*)(gbase) + (voff)[_i]), (LAS unsigned*)(lds + (bufoff) + ldsw + _i * 8192), 16, 0, 0); } while (0)
#define PG8_LDA(dst, b, h) do { _Pragma("unroll") for (int m = 0; m < 4; ++m) _Pragma("unroll") for (int k = 0; k < 2; ++k) dst[m][k] = *(const LAS bf16x8*)(lds + PG8_SA(b, h) + aoff + m * 2048 + k * 1024); } while (0)
#define PG8_LDB(dst, b, h) do { _Pragma("unroll") for (int n = 0; n < 2; ++n) _Pragma("unroll") for (int k = 0; k < 2; ++k) dst[n][k] = *(const LAS bf16x8*)(lds + PG8_SB(b, h) + boff + n * 2048 + k * 1024); } while (0)
#define PG8_MMA(ai, bj, At, Bt) do { __builtin_amdgcn_s_setprio(1); _Pragma("unroll") for (int m = 0; m < 4; ++m) _Pragma("unroll") for (int n = 0; n < 2; ++n) _Pragma("unroll") for (int k = 0; k < 2; ++k) \
        acc[ai][bj][m][n] = __builtin_amdgcn_mfma_f32_16x16x32_bf16(Bt[n][k], At[m][k], acc[ai][bj][m][n], 0, 0, 0); __builtin_amdgcn_s_setprio(0); } while (0)
#define PG8_WAIT_V(n) asm volatile("s_waitcnt vmcnt(" #n ")" ::: "memory")
#define PG8_WAIT_L(n) asm volatile("s_waitcnt lgkmcnt(" #n ")" ::: "memory")
#define PG8_BAR __builtin_amdgcn_s_barrier()
#define PG8_SCHED __builtin_amdgcn_sched_barrier(0)
    Unit cur, nxt; int ui = 0;
    if (!S.next(0, cur)) return;
    f32x4 acc[2][2][4][2];
#pragma unroll
    for (int a = 0; a < 2; ++a)
#pragma unroll
        for (int b = 0; b < 2; ++b)
#pragma unroll
            for (int m = 0; m < 4; ++m)
#pragma unroll
                for (int n = 0; n < 2; ++n) acc[a][b][m][n] = (f32x4){0.f, 0.f, 0.f, 0.f};
    bf16x8 At[4][2], B0[2][2], B1[2][2];
    const char* cA = (const char*)g.A + (size_t)cur.pm * tstep; const char* cB = (const char*)g.Bt + (size_t)cur.pn * tstep;
    S.a_ready(cur);
    if constexpr (SP2) {
        PG8_STAGE(PG8_SB(0, 0), cB, voffB); PG8_STAGE(PG8_SB(0, 1), cB + hstep, voffB); PG8_STAGE(PG8_SA(0, 0), cA, voffA); PG8_STAGE(PG8_SA(0, 1), cA + hstep, voffA);
        if (wr == 1) PG8_BAR;
        PG8_WAIT_V(2); PG8_BAR;
        PG8_STAGE(PG8_SB(1, 0), cB + kstep, voffB); PG8_STAGE(PG8_SA(1, 0), cA + kstep, voffA); PG8_STAGE(PG8_SB(1, 1), cB + hstep + kstep, voffB);
        PG8_WAIT_V(6); PG8_BAR;
    } else {
        PG8_STAGE(PG8_SB(0, 0), cB, voffB); PG8_STAGE(PG8_SA(0, 0), cA, voffA); PG8_STAGE(PG8_SB(0, 1), cB + hstep, voffB); PG8_STAGE(PG8_SA(0, 1), cA + hstep, voffA);
        if (wr == 1) PG8_BAR;
        PG8_WAIT_V(4); PG8_BAR;
        PG8_STAGE(PG8_SB(1, 0), cB + kstep, voffB); PG8_STAGE(PG8_SA(1, 0), cA + kstep, voffA); PG8_STAGE(PG8_SB(1, 1), cB + hstep + kstep, voffB);
        PG8_WAIT_V(6); PG8_BAR;
    }
    for (;;) {
        const bool has_next = S.next(ui + 1, nxt);
        const char* nA = has_next ? (const char*)g.A + (size_t)nxt.pm * tstep : cA; const char* nB = has_next ? (const char*)g.Bt + (size_t)nxt.pn * tstep : cB;
        for (int t = 0; t < nt; t += 2) {
            const bool last = (t == nt - 2);
            const char* a1 = cA + (size_t)(t + 1) * kstep;
            const char* a2 = last ? nA : cA + (size_t)(t + 2) * kstep; const char* b2 = last ? nB : cB + (size_t)(t + 2) * kstep;
            const char* a3 = a2 + kstep; const char* b3 = b2 + kstep;
            if (last && has_next) S.a_ready(nxt);
            if constexpr (SP2) {
            PG8_LDB(B0, 0, 0); PG8_LDB(B1, 0, 1); PG8_SCHED; PG8_LDA(At, 0, 0); PG8_STAGE(PG8_SA(1, 1), a1 + hstep, voffA);
            PG8_WAIT_V(8); PG8_WAIT_L(0); PG8_BAR; PG8_MMA(0, 0, At, B0); PG8_MMA(0, 1, At, B1); PG8_BAR; PG8_SCHED;
            PG8_LDA(At, 0, 1); PG8_STAGE(PG8_SB(0, 0), b2, voffB); PG8_STAGE(PG8_SB(0, 1), b2 + hstep, voffB); PG8_STAGE(PG8_SA(0, 0), a2, voffA);
            PG8_WAIT_V(8); PG8_WAIT_L(0); PG8_BAR; PG8_MMA(1, 0, At, B0); PG8_MMA(1, 1, At, B1); PG8_BAR; PG8_SCHED;
            PG8_LDB(B0, 1, 0); PG8_LDB(B1, 1, 1); PG8_SCHED; PG8_LDA(At, 1, 0); PG8_STAGE(PG8_SA(0, 1), a2 + hstep, voffA);
            PG8_WAIT_V(8); PG8_WAIT_L(0); PG8_BAR; PG8_MMA(0, 0, At, B0); PG8_MMA(0, 1, At, B1); PG8_BAR; PG8_SCHED;
            PG8_LDA(At, 1, 1); PG8_STAGE(PG8_SB(1, 0), b3, voffB); PG8_STAGE(PG8_SB(1, 1), b3 + hstep, voffB); PG8_STAGE(PG8_SA(1, 0), a3, voffA);
            PG8_WAIT_V(8); PG8_WAIT_L(0); PG8_BAR; PG8_MMA(1, 0, At, B0); PG8_MMA(1, 1, At, B1); PG8_BAR; PG8_SCHED;
            } else {
            PG8_LDB(B0, 0, 0); PG8_SCHED; PG8_LDA(At, 0, 0); PG8_STAGE(PG8_SA(1, 1), a1 + hstep, voffA);
            PG8_WAIT_L(8); PG8_BAR; PG8_WAIT_L(0); PG8_MMA(0, 0, At, B0); PG8_BAR; PG8_SCHED;
            PG8_LDB(B1, 0, 1); PG8_STAGE(PG8_SB(0, 0), b2, voffB);
            PG8_BAR; PG8_WAIT_L(0); PG8_MMA(0, 1, At, B1); PG8_BAR;
            PG8_LDA(At, 0, 1); PG8_STAGE(PG8_SA(0, 0), a2, voffA);
            PG8_BAR; PG8_WAIT_L(0); PG8_MMA(1, 0, At, B0); PG8_BAR; PG8_SCHED;
            PG8_STAGE(PG8_SB(0, 1), b2 + hstep, voffB);
            PG8_WAIT_V(6); PG8_BAR; PG8_MMA(1, 1, At, B1); PG8_BAR;
            PG8_LDB(B0, 1, 0); PG8_SCHED; PG8_LDA(At, 1, 0); PG8_STAGE(PG8_SA(0, 1), a2 + hstep, voffA);
            PG8_WAIT_L(8); PG8_BAR; PG8_WAIT_L(0); PG8_MMA(0, 0, At, B0); PG8_BAR; PG8_SCHED;
            PG8_LDB(B1, 1, 1); PG8_STAGE(PG8_SB(1, 0), b3, voffB);
            PG8_BAR; PG8_WAIT_L(0); PG8_MMA(0, 1, At, B1); PG8_BAR;
            PG8_LDA(At, 1, 1); PG8_STAGE(PG8_SA(1, 0), a3, voffA);
            PG8_BAR; PG8_WAIT_L(0); PG8_MMA(1, 0, At, B0); PG8_BAR; PG8_SCHED;
            PG8_STAGE(PG8_SB(1, 1), b3 + hstep, voffB);
            PG8_WAIT_V(6); PG8_BAR; PG8_MMA(1, 1, At, B1); PG8_BAR;
            }
        }
        if constexpr (ALIGN_EPI) { if (wr == 0) PG8_BAR; }
        E(acc, cur, wr, wc, fr, fq); S.done(cur);
        if (!has_next) break;
#pragma unroll
        for (int a = 0; a < 2; ++a)
#pragma unroll
            for (int b = 0; b < 2; ++b)
#pragma unroll
                for (int m = 0; m < 4; ++m)
#pragma unroll
                    for (int n = 0; n < 2; ++n) acc[a][b][m][n] = (f32x4){0.f, 0.f, 0.f, 0.f};
        cur = nxt; cA = nA; cB = nB; ++ui;
        if constexpr (ALIGN_EPI) { if (wr == 1) PG8_BAR; }
    }
    PG8_WAIT_V(0);
    if constexpr (!ALIGN_EPI) { if (wr == 0) PG8_BAR; }
    PG8_BAR;
#undef PG8_SA
#undef PG8_SB
#undef PG8_STAGE
#undef PG8_LDA
#undef PG8_LDB
#undef PG8_MMA
#undef PG8_WAIT_V
#undef PG8_WAIT_L
#undef PG8_BAR
#undef PG8_SCHED
}

#ifndef EPI_AUX
#define EPI_AUX 16
#endif
__device__ __forceinline__ __amdgpu_buffer_rsrc_t epi_rsrc(const void* base) { return __builtin_amdgcn_make_buffer_rsrc((void*)base, 0, 0x7fffffff, 0x00020000); }
__device__ __forceinline__ void epi_st16(__amdgpu_buffer_rsrc_t r, size_t elem_off, u32x4 v) { __builtin_amdgcn_raw_buffer_store_b128(v, r, (unsigned)(elem_off * 2), 0, EPI_AUX); }

__device__ __forceinline__ float row_rstd(const float* ssqp, int row, int fq) {
    const f32x4 pp = *(const f32x4*)(ssqp + (size_t)row * 16 + 4 * fq);
    float s = (pp[0] + pp[1]) + (pp[2] + pp[3]);
    s += __shfl_xor(s, 16); s += __shfl_xor(s, 32);
    return __builtin_amdgcn_rsqf(s * (1.0f / DM) + EPS_);
}

constexpr int RS_OFF = 132 * 1024;
__device__ __forceinline__ void stage_rstd(LAS unsigned char* lds, const float* ssqp, int pm) {
    const int tid = opaque_tid(), row = tid >> 1, half = tid & 1;
    const f32x4* p = (const f32x4*)(ssqp + ((size_t)pm * BM + row) * 16 + 8 * half);
    const f32x4 a = p[0], b = p[1];
    float s = ((a[0] + a[1]) + (a[2] + a[3])) + ((b[0] + b[1]) + (b[2] + b[3]));
    s += __shfl_xor(s, 1);
    if (half == 0) ((LAS float*)(lds + RS_OFF))[row] = __builtin_amdgcn_rsqf(s * (1.0f / DM) + EPS_);
    __syncthreads();
}
#define ROW_RSTD(row) ((u.pm == pm0) ? ((const LAS float*)(rsl))[(row) - pm0 * BM] : row_rstd(ssqp, (row), fq))

struct EpiIn {
    static constexpr bool PERM = true;
    bf16* O1; bf16* O2; const float* ssqp; float* lnp; int silu_hi, prod_hi; const LAS unsigned char* rsl; int pm0;
    __device__ __forceinline__ void operator()(const f32x4 (&acc)[2][2][4][2], const Unit& u, int wr, int wc, int fr, int fq) const {
        const int row0 = u.pm * BM + wr * 64 + fr, cw = wc * 32 + 8 * fq;
        if (u.pn < prod_hi) {
            const bool sl = u.pn < silu_hi;
            const __amdgpu_buffer_rsrc_t rs_ = epi_rsrc(O1);
            const size_t ob = sl ? (size_t)128 * u.pn : (size_t)(O2 - O1) + 128 * (u.pn - silu_hi);
#pragma unroll
            for (int ai = 0; ai < 2; ++ai)
#pragma unroll
                for (int m = 0; m < 4; ++m) {
                    const int row = row0 + ai * HALF + m * 16;
                    const float rstd = ROW_RSTD(row);
                    const f32x4 x0 = acc[ai][0][m][0] * rstd, x1 = acc[ai][0][m][1] * rstd; f32x4 y0 = acc[ai][1][m][0] * rstd, y1 = acc[ai][1][m][1] * rstd;
                    if (sl) {
#pragma unroll
                        for (int j = 0; j < 4; ++j) { y0[j] = silu_f(y0[j]); y1[j] = silu_f(y1[j]); }
                    }
                    u32x4 w; w.x = cvt_pk_bf16(x0[0] * y0[0], x0[1] * y0[1]); w.y = cvt_pk_bf16(x0[2] * y0[2], x0[3] * y0[3]); w.z = cvt_pk_bf16(x1[0] * y1[0], x1[1] * y1[1]); w.w = cvt_pk_bf16(x1[2] * y1[2], x1[3] * y1[3]);
                    epi_st16(rs_, ob + (size_t)row * EW + cw, w);
                }
            return;
        }
        const int tn = u.pn - prod_hi;
        const __amdgpu_buffer_rsrc_t rs2_ = epi_rsrc(O2);
#pragma unroll
        for (int ai = 0; ai < 2; ++ai)
#pragma unroll
            for (int m = 0; m < 4; ++m) {
                const int row = row0 + ai * HALF + m * 16;
                const float rstd = ROW_RSTD(row);
                const size_t rowo = (size_t)row * EW + tn * BM + cw;
                float ps = 0.f, pq = 0.f;
#pragma unroll
                for (int bj = 0; bj < 2; ++bj) {
                    const f32x4 v0 = acc[ai][bj][m][0] * rstd, v1 = acc[ai][bj][m][1] * rstd;
                    u32x4 w; w.x = cvt_pk_bf16(v0[0], v0[1]); w.y = cvt_pk_bf16(v0[2], v0[3]); w.z = cvt_pk_bf16(v1[0], v1[1]); w.w = cvt_pk_bf16(v1[2], v1[3]);
                    epi_st16(rs2_, rowo + bj * HALF, w);
                    ps += ((v0[0] + v0[1]) + (v0[2] + v0[3])) + ((v1[0] + v1[1]) + (v1[2] + v1[3]));
                    pq += ((v0[0] * v0[0] + v0[1] * v0[1]) + (v0[2] * v0[2] + v0[3] * v0[3])) + ((v1[0] * v1[0] + v1[1] * v1[1]) + (v1[2] * v1[2] + v1[3] * v1[3]));
                }
                ps += __shfl_xor(ps, 16); ps += __shfl_xor(ps, 32); pq += __shfl_xor(pq, 16); pq += __shfl_xor(pq, 32);
                if (fq == 0) *(f32x2*)(lnp + ((size_t)row * 32 + tn * 4 + wc) * 2) = (f32x2){ps, pq};
            }
    }
};

struct EpiOut {
    static constexpr bool PERM = true;
    bf16* hb; float* ssqn;
    __device__ __forceinline__ void operator()(const f32x4 (&acc)[2][2][4][2], const Unit& u, int wr, int wc, int fr, int fq) const {
        const int row0 = u.pm * BM + wr * 64 + fr, col0 = u.pn * BM + wc * 32 + 8 * fq;
        const __amdgpu_buffer_rsrc_t rsh_ = epi_rsrc(hb);
        u32x4 rv[2][4][2];
#pragma unroll
        for (int ai = 0; ai < 2; ++ai)
#pragma unroll
            for (int m = 0; m < 4; ++m)
#pragma unroll
                for (int bj = 0; bj < 2; ++bj) rv[ai][m][bj] = *(const u32x4*)(hb + (size_t)(row0 + ai * HALF + m * 16) * DM + col0 + bj * HALF);
#pragma unroll
        for (int ai = 0; ai < 2; ++ai)
#pragma unroll
            for (int m = 0; m < 4; ++m) {
                const int row = row0 + ai * HALF + m * 16;
                const size_t off = (size_t)row * DM + col0;
                float sq = 0.f;
#pragma unroll
                for (int bj = 0; bj < 2; ++bj) {
                    const u32x4 r = rv[ai][m][bj];
                    const f32x4 v0 = acc[ai][bj][m][0] + (f32x4){bflo(r.x), bfhi(r.x), bflo(r.y), bfhi(r.y)}, v1 = acc[ai][bj][m][1] + (f32x4){bflo(r.z), bfhi(r.z), bflo(r.w), bfhi(r.w)};
                    u32x4 w; w.x = cvt_pk_bf16(v0[0], v0[1]); w.y = cvt_pk_bf16(v0[2], v0[3]); w.z = cvt_pk_bf16(v1[0], v1[1]); w.w = cvt_pk_bf16(v1[2], v1[3]);
                    epi_st16(rsh_, off + bj * HALF, w);
                    sq += ((v0[0] * v0[0] + v0[1] * v0[1]) + (v0[2] * v0[2] + v0[3] * v0[3])) + ((v1[0] * v1[0] + v1[1] * v1[1]) + (v1[2] * v1[2] + v1[3] * v1[3]));
                }
                sq += __shfl_xor(sq, 16); sq += __shfl_xor(sq, 32);
                if (fq == 0) ssqn[(size_t)row * 16 + u.pn * 4 + wc] = sq;
            }
    }
};

struct EpiCin {
    static constexpr bool PERM = true;
    bf16* QKV; bf16* GATE; const float* ssqp; const float* rope; float* out; const LAS unsigned char* rsl; int pm0;
    __device__ __forceinline__ void operator()(const f32x4 (&acc)[2][2][4][2], const Unit& u, int wr, int wc, int fr, int fq) const {
        const int row0 = u.pm * BM + wr * 64 + fr;
        if (u.pn >= 72) {
            const int col0 = (u.pn - 72) * BM + wc * 32 + 8 * fq;
            const __amdgpu_buffer_rsrc_t rsg_ = epi_rsrc(GATE);
#pragma unroll
            for (int ai = 0; ai < 2; ++ai)
#pragma unroll
                for (int m = 0; m < 4; ++m) {
                    const int row = row0 + ai * HALF + m * 16;
                    const float rstd = ROW_RSTD(row);
                    const size_t rowo = (size_t)row * EW + col0;
#pragma unroll
                    for (int bj = 0; bj < 2; ++bj) {
                        const f32x4 v0 = acc[ai][bj][m][0] * rstd, v1 = acc[ai][bj][m][1] * rstd;
                        u32x4 w; w.x = cvt_pk_bf16(v0[0], v0[1]); w.y = cvt_pk_bf16(v0[2], v0[3]); w.z = cvt_pk_bf16(v1[0], v1[1]); w.w = cvt_pk_bf16(v1[2], v1[3]);
                        epi_st16(rsg_, rowo + bj * HALF, w);
                    }
                }
            return;
        }
        const int which = u.pn / 24, g = (u.pn % 24) >> 3, hp2 = u.pn & 7;
        const int dsh = 2 * g, lsh = 13 - dsh, dmask = (1 << dsh) - 1, win = 128 << dsh;
        const int b = u.pm >> 5;
        const bool do_rope = (which < 2) && (wc == 0);
        const __amdgpu_buffer_rsrc_t rsq_ = epi_rsrc(QKV);
        float ivr[4];
#pragma unroll
        for (int q = 0; q < 4; ++q) ivr[q] = __builtin_amdgcn_exp2f(-(float)(4 * fq + q) * 1.1832230355827609f - 2.651496129472319f);
#pragma unroll
        for (int ai = 0; ai < 2; ++ai)
#pragma unroll
            for (int m = 0; m < 4; ++m) {
                const int row = row0 + ai * HALF + m * 16;
                const int t = row & (SEQ_ - 1);
                const int sp = ((t & dmask) << lsh) | (t >> dsh);
                const float rstd = ROW_RSTD(row);
                f32x4 cs0 = (f32x4){1.f, 0.f, 1.f, 0.f}, cs1 = cs0;
                if (do_rope) { const float tf = (float)t;
                    const float r0 = __builtin_amdgcn_fractf(tf * ivr[0]), r1 = __builtin_amdgcn_fractf(tf * ivr[1]), r2 = __builtin_amdgcn_fractf(tf * ivr[2]), r3 = __builtin_amdgcn_fractf(tf * ivr[3]);
                    cs0 = (f32x4){__builtin_amdgcn_cosf(r0), __builtin_amdgcn_sinf(r0), __builtin_amdgcn_cosf(r1), __builtin_amdgcn_sinf(r1)};
                    cs1 = (f32x4){__builtin_amdgcn_cosf(r2), __builtin_amdgcn_sinf(r2), __builtin_amdgcn_cosf(r3), __builtin_amdgcn_sinf(r3)}; }
#pragma unroll
                for (int bj = 0; bj < 2; ++bj) {
                    const int h = 2 * hp2 + bj;
                    f32x4 v0 = acc[ai][bj][m][0] * rstd, v1 = acc[ai][bj][m][1] * rstd;
                    if (do_rope) {
                        const f32x4 a = v0, c = v1;
                        v0[0] = a[0] * cs0[0] - a[1] * cs0[1]; v0[1] = a[1] * cs0[0] + a[0] * cs0[1];
                        v0[2] = a[2] * cs0[2] - a[3] * cs0[3]; v0[3] = a[3] * cs0[2] + a[2] * cs0[3];
                        v1[0] = c[0] * cs1[0] - c[1] * cs1[1]; v1[1] = c[1] * cs1[0] + c[0] * cs1[1];
                        v1[2] = c[2] * cs1[2] - c[3] * cs1[3]; v1[3] = c[3] * cs1[2] + c[2] * cs1[3];
                    }
                    u32x4 w; w.x = cvt_pk_bf16(v0[0], v0[1]); w.y = cvt_pk_bf16(v0[2], v0[3]); w.z = cvt_pk_bf16(v1[0], v1[1]); w.w = cvt_pk_bf16(v1[2], v1[3]);
                    epi_st16(rsq_, ((((size_t)(which * 3 + g) * 2 + b) * 16 + h) * SEQ_ + sp) * 128 + wc * 32 + 8 * fq, w);
                }
            }
    }
};
}

#define XB_TMO      128
#define XB_XCNT(j)  (256  + 64 * (j))
#define XB_XSUB(j)  (1280 + 64 * (j))
#define XB_XGEN(j)  (2304 + 64 * (j))
#define XB_TOP      3328
#define XB_TOPGEN   3392
#define XCD_BAR_WORDS 3456
#define XB_SPIN_CAP (1u << 18)

__device__ __forceinline__ unsigned xb_ld(unsigned* p)              { return __hip_atomic_load(p, __ATOMIC_RELAXED, __HIP_MEMORY_SCOPE_AGENT); }
__device__ __forceinline__ unsigned xb_add(unsigned* p, unsigned v) { return __hip_atomic_fetch_add(p, v, __ATOMIC_RELAXED, __HIP_MEMORY_SCOPE_AGENT); }
__device__ __forceinline__ unsigned xb_xcc_id() { return (unsigned)__builtin_amdgcn_s_getreg((3 << 11) | 20) & 0xFu; }
#define XB_SPIN(cond, bar) do { unsigned _sp = 0; while (cond) { __builtin_amdgcn_s_sleep(1); \
    if ((++_sp & 255u) == 0u) { if (xb_ld(&(bar)[XB_TMO])) break; if (_sp > XB_SPIN_CAP) { atomicAdd(&(bar)[XB_TMO], 1u); break; } } } } while (0)

struct XcdBarrier { unsigned* bar; unsigned x; volatile LAS unsigned* st; };

__device__ __forceinline__ XcdBarrier xcd_barrier_post(unsigned* bar, volatile LAS unsigned* st) {
    XcdBarrier b; b.bar = bar; b.x = xb_xcc_id(); b.st = st;
    if (threadIdx.x == 0) (void)xb_add(&bar[XB_XCNT(b.x)], 1u);
    return b;
}
__device__ __forceinline__ void xcd_barrier_complete(unsigned* bar, unsigned x, unsigned& nloc, unsigned& nx) {
    const unsigned G = gridDim.x * gridDim.y * gridDim.z;
    unsigned sum, cnt, mine, sp = 0u;
    for (;;) {
        sum = 0u; cnt = 0u; mine = 0u;
#pragma unroll
        for (unsigned j = 0; j < 16; ++j) { const unsigned c = xb_ld(&bar[XB_XCNT(j)]); sum += c; cnt += (c > 0u) ? 1u : 0u; mine = (j == x) ? c : mine; }
        if (sum == G) break;
        __builtin_amdgcn_s_sleep(1);
        if ((++sp & 255u) == 0u) { if (xb_ld(&bar[XB_TMO])) break; if (sp > XB_SPIN_CAP) { atomicAdd(&bar[XB_TMO], 1u); break; } }
    }
    nloc = mine > 0u ? mine : 1u; nx = cnt > 0u ? cnt : 1u;
}
__device__ __forceinline__ void xcd_barrier(const XcdBarrier& b) {
    asm volatile("s_waitcnt vmcnt(0)" ::: "memory");
    __syncthreads();
    if (threadIdx.x == 0) {
        unsigned* bar = b.bar;
        __builtin_amdgcn_s_waitcnt(0);
        unsigned nloc = b.st[0], nx = b.st[1];
        if (nloc == 0u) { xcd_barrier_complete(bar, b.x, nloc, nx); b.st[0] = nloc; b.st[1] = nx; }
        const unsigned old = xb_add(&bar[XB_XSUB(b.x)], 1u);
        const unsigned gen = old / nloc;
        if (old + 1u == (gen + 1u) * nloc) {
            __builtin_amdgcn_fence(__ATOMIC_RELEASE, "agent");
            asm volatile("s_waitcnt vmcnt(0)" ::: "memory");
            const unsigned og = xb_add(&bar[XB_TOP], 1u);
            const unsigned tg = og / nx;
            if (og + 1u == (tg + 1u) * nx) xb_add(&bar[XB_TOPGEN], 1u);
            else XB_SPIN(xb_ld(&bar[XB_TOPGEN]) == tg, bar);
            __builtin_amdgcn_fence(__ATOMIC_ACQUIRE, "agent");
            xb_add(&bar[XB_XGEN(b.x)], 1u);
            asm volatile("s_waitcnt vmcnt(0)" ::: "memory");
        } else {
            XB_SPIN(xb_ld(&bar[XB_XGEN(b.x)]) == gen, bar);
            __builtin_amdgcn_fence(__ATOMIC_ACQUIRE, "agent");
            asm volatile("s_waitcnt vmcnt(0)" ::: "memory");
        }
    }
    __syncthreads();
}

struct Args { const float* in[19]; float* out; unsigned char* ws; int ph_lo, ph_hi; };

__device__ __forceinline__ void p0_transpose_item(const float* W, int K, int N, bf16* WT, const float* scale, bool ropeperm, LAS float* scr, int kb, int nb, int lane, int sn0) {
    const int k0 = 64 * kb, n0 = 32 * nb;
    float tv[32];
#pragma unroll
    for (int i = 0; i < 32; ++i) { const int kk = 2 * i + (lane >> 5); tv[i] = W[(size_t)(k0 + kk) * N + sn0 + (lane & 31)]; }
    const float sc0 = scale ? scale[k0 + lane] : 1.0f;
#pragma unroll
    for (int i = 0; i < 32; ++i) { const int kk = 2 * i + (lane >> 5); scr[kk * 33 + (lane & 31)] = tv[i] * __shfl(sc0, kk); }
    LDS_WAIT(); asm volatile("" ::: "memory");
    const int c = lane & 7;
#pragma unroll
    for (int j = 0; j < 4; ++j) { const int n = (lane >> 3) + 8 * j; const int sn = ropeperm ? ((n >> 1) + ((n & 1) << 4)) : n; const LAS float* s = scr + (8 * c) * 33 + sn;
        u32x4 o; o.x = cvt_pk_bf16(s[0 * 33], s[1 * 33]); o.y = cvt_pk_bf16(s[2 * 33], s[3 * 33]); o.z = cvt_pk_bf16(s[4 * 33], s[5 * 33]); o.w = cvt_pk_bf16(s[6 * 33], s[7 * 33]);
        *(u32x4*)(WT + (size_t)(n0 + n) * K + k0 + 8 * c) = o; }
    LDS_WAIT(); asm volatile("" ::: "memory");
}

__device__ __forceinline__ void p0_prologue(const Args& a, LAS unsigned char* lds, int G) {
    const int tid = opaque_tid(), lane = tid & 63, wave = tid >> 6;
    unsigned char* ws = a.ws;
    LAS float* scr = (LAS float*)(lds + wave * 16384);
    const int gw = blockIdx.x * NWAVES + wave, NGW = G * NWAVES;
    constexpr int I_AIN = (DM / 64) * (N_AIN / 32), I_BIN = (DM / 64) * (N_BIN / 32), I_CIN = (DM / 64) * (N_CIN / 32), I_OUT = (EW / 64) * (DM / 32);
    constexpr int NITEMS = 2 * I_AIN + I_BIN + I_CIN + 4 * I_OUT;
    for (int it = gw; it < NITEMS; it += NGW) {
        int r = it;
        if (r < 2 * I_AIN) { const int la = r >= I_AIN; if (la) r -= I_AIN; const int nb = r % (N_AIN / 32), n0 = 32 * nb, tile = n0 >> 8, wi = n0 & 255;
            const int sn0 = tile < 16 ? (wi < 128 ? 128 * tile + wi : 2 * EW + 128 * tile + wi - 128) : EW + 256 * (tile - 16) + wi;
            p0_transpose_item(a.in[8] + (size_t)la * DM * N_AIN, DM, N_AIN, (bf16*)(ws + (la ? WS_WA_IN1 : WS_WA_IN0)), a.in[6] + (la ? 3 : 0) * DM, false, scr, r / (N_AIN / 32), nb, lane, sn0); continue; } r -= 2 * I_AIN;
        if (r < I_BIN) { const int nb = r % (N_BIN / 32), n0 = 32 * nb, tile = n0 >> 8, wi = n0 & 255, t2 = tile - 16;
            const int sn0 = tile < 16 ? (wi < 128 ? 128 * tile + wi : 3 * EW + 128 * tile + wi - 128) : (wi < 128 ? EW + 128 * t2 + wi : 2 * EW + 128 * t2 + wi - 128);
            p0_transpose_item(a.in[14], DM, N_BIN, (bf16*)(ws + WS_WB_IN), a.in[6] + 1 * DM, false, scr, r / (N_BIN / 32), nb, lane, sn0); continue; } r -= I_BIN;
        if (r < I_CIN) { const int nb = r % (N_CIN / 32);
            const bool ropeperm = (nb * 32 < 2 * 3 * EW) && ((nb & 3) == 0);
            p0_transpose_item(a.in[17], DM, N_CIN, (bf16*)(ws + WS_WC_IN), a.in[6] + 2 * DM, ropeperm, scr, r / (N_CIN / 32), nb, lane, 32 * nb); continue; } r -= I_CIN;
        const int which = r / I_OUT; r -= which * I_OUT;
        const float* src = which == 0 ? a.in[13] : (which == 1 ? a.in[13] + (size_t)EW * DM : (which == 2 ? a.in[16] : a.in[18]));
        bf16* dst = (bf16*)(ws + (which == 0 ? WS_WA_OUT0 : (which == 1 ? WS_WA_OUT1 : (which == 2 ? WS_WB_OUT : WS_WC_OUT))));
        p0_transpose_item(src, EW, DM, dst, nullptr, false, scr, r / (DM / 32), r % (DM / 32), lane, 32 * (r % (DM / 32)));
    }
    {
        const float* x = a.in[0]; bf16* hb = (bf16*)(ws + WS_HB); float* ssq0 = (float*)(ws + WS_SSQP);
        for (int m = gw; m < M_; m += NGW) {
            const f32x4* xr = (const f32x4*)(x + (size_t)m * DM) + lane;
            f32x4 v[4]; float s = 0.f;
#pragma unroll
            for (int j = 0; j < 4; ++j) { v[j] = xr[64 * j]; s += (v[j][0] * v[j][0] + v[j][1] * v[j][1]) + (v[j][2] * v[j][2] + v[j][3] * v[j][3]); }
            s = wave_sum(s);
            u32x2* o8 = (u32x2*)(hb + (size_t)m * DM) + lane;
#pragma unroll
            for (int j = 0; j < 4; ++j) { u32x2 w; w.x = cvt_pk_bf16(v[j][0], v[j][1]); w.y = cvt_pk_bf16(v[j][2], v[j][3]); o8[64 * j] = w; }
            if (lane < 16) ssq0[(size_t)m * 16 + lane] = (lane == 0) ? s : 0.f;
        }
    }
    const int gt = blockIdx.x * (NWAVES * 64) + tid, NGT = G * NWAVES * 64;
    { const float* xs = a.in[1]; float* hs = (float*)(ws + WS_HS); for (int i = gt; i < MS_ * DM; i += NGT) hs[i] = xs[i]; }
    { f32x2* rope = (f32x2*)(ws + WS_ROPE);
      for (int i = SEQ_ * 16 + gt; i < (SEQ_ + 1) * 16; i += NGT) { const int pos = i >> 4, k = i & 15;
          const float inv = (float)pow(500000.0, -(double)k / 16.0); const float ang = (float)pos * inv;
          rope[i] = (f32x2){(float)cos((double)ang), (float)sin((double)ang)}; } }
    { const float* wsrc = a.in[11]; bf16* wt = (bf16*)(ws + WS_WTRIL);
      for (int i = gt; i < 2 * 8 * 128 * 128 / 2; i += NGT) { const int e = 2 * i, ii = (e >> 7) & 127, jj = e & 127;
          const float v0 = (jj <= ii) ? wsrc[e] : 0.f, v1 = (jj + 1 <= ii) ? wsrc[e + 1] : 0.f;
          ((unsigned*)wt)[i] = cvt_pk_bf16(v0, v1); } }
}

__device__ __forceinline__ void sample_in_gemm(LAS unsigned char* lds, const float* hs, const bf16* Wt, int N, float* zs, int G) {
    const int tid = opaque_tid(), lane = tid & 63, wave = tid >> 6, fr = lane & 15, fq = lane >> 4;
    constexpr int PITCH = 2064;
    LAS float* rs = (LAS float*)(lds + 32 * PITCH);
    {
        const int row = tid >> 4, c0 = (tid & 15) * 64;
        const f32x4* src = (const f32x4*)(hs + (size_t)row * DM + c0);
        float s = 0.f;
#pragma unroll
        for (int i = 0; i < 8; ++i) { const f32x4 a0 = src[2 * i], a1 = src[2 * i + 1];
            s += ((a0[0] * a0[0] + a0[1] * a0[1]) + (a0[2] * a0[2] + a0[3] * a0[3])) + ((a1[0] * a1[0] + a1[1] * a1[1]) + (a1[2] * a1[2] + a1[3] * a1[3]));
            u32x4 w; w.x = cvt_pk_bf16(a0[0], a0[1]); w.y = cvt_pk_bf16(a0[2], a0[3]); w.z = cvt_pk_bf16(a1[0], a1[1]); w.w = cvt_pk_bf16(a1[2], a1[3]);
            *(LAS u32x4*)(lds + row * PITCH + (c0 + 8 * i) * 2) = w; }
        s += __shfl_xor(s, 1); s += __shfl_xor(s, 2); s += __shfl_xor(s, 4); s += __shfl_xor(s, 8);
        if ((tid & 15) == 0) rs[row] = __builtin_amdgcn_rsqf(s * (1.0f / DM) + EPS_);
    }
    __syncthreads();
    const int ntiles = N / 16;
    for (int nt = blockIdx.x + G * wave; nt < ntiles; nt += G * NWAVES) {
        f32x4 acc0 = (f32x4){0.f, 0.f, 0.f, 0.f}, acc1 = acc0;
        const bf16* bp = Wt + (size_t)(nt * 16 + fr) * DM + 8 * fq;
        int apo = fr * PITCH + fq * 16; asm volatile("" : "+v"(apo));
        const LAS unsigned char* ap = lds + apo;
        for (int kh = 0; kh < 2; ++kh) {
            bf16x8 bw[16];
#pragma unroll
            for (int k = 0; k < 16; ++k) bw[k] = *(const bf16x8*)(bp + 32 * (16 * kh + k));
#pragma unroll
            for (int k = 0; k < 16; ++k) {
                const bf16x8 a0 = *(const LAS bf16x8*)(ap + (16 * kh + k) * 64), a1 = *(const LAS bf16x8*)(ap + 16 * PITCH + (16 * kh + k) * 64);
                acc0 = __builtin_amdgcn_mfma_f32_16x16x32_bf16(bw[k], a0, acc0, 0, 0, 0);
                acc1 = __builtin_amdgcn_mfma_f32_16x16x32_bf16(bw[k], a1, acc1, 0, 0, 0);
            }
        }
        const float r0 = rs[fr], r1 = rs[16 + fr];
        *(f32x4*)(zs + (size_t)fr * N + nt * 16 + 4 * fq) = acc0 * r0;
        *(f32x4*)(zs + (size_t)(16 + fr) * N + nt * 16 + 4 * fq) = acc1 * r1;
    }
    __syncthreads();
}
__device__ __forceinline__ void sample_out_gemm(LAS unsigned char* lds, const bf16* ts, const bf16* Wt, float* hs, int G) {
    const int tid = opaque_tid(), lane = tid & 63, wave = tid >> 6, fr = lane & 15, fq = lane >> 4;
    LAS f32x4* red = (LAS f32x4*)lds;
    for (int nt = blockIdx.x; nt < DM / 16; nt += G) {
        f32x4 acc0 = (f32x4){0.f, 0.f, 0.f, 0.f}, acc1 = acc0;
        const bf16* bp = Wt + (size_t)(nt * 16 + fr) * EW + 256 * wave + 8 * fq;
        const bf16* ap = ts + (size_t)fr * EW + 256 * wave + 8 * fq;
        bf16x8 bw[8], a0[8], a1[8];
#pragma unroll
        for (int k = 0; k < 8; ++k) { bw[k] = *(const bf16x8*)(bp + 32 * k); a0[k] = *(const bf16x8*)(ap + 32 * k); a1[k] = *(const bf16x8*)(ap + 16 * EW + 32 * k); }
#pragma unroll
        for (int k = 0; k < 8; ++k) {
            acc0 = __builtin_amdgcn_mfma_f32_16x16x32_bf16(bw[k], a0[k], acc0, 0, 0, 0);
            acc1 = __builtin_amdgcn_mfma_f32_16x16x32_bf16(bw[k], a1[k], acc1, 0, 0, 0);
        }
        red[(wave * 2 + 0) * 64 + lane] = acc0; red[(wave * 2 + 1) * 64 + lane] = acc1;
        __syncthreads();
        if (wave < 2) {
            f32x4 sum = red[(0 * 2 + wave) * 64 + lane];
#pragma unroll
            for (int w = 1; w < 8; ++w) sum = sum + red[(w * 2 + wave) * 64 + lane];
            f32x4* p0 = (f32x4*)(hs + (size_t)(16 * wave + fr) * DM + nt * 16 + 4 * fq);
            *p0 = *p0 + sum;
        }
        __syncthreads();
    }
}

__device__ __forceinline__ void mix_a_phase(LAS unsigned char* lds, const Args& a, int layerA, int G) {
    const int tid = opaque_tid(), lane = tid & 63, wave = __builtin_amdgcn_readfirstlane(tid >> 6), fr = lane & 15, fq = lane >> 4, wr = wave >> 2, wc = wave & 3;
    unsigned char* ws = a.ws;
    const bf16* UG = (const bf16*)(ws + WS_Z); const bf16* Vb = UG + (size_t)M_ * EW; bf16* T = (bf16*)(ws + WS_T);
    const float* lnp = (const float*)(ws + WS_LNP);
    const float* lg = a.in[9] + layerA * EW; const float* lb = a.in[10] + layerA * EW;
    const float* bs = a.in[12] + layerA * 8 * 128;
    const bf16* wtril = (const bf16*)(ws + WS_WTRIL) + (size_t)layerA * 8 * 128 * 128;
    constexpr int VP = 272;
    LAS unsigned char* vT = lds;
    LAS f32x2* stat = (LAS f32x2*)(lds + 256 * VP);
    LAS unsigned char* wA = lds + 72 * 1024;
    u32x4 vraw[2][4]; f32x4 lnq[4]; u32x4 ugr[4][2]; u32x4 war[4];
    float lgq, bsq;
    LAS float* lgS = (LAS float*)(lds + 112 * 1024);
    const int sj = tid >> 2, sq4 = tid & 3;
#define MIX_LOADV(uu) do { const int c_ = (uu) >> 3, g_ = (uu) & 7; \
        const f32x4* p_ = (const f32x4*)(lnp + ((size_t)(128 * c_ + sj) * 32 + sq4 * 8) * 2); \
        _Pragma("unroll") for (int i = 0; i < 4; ++i) lnq[i] = p_[i]; \
        _Pragma("unroll") for (int it = 0; it < 2; ++it) { const int item = tid + it * 512, ec = item & 31, jb = item >> 5; \
            _Pragma("unroll") for (int rr = 0; rr < 4; ++rr) vraw[it][rr] = *(const u32x4*)(Vb + (size_t)(128 * c_ + 4 * jb + rr) * EW + 256 * g_ + 8 * ec); } \
        lgq = (tid < 256) ? lg[256 * g_ + tid] : lb[256 * g_ + tid - 256]; bsq = bs[g_ * 128 + (tid & 127)]; \
        _Pragma("unroll") for (int q = 0; q < 4; ++q) { const int idx = tid + 512 * q; war[q] = *(const u32x4*)(wtril + (size_t)g_ * 128 * 128 + (size_t)(idx >> 4) * 128 + (idx & 15) * 8); } } while (0)
#define MIX_LOADUG(uu) do { const int c_ = (uu) >> 3, g_ = (uu) & 7; \
        _Pragma("unroll") for (int m = 0; m < 4; ++m) _Pragma("unroll") for (int np = 0; np < 2; ++np) \
            ugr[m][np] = *(const u32x4*)(UG + ((size_t)128 * c_ + 64 * wr + 16 * m + fr) * EW + 256 * g_ + 64 * wc + 32 * np + 8 * fq); } while (0)
    if ((int)blockIdx.x < 1024) { MIX_LOADV((int)blockIdx.x); MIX_LOADUG((int)blockIdx.x); }
    for (int u = blockIdx.x; u < 1024; u += G) {
        const int c = u >> 3, g = u & 7, un = (u + G < 1024) ? u + G : u;
        {
#pragma unroll
            for (int q = 0; q < 4; ++q) { const int idx = tid + 512 * q; *(LAS u32x4*)(wA + (idx >> 4) * VP + (idx & 15) * 16) = war[q]; }
            lgS[tid] = lgq; if (tid < 128) lgS[512 + tid] = bsq;
            float s = 0.f, ss = 0.f;
#pragma unroll
            for (int i = 0; i < 4; ++i) { const f32x4 x = lnq[i]; s += x[0] + x[2]; ss += x[1] + x[3]; }
            s += __shfl_xor(s, 1); s += __shfl_xor(s, 2); ss += __shfl_xor(ss, 1); ss += __shfl_xor(ss, 2);
            const float mean = s * (1.0f / EW); const float var = fmaxf(ss * (1.0f / EW) - mean * mean, 0.f);
            if (sq4 == 0) stat[sj] = (f32x2){mean, __builtin_amdgcn_rsqf(var + EPS_)};
        }
        __syncthreads();
#pragma unroll
        for (int it = 0; it < 2; ++it) {
            const int item = tid + it * 512, ec = item & 31, jb = item >> 5;
            const f32x4 g0 = *(const LAS f32x4*)(lgS + 8 * ec), g1 = *(const LAS f32x4*)(lgS + 8 * ec + 4), b0 = *(const LAS f32x4*)(lgS + 256 + 8 * ec), b1 = *(const LAS f32x4*)(lgS + 256 + 8 * ec + 4);
            float vals[4][8];
#pragma unroll
            for (int rr = 0; rr < 4; ++rr) {
                const int j = 4 * jb + rr;
                const u32x4 raw = vraw[it][rr];
                const f32x2 st = stat[j];
                vals[rr][0] = (bflo(raw.x) - st.x) * st.y * g0[0] + b0[0]; vals[rr][1] = (bfhi(raw.x) - st.x) * st.y * g0[1] + b0[1];
                vals[rr][2] = (bflo(raw.y) - st.x) * st.y * g0[2] + b0[2]; vals[rr][3] = (bfhi(raw.y) - st.x) * st.y * g0[3] + b0[3];
                vals[rr][4] = (bflo(raw.z) - st.x) * st.y * g1[0] + b1[0]; vals[rr][5] = (bfhi(raw.z) - st.x) * st.y * g1[1] + b1[1];
                vals[rr][6] = (bflo(raw.w) - st.x) * st.y * g1[2] + b1[2]; vals[rr][7] = (bfhi(raw.w) - st.x) * st.y * g1[3] + b1[3];
            }
#pragma unroll
            for (int q = 0; q < 8; ++q) {
                const int e = 8 * ec + q, c32 = e & 31, slot = (e & ~31) + 16 * ((c32 >> 2) & 1) + 4 * (c32 >> 3) + (c32 & 3);
                u32x2 w; w.x = cvt_pk_bf16(vals[0][q], vals[1][q]); w.y = cvt_pk_bf16(vals[2][q], vals[3][q]);
                const int gsw = ((slot >> 5) & 3) + 4 * ((slot >> 3) & 1);
                *(LAS u32x2*)(vT + slot * VP + 16 * ((jb >> 1) ^ gsw) + 8 * (jb & 1)) = w;
            }
        }
        MIX_LOADV(un);
        __syncthreads();
        f32x4 acc[4][4];
#pragma unroll
        for (int m = 0; m < 4; ++m)
#pragma unroll
            for (int n = 0; n < 4; ++n) acc[m][n] = (f32x4){0.f, 0.f, 0.f, 0.f};
        const int kmax = wr ? 4 : 2;
        for (int k = 0; k < kmax; ++k) {
            bf16x8 af[4], bfv[4];
#pragma unroll
            for (int m = 0; m < 4; ++m) af[m] = *(const LAS bf16x8*)(wA + (64 * wr + 16 * m + fr) * VP + (32 * k + 8 * fq) * 2);
#pragma unroll
            for (int n = 0; n < 4; ++n) { const int R = 64 * wc + 16 * n + fr, gsw = ((R >> 5) & 3) + 4 * ((R >> 3) & 1);
                bfv[n] = *(const LAS bf16x8*)(vT + R * VP + 16 * ((4 * k + fq) ^ gsw)); }
#pragma unroll
            for (int m = 0; m < 4; ++m)
#pragma unroll
                for (int n = 0; n < 4; ++n) acc[m][n] = __builtin_amdgcn_mfma_f32_16x16x32_bf16(bfv[n], af[m], acc[m][n], 0, 0, 0);
        }
#pragma unroll
        for (int m = 0; m < 4; ++m) {
            const int i = 64 * wr + 16 * m + fr; const size_t row = (size_t)128 * c + i;
            const float bsv = lgS[512 + i];
#pragma unroll
            for (int np = 0; np < 2; ++np) {
                const int e0 = 256 * g + 64 * wc + 32 * np + 8 * fq;
                const u32x4 uu = ugr[m][np];
                const f32x4 x0 = acc[m][2 * np] + bsv, x1 = acc[m][2 * np + 1] + bsv;
                u32x4 w;
                w.x = cvt_pk_bf16(bflo(uu.x) * x0[0], bfhi(uu.x) * x0[1]);
                w.y = cvt_pk_bf16(bflo(uu.y) * x0[2], bfhi(uu.y) * x0[3]);
                w.z = cvt_pk_bf16(bflo(uu.z) * x1[0], bfhi(uu.z) * x1[1]);
                w.w = cvt_pk_bf16(bflo(uu.w) * x1[2], bfhi(uu.w) * x1[3]);
                *(u32x4*)(T + row * EW + e0) = w;
            }
        }
        MIX_LOADUG(un);
        __syncthreads();
    }
#undef MIX_LOADV
#undef MIX_LOADUG
    const int gw = blockIdx.x * NWAVES + wave;
    if (gw < MS_) {
        const int b = gw; const float* zs = (const float*)(ws + WS_ZS) + (size_t)b * N_AIN;
        const float* wsrc = a.in[11] + (size_t)layerA * 8 * 128 * 128;
        f32x4 v[8]; float s = 0.f;
#pragma unroll
        for (int i = 0; i < 8; ++i) { v[i] = *(const f32x4*)(zs + 2 * EW + 256 * i + 4 * lane); s += (v[i][0] + v[i][1]) + (v[i][2] + v[i][3]); }
        const float mean = wave_sum(s) * (1.0f / EW); float q = 0.f;
#pragma unroll
        for (int i = 0; i < 8; ++i) { v[i] = v[i] - mean; q += (v[i][0] * v[i][0] + v[i][1] * v[i][1]) + (v[i][2] * v[i][2] + v[i][3] * v[i][3]); }
        const float rstd = __builtin_amdgcn_rsqf(wave_sum(q) * (1.0f / EW) + EPS_);
        float* sv = a.out + OFF_SV + ((size_t)layerA * MS_ + b) * EW; bf16* ts = (bf16*)(ws + WS_TS) + (size_t)b * EW;
#pragma unroll
        for (int i = 0; i < 8; ++i) {
            const int e = 256 * i + 4 * lane;
            const f32x4 vn = v[i] * rstd * *(const f32x4*)(lg + e) + *(const f32x4*)(lb + e);
            *(f32x4*)(sv + e) = vn;
            const float w00 = wsrc[(size_t)i * 128 * 128], b00 = bs[i * 128];
            const int pe = 256 * (e >> 7) + (e & 127);
            const f32x4 uu = *(const f32x4*)(zs + pe), gg = *(const f32x4*)(zs + pe + 128);
            u32x2 w; w.x = cvt_pk_bf16(uu[0] * (w00 * vn[0] + b00) * silu_f(gg[0]), uu[1] * (w00 * vn[1] + b00) * silu_f(gg[1]));
            w.y = cvt_pk_bf16(uu[2] * (w00 * vn[2] + b00) * silu_f(gg[2]), uu[3] * (w00 * vn[3] + b00) * silu_f(gg[3]));
            *(u32x2*)(ts + e) = w;
        }
    }
}

__device__ __forceinline__ void conv_b_phase(const Args& a, int G) {
    const int tid = opaque_tid();
    unsigned char* ws = a.ws;
    const bf16* BGG = (const bf16*)(ws + WS_Z); const bf16* P = BGG + (size_t)M_ * EW; bf16* T = (bf16*)(ws + WS_T);
    const float* cw = a.in[15];
    const int NIT = (M_ / 32) * 256;
#define UNPK8(dst, v) do { dst[0] = bflo(v.x); dst[1] = bfhi(v.x); dst[2] = bflo(v.y); dst[3] = bfhi(v.y); dst[4] = bflo(v.z); dst[5] = bfhi(v.z); dst[6] = bflo(v.w); dst[7] = bfhi(v.w); } while (0)
    for (int item = blockIdx.x * 512 + tid; item < NIT; item += G * 512) {
        const int cc = item & 255, rb = item >> 8, r0 = 32 * rb, c0 = 8 * cc;
        float w0[8], w1[8], w2[8];
#pragma unroll
        for (int q = 0; q < 8; ++q) { w0[q] = cw[c0 + q]; w1[q] = cw[EW + c0 + q]; w2[q] = cw[2 * EW + c0 + q]; }
        float p2[8], p1[8];
        if ((r0 & (SEQ_ - 1)) == 0) {
#pragma unroll
            for (int q = 0; q < 8; ++q) { p2[q] = 0.f; p1[q] = 0.f; }
        } else {
            const u32x4 pa = *(const u32x4*)(P + (size_t)(r0 - 2) * EW + c0), pb = *(const u32x4*)(P + (size_t)(r0 - 1) * EW + c0);
            UNPK8(p2, pa); UNPK8(p1, pb);
        }
#pragma unroll 8
        for (int rr = 0; rr < 32; ++rr) {
            const size_t row = (size_t)r0 + rr;
            const u32x4 bgv = *(const u32x4*)(BGG + row * EW + c0), pv = *(const u32x4*)(P + row * EW + c0);
            float p0[8], bgf[8];
            UNPK8(p0, pv); UNPK8(bgf, bgv);
            float o[8];
#pragma unroll
            for (int q = 0; q < 8; ++q) { o[q] = bgf[q] * (w0[q] * p2[q] + w1[q] * p1[q] + w2[q] * p0[q]); }
            u32x4 w; w.x = cvt_pk_bf16(o[0], o[1]); w.y = cvt_pk_bf16(o[2], o[3]); w.z = cvt_pk_bf16(o[4], o[5]); w.w = cvt_pk_bf16(o[6], o[7]);
            *(u32x4*)(T + row * EW + c0) = w;
            const int t = (int)(row & (SEQ_ - 1));
            if (t >= SEQ_ - 2) {
                float* sp = a.out + OFF_SCP + ((size_t)(row >> 13) * 2 + (t - (SEQ_ - 2))) * EW + c0;
                *(f32x4*)sp = (f32x4){p0[0], p0[1], p0[2], p0[3]}; *(f32x4*)(sp + 4) = (f32x4){p0[4], p0[5], p0[6], p0[7]};
            }
#pragma unroll
            for (int q = 0; q < 8; ++q) { p2[q] = p1[q]; p1[q] = p0[q]; }
        }
    }
#undef UNPK8
    for (int item = blockIdx.x * 512 + tid; item < MS_ * EW; item += G * 512) {
        const int b = item >> 11, c = item & (EW - 1), pc = 256 * (c >> 7) + (c & 127);
        const float* zs = (const float*)(ws + WS_ZS) + (size_t)b * N_BIN;
        const float* st = a.in[2] + (size_t)b * 2 * EW;
        const float pr0 = st[c], pr1 = st[EW + c], pn = zs[2 * EW + pc] * zs[2 * EW + pc + 128];
        const float conv = cw[c] * pr0 + cw[EW + c] * pr1 + cw[2 * EW + c] * pn;
        const float o = zs[pc] * conv * silu_f(zs[pc + 128]);
        ((bf16*)(ws + WS_TS))[(size_t)b * EW + c] = (bf16)(cvt_pk_bf16(o, 0.f) & 0xffffu);
        float* so = a.out + OFF_SCS + (size_t)b * 2 * EW; so[c] = pr1; so[EW + c] = pn;
    }
}

namespace att {
#define KSWZ(row, colB) ((row) * 256 + ((colB) ^ (((row) & 7) << 4)))
__device__ __forceinline__ int crow(int r, int hi) { return (r & 3) + 8 * (r >> 2) + 4 * hi; }
__device__ __forceinline__ int v_st(int k, int c) { const int kk = (k & ~0xC) | ((k & 4) << 1) | ((k & 8) >> 1); return ((kk >> 3) * 4 + (c >> 5)) * 512 + ((kk & 7) * 32 + (c & 31)) * 2; }
__device__ __forceinline__ int v_rd_base(int lane) { return ((lane & 3) << 3) | (((lane >> 2) & 3) << 6) | (((lane >> 4) & 1) << 5) | (((lane >> 5) & 1) << 8); }
constexpr int v_rd_off(int d0, int ks, int half) { return d0 * 512 + ks * 4096 + half * 2048; }
template <int OFF> __device__ __forceinline__ s16x4 tr_read(int vb) { s16x4 r; asm volatile("ds_read_b64_tr_b16 %0, %1 offset:%2" : "=&v"(r) : "v"(vb), "i"(OFF) : "memory"); return r; }
constexpr int SHM_T = 16384;
constexpr int OST_OFF = 4 * SHM_T, OST_PITCH = 272, OST_WAVE = 32 * OST_PITCH;

template <int OFF>
__device__ __forceinline__ void qkt_half(f32x16& p, int kbase, int r32, int hi, const bf16x8 (&qr)[8]) {
    p = (f32x16){};
    asm volatile("" : "+v"(r32), "+v"(hi));
    const int rowb = kbase + r32 * 256, sw = (r32 & 7) << 4;
#pragma unroll
    for (int d0 = 0; d0 < 8; ++d0) {
        const bf16x8 b0 = *(const LAS bf16x8*)(uintptr_t)(unsigned)(rowb + ((((d0 & 3) * 32) + hi * 16) ^ sw) + (d0 >> 2) * 128 + OFF);
        p = __builtin_amdgcn_mfma_f32_32x32x16_bf16(b0, qr[d0], p, 0, 0, 0); }
}
template <int D0, int KS0, int BUFOFF> __device__ __forceinline__ void pv_half(f32x16& od, int vb, bf16x8 pa0, bf16x8 pa1) {
    const s16x4 l0 = tr_read<v_rd_off(D0, KS0, 0) + BUFOFF>(vb), h0 = tr_read<v_rd_off(D0, KS0, 1) + BUFOFF>(vb), l1 = tr_read<v_rd_off(D0, KS0 + 1, 0) + BUFOFF>(vb), h1 = tr_read<v_rd_off(D0, KS0 + 1, 1) + BUFOFF>(vb);
    asm volatile("s_waitcnt lgkmcnt(0)" ::: "memory"); __builtin_amdgcn_sched_barrier(0);
#define PKV(L, H) (bf16x8){L[0], L[1], L[2], L[3], H[0], H[1], H[2], H[3]}
    od = __builtin_amdgcn_mfma_f32_32x32x16_bf16(PKV(l0, h0), pa0, od, 0, 0, 0);
    od = __builtin_amdgcn_mfma_f32_32x32x16_bf16(PKV(l1, h1), pa1, od, 0, 0, 0);
#undef PKV
}
struct UnitInfo { int g, b, h, qbg, first, dsh; };
__device__ __forceinline__ UnitInfo decode(int U) { UnitInfo u; u.qbg = U & 31; u.h = (U >> 5) & 15; u.b = (U >> 9) & 1; u.g = U >> 10; u.dsh = 2 * u.g; u.first = ((u.qbg & ((32 >> u.dsh) - 1)) == 0) ? 1 : 0; return u; }
}

__device__ __forceinline__ void attn_c_phase(LAS unsigned char* lds, const Args& a, int G) {
    using namespace att;
    const int tid = threadIdx.x, lane = tid & 63, wave = __builtin_amdgcn_readfirstlane(tid >> 6), r32 = lane & 31, hi = lane >> 5, wp = wave >> 1;
    unsigned char* ws = a.ws;
    const bf16* QKV = (const bf16*)(ws + WS_Z); bf16* OG = (bf16*)(ws + WS_OG); float* LSE = (float*)(ws + WS_LSE);
    LAS unsigned char* V_lds = lds; LAS unsigned char* K_lds = lds + 2 * SHM_T;
    LAS unsigned char* ost = lds + OST_OFF + wave * OST_WAVE;
    constexpr float C = ATT_SCALE * LOG2E;
    const int kbase = (int)(uintptr_t)K_lds;
    constexpr int NU = 3 * 2 * 16 * 32;
    const bool contig = (NU % G) == 0; const int upb = contig ? NU / G : (NU + G - 1) / G;
#define UNIT_ID(i) (contig ? (int)blockIdx.x * upb + (i) : (int)blockIdx.x + G * (i))
#define UNIT_OK(i) ((i) < upb && UNIT_ID(i) < NU)
    int nun = 0; for (int i = 0; i < upb; ++i) nun += UNIT_OK(i) ? 1 : 0;
#define RUN_LEN(i0_, out_) do { int n_ = 1; while ((i0_) + n_ < nun && UNIT_ID((i0_) + n_) == UNIT_ID((i0_) + n_ - 1) + 1 && !decode(UNIT_ID((i0_) + n_)).first) ++n_; out_ = n_; } while (0)
    int l_i0 = 0, l_nu = 1, l_tau = 0; const bf16* l_kp = QKV; const bf16* l_vp = QKV;
    if (nun > 0) { RUN_LEN(0, l_nu); l_tau = decode(UNIT_ID(0)).first ? 2 : 0; }
    bf16x8 ra_k0 = {}, ra_k1 = {}, ra_v0 = {}, ra_v1 = {}, rb_k0 = {}, rb_k1 = {}, rb_v0 = {}, rb_v1 = {};
#define ISSUE(K0, K1, V0, V1) do { if (l_i0 < nun) { const UnitInfo _u = decode(UNIT_ID(l_i0)); \
            const size_t _hb = (((size_t)(_u.g) * 2 + _u.b) * 16 + _u.h) * SEQ_; const long _sp = (long)256 * _u.qbg - 128 + 64 * l_tau; \
            l_kp = QKV + ((size_t)(1 * 3) * 2 * 16 * SEQ_ + _hb + _sp) * 128; l_vp = QKV + ((size_t)(2 * 3) * 2 * 16 * SEQ_ + _hb + _sp) * 128; \
            l_tau += 1; if (l_tau > 4 * l_nu + 1) { l_i0 += l_nu; if (l_i0 < nun) { RUN_LEN(l_i0, l_nu); l_tau = decode(UNIT_ID(l_i0)).first ? 2 : 0; } } } \
        int t_ = tid; asm volatile("" : "+v"(t_)); const unsigned ldoff = (unsigned)((t_ >> 4) * 256 + (t_ & 15) * 16);     \
        K0 = *(const bf16x8*)((const char*)l_kp + ldoff); K1 = *(const bf16x8*)((const char*)l_kp + 8192 + ldoff); \
        V0 = *(const bf16x8*)((const char*)l_vp + ldoff); V1 = *(const bf16x8*)((const char*)l_vp + 8192 + ldoff); } while (0)
#define SWRITE(buf, K0, K1, V0, V1) do { int t_ = tid; asm volatile("" : "+v"(t_)); const int sr_ = t_ >> 4, sc_ = (t_ & 15) * 8; \
        const int vstA = (int)(uintptr_t)V_lds + v_st(sr_, sc_), kstA = (int)(uintptr_t)K_lds + KSWZ(sr_, sc_ * 2); \
        *(LAS bf16x8*)(uintptr_t)(unsigned)(vstA + (buf) * SHM_T) = V0; *(LAS bf16x8*)(uintptr_t)(unsigned)(vstA + (buf) * SHM_T + 8192) = V1; \
        *(LAS bf16x8*)(uintptr_t)(unsigned)(kstA + (buf) * SHM_T) = K0; *(LAS bf16x8*)(uintptr_t)(unsigned)(kstA + (buf) * SHM_T + 8192) = K1; } while (0)
#define QLOAD(uidx) do { const UnitInfo _q = decode(UNIT_ID(uidx)); \
        const bf16* qp = QKV + (((((size_t)_q.g) * 2 + _q.b) * 16 + _q.h) * SEQ_ + 256 * _q.qbg + 32 * wave + r32) * 128 + hi * 8; \
        _Pragma("unroll") for (int d0 = 0; d0 < 8; ++d0) qr[d0] = *(const bf16x8*)(qp + d0 * 16); } while (0)
#define EPILOGUE(uidx) do { const UnitInfo _e = decode(UNIT_ID(uidx)); const float inv = __builtin_amdgcn_rcpf(l_reg); \
        _Pragma("unroll") for (int d0 = 0; d0 < 4; ++d0) _Pragma("unroll") for (int i = 0; i < 4; ++i) { \
            u32x2 w_; w_.x = cvt_pk_bf16(o[d0][4 * i] * inv, o[d0][4 * i + 1] * inv); w_.y = cvt_pk_bf16(o[d0][4 * i + 2] * inv, o[d0][4 * i + 3] * inv); \
            *(LAS u32x2*)(ost + r32 * OST_PITCH + (32 * d0 + 8 * i + 4 * hi) * 2) = w_; } \
        const int lsh_ = 13 - _e.dsh, lmask_ = (1 << lsh_) - 1; \
        { const int sp_ = 256 * _e.qbg + 32 * wave + r32; const int t_ = (sp_ >> lsh_) + ((sp_ & lmask_) << _e.dsh); \
            LSE[((size_t)_e.g * M_ + (size_t)_e.b * SEQ_ + t_) * 16 + _e.h] = m_reg * ATT_SCALE + __logf(l_reg); } \
        LDS_WAIT(); asm volatile("" ::: "memory"); \
        _Pragma("unroll") for (int i = 0; i < 8; ++i) { const int ch_ = lane + 64 * i, row_ = ch_ >> 4, c16_ = ch_ & 15; \
            const u32x4 w_ = *(const LAS u32x4*)(ost + row_ * OST_PITCH + c16_ * 16); \
            const int sp_ = 256 * _e.qbg + 32 * wave + row_; const int t_ = (sp_ >> lsh_) + ((sp_ & lmask_) << _e.dsh); \
            *(u32x4*)(OG + ((size_t)_e.g * M_ + (size_t)_e.b * SEQ_ + t_) * EW + _e.h * 128 + c16_ * 8) = w_; \
            if (i & 1) asm volatile("" ::: "memory"); } \
        LDS_WAIT(); asm volatile("" ::: "memory"); } while (0)
    if (nun > 0) {
        ISSUE(ra_k0, ra_k1, ra_v0, ra_v1); ISSUE(rb_k0, rb_k1, rb_v0, rb_v1);
        SWRITE(0, ra_k0, ra_k1, ra_v0, ra_v1);
        __syncthreads();
        bf16x8 qr[8];
        float m_reg = -1e30f, l_reg = 0.f; f32x16 o[4] = {};
        int i0 = 0;
        while (i0 < nun) {
            int nu; RUN_LEN(i0, nu);
            const int tau0 = decode(UNIT_ID(i0)).first ? 2 : 0;
            QLOAD(i0);
            for (int tau = tau0; tau <= 4 * nu + 1; tau += 2) {
#pragma unroll
                for (int par = 0; par < 2; ++par) {
                    const int tt = tau + par, k = tt - wp, n = k >> 2, ph = k & 3;
                    const bool valid = (k >= 0) && (n < nu);
                    if (valid && ph == 3) {
                        EPILOGUE(i0 + n);
                        QLOAD(i0 + (n + 1 < nu ? n + 1 : n));
                        if (par == 0) ISSUE(ra_k0, ra_k1, ra_v0, ra_v1); else ISSUE(rb_k0, rb_k1, rb_v0, rb_v1);
                        if (par == 0) SWRITE(1, rb_k0, rb_k1, rb_v0, rb_v1); else SWRITE(0, ra_k0, ra_k1, ra_v0, ra_v1);
                    } else {
                        if (par == 0) ISSUE(ra_k0, ra_k1, ra_v0, ra_v1); else ISSUE(rb_k0, rb_k1, rb_v0, rb_v1);
                        if (valid) {
                            const int jj = ph + wp;
                            if (ph == 0 || tt == tau0) { m_reg = -1e30f; l_reg = 0.f;
#pragma unroll
                                for (int d = 0; d < 4; ++d) o[d] = (f32x16){}; }
#define HALF_STEP(HH, PAR) do { \
        const bool skip_ = (HH == 0) ? ((wave & 1) && ph == 0) : (!(wave & 1) && ph == 2); \
        if (!skip_) { \
            f32x16 p; qkt_half<(PAR) * SHM_T + (HH) * 8192>(p, kbase, r32, hi, qr); \
            const bool lowb_ = (ph == 0) && ((wave & 1) ? (HH == 1) : (HH == 0)); const bool upb_ = (ph == 2) && ((wave & 1) ? (HH == 1) : (HH == 0)); \
            if (lowb_ || upb_) { const int base = 64 * jj + 32 * (HH) - 32 * wave - r32 + 4 * hi; \
                _Pragma("unroll") for (int r = 0; r < 16; ++r) { const int kx = base + (r & 3) + 8 * (r >> 2); p[r] = ((unsigned)kx <= 128u) ? p[r] : -INFINITY; } } \
            float pmax = p[0]; \
            _Pragma("unroll") for (int r = 1; r < 16; ++r) pmax = fmaxf(pmax, p[r]); \
            { auto rr = __builtin_amdgcn_permlane32_swap(__float_as_uint(pmax), __float_as_uint(pmax), false, false); pmax = fmaxf(__uint_as_float(rr[0]), __uint_as_float(rr[1])); } \
            const float mn = fmaxf(m_reg, pmax); const float alpha = __builtin_amdgcn_exp2f((m_reg - mn) * C); m_reg = mn; \
            const float mnC = -mn * C; \
            _Pragma("unroll") for (int r = 0; r < 16; ++r) p[r] = __builtin_amdgcn_exp2f(fmaf(p[r], C, mnC)); \
            float ps = 0.f; \
            _Pragma("unroll") for (int r = 0; r < 16; ++r) ps += p[r]; \
            { auto rr = __builtin_amdgcn_permlane32_swap(__float_as_uint(ps), __float_as_uint(ps), false, false); ps = __uint_as_float(rr[0]) + __uint_as_float(rr[1]); } \
            l_reg = l_reg * alpha + ps; \
            if (!__all(alpha == 1.0f)) { _Pragma("unroll") for (int d = 0; d < 4; ++d) _Pragma("unroll") for (int r = 0; r < 16; ++r) o[d][r] *= alpha; } \
            bf16x8 pa0, pa1; \
            PK4(p, 0, pa0); PK4(p, 8, pa1); \
            int l_ = lane; asm volatile("" : "+v"(l_)); const int vb0 = (int)(uintptr_t)V_lds + v_rd_base(l_); \
            pv_half<0, 2 * (HH), (PAR) * SHM_T>(o[0], vb0, pa0, pa1); pv_half<1, 2 * (HH), (PAR) * SHM_T>(o[1], vb0, pa0, pa1); \
            pv_half<2, 2 * (HH), (PAR) * SHM_T>(o[2], vb0, pa0, pa1); pv_half<3, 2 * (HH), (PAR) * SHM_T>(o[3], vb0, pa0, pa1); } } while (0)
#define PK4(P, BASE, OUT) do { unsigned a0 = cvt_pk_bf16(P[BASE + 0], P[BASE + 1]), a1 = cvt_pk_bf16(P[BASE + 2], P[BASE + 3]); \
    unsigned b0 = cvt_pk_bf16(P[BASE + 4], P[BASE + 5]), b1 = cvt_pk_bf16(P[BASE + 6], P[BASE + 7]); \
    auto r0 = __builtin_amdgcn_permlane32_swap(a0, b0, false, false); auto r1 = __builtin_amdgcn_permlane32_swap(a1, b1, false, false); \
    u32x4 w = {r0[0], r1[0], r0[1], r1[1]}; OUT = __builtin_bit_cast(bf16x8, w); } while (0)
                            if (par == 0) { HALF_STEP(0, 0); HALF_STEP(1, 0); } else { HALF_STEP(0, 1); HALF_STEP(1, 1); }
#undef PK4
#undef HALF_STEP
                        }
                        if (par == 0) SWRITE(1, rb_k0, rb_k1, rb_v0, rb_v1); else SWRITE(0, ra_k0, ra_k1, ra_v0, ra_v1);
                    }
                    __syncthreads();
                }
            }
            if (wp == 3) EPILOGUE(i0 + nu - 1);
            i0 += nu;
        }
    }
    __syncthreads();
#undef ISSUE
#undef SWRITE
#undef QLOAD
#undef EPILOGUE
#undef RUN_LEN
#undef UNIT_ID
#undef UNIT_OK
}

__device__ __forceinline__ void attn_c_sample(LAS unsigned char* lds, const Args& a, int G) {
    const int tid = opaque_tid(), lane = tid & 63, wave = __builtin_amdgcn_readfirstlane(tid >> 6);
    unsigned char* ws = a.ws;
    const float* rope = (const float*)(ws + WS_ROPE) + (size_t)SEQ_ * 16 * 2;
    constexpr int TSK = 768 * 4;
    for (int pp = blockIdx.x; pp < 256; pp += G) {
        __syncthreads();
        if (wave < 6) {
            const int pr = wave / 3, g = wave - 3 * pr, P = 2 * pp + pr, b = P >> 4, h = P & 15;
            LAS float* sm = (LAS float*)(lds + wave * TSK);
            LAS float* qs = sm, *ks = sm + 128, *vs = sm + 256, *psm = sm + 384, *os = sm + 512, *misc = sm + 640;
            const float* zs = (const float*)(ws + WS_ZS) + (size_t)b * N_CIN;
            const int dil = 1 << (2 * g), win = 128 << (2 * g);
            const float* cache = a.in[3 + g] + (size_t)b * win * 4096;
            float* kvs = a.out + (g == 0 ? OFF_KV128S : (g == 1 ? OFF_KV512S : OFF_KV2048S)) + (size_t)b * 4096 + h * 128;
            {
                const int cq = g * EW + h * 128 + 2 * lane;
                const f32x2 qv = *(const f32x2*)(zs + cq), kv = *(const f32x2*)(zs + 3 * EW + cq), vv = *(const f32x2*)(zs + 6 * EW + cq);
                if (lane < 16) { const float c = rope[2 * lane], s = rope[2 * lane + 1];
                    const float q1 = qv.x * c - qv.y * s, q2 = qv.y * c + qv.x * s, k1 = kv.x * c - kv.y * s, k2 = kv.y * c + kv.x * s;
                    qs[lane] = q1; qs[lane + 16] = q2; ks[lane] = k1; ks[lane + 16] = k2; kvs[lane] = k1; kvs[lane + 16] = k2; }
                else { qs[2 * lane] = qv.x; qs[2 * lane + 1] = qv.y; ks[2 * lane] = kv.x; ks[2 * lane + 1] = kv.y; kvs[2 * lane] = kv.x; kvs[2 * lane + 1] = kv.y; }
                vs[2 * lane] = vv.x; vs[2 * lane + 1] = vv.y; kvs[2048 + 2 * lane] = vv.x; kvs[2048 + 2 * lane + 1] = vv.y;
            }
            LDS_WAIT(); asm volatile("" ::: "memory");
            const float* k0p = cache + ((size_t)(dil * lane) * 2) * 2048 + h * 128; const float* k1p = cache + ((size_t)(dil * (lane + 64)) * 2) * 2048 + h * 128;
            float s0 = 0.f, s1 = 0.f;
#pragma unroll 8
            for (int dc = 0; dc < 32; ++dc) { const f32x4 q4 = *(const LAS f32x4*)(qs + 4 * dc); const f32x4 ka = *(const f32x4*)(k0p + 4 * dc), kb = *(const f32x4*)(k1p + 4 * dc);
                s0 += (q4[0] * ka[0] + q4[1] * ka[1]) + (q4[2] * ka[2] + q4[3] * ka[3]); s1 += (q4[0] * kb[0] + q4[1] * kb[1]) + (q4[2] * kb[2] + q4[3] * kb[3]); }
            float sn = qs[2 * lane] * ks[2 * lane] + qs[2 * lane + 1] * ks[2 * lane + 1]; sn = wave_sum(sn);
            s0 *= ATT_SCALE; s1 *= ATT_SCALE; sn *= ATT_SCALE;
            const float mx = fmaxf(wave_max(fmaxf(s0, s1)), sn);
            const float e0 = __expf(s0 - mx), e1 = __expf(s1 - mx), en = __expf(sn - mx);
            const float den = wave_sum(e0 + e1) + en;
            psm[lane] = e0; psm[lane + 64] = e1;
            LDS_WAIT(); asm volatile("" ::: "memory");
            f32x2 acc = (f32x2){en * vs[2 * lane], en * vs[2 * lane + 1]};
            const float* vp = cache + 2048 + h * 128 + 2 * lane;
#pragma unroll 16
            for (int i = 0; i < 128; ++i) { const f32x2 vv = *(const f32x2*)(vp + (size_t)(dil * i) * 4096); const float pi = psm[i]; acc.x += pi * vv.x; acc.y += pi * vv.y; }
            const float rden = 1.0f / den;
            os[2 * lane] = acc.x * rden; os[2 * lane + 1] = acc.y * rden;
            if (lane == 0) misc[0] = mx + __logf(den);
        }
        __syncthreads();
        if (wave < 2) {
            const int P = 2 * pp + wave, b = P >> 4, h = P & 15;
            LAS float* s0 = (LAS float*)(lds + (3 * wave + 0) * TSK), *s1 = (LAS float*)(lds + (3 * wave + 1) * TSK), *s2 = (LAS float*)(lds + (3 * wave + 2) * TSK);
            const float l0 = s0[640], l1 = s1[640], l2 = s2[640]; const float mx = fmaxf(l0, fmaxf(l1, l2));
            const float w0 = __expf(l0 - mx), w1 = __expf(l1 - mx), w2 = __expf(l2 - mx); const float rs = 1.0f / (w0 + w1 + w2);
            const float* zs = (const float*)(ws + WS_ZS) + (size_t)b * N_CIN + 9 * EW + h * 128;
            const float oa = (w0 * s0[512 + 2 * lane] + w1 * s1[512 + 2 * lane] + w2 * s2[512 + 2 * lane]) * rs;
            const float ob = (w0 * s0[512 + 2 * lane + 1] + w1 * s1[512 + 2 * lane + 1] + w2 * s2[512 + 2 * lane + 1]) * rs;
            ((unsigned*)(ws + WS_TS))[((size_t)b * EW + h * 128) / 2 + lane] = cvt_pk_bf16(oa * silu_f(zs[2 * lane]), ob * silu_f(zs[2 * lane + 1]));
        }
    }
    __syncthreads();
}

__device__ __forceinline__ void combine_c_phase(const Args& a, int G) {
    unsigned char* ws = a.ws;
    const bf16* OG = (const bf16*)(ws + WS_OG); const float* LSE = (const float*)(ws + WS_LSE); const bf16* GATE = (const bf16*)(ws + WS_GATE); bf16* T = (bf16*)(ws + WS_T);
    const int NIT = M_ * 256;
    const int ctid = opaque_tid();
    for (int item = blockIdx.x * 512 + ctid; item < NIT; item += G * 512) {
        const int row = item >> 8, ch = item & 255, h = ch >> 4;
        const float l0 = LSE[((size_t)0 * M_ + row) * 16 + h], l1 = LSE[((size_t)1 * M_ + row) * 16 + h], l2 = LSE[((size_t)2 * M_ + row) * 16 + h];
        const float mx = fmaxf(l0, fmaxf(l1, l2)); float w0 = __expf(l0 - mx), w1 = __expf(l1 - mx), w2 = __expf(l2 - mx); const float rs = 1.0f / (w0 + w1 + w2); w0 *= rs; w1 *= rs; w2 *= rs;
        const size_t off = (size_t)row * EW + ch * 8;
        const u32x4 a0 = *(const u32x4*)(OG + off), a1 = *(const u32x4*)(OG + (size_t)M_ * EW + off), a2 = *(const u32x4*)(OG + (size_t)2 * M_ * EW + off), gg = *(const u32x4*)(GATE + off);
        u32x4 w;
        w.x = cvt_pk_bf16((w0 * bflo(a0.x) + w1 * bflo(a1.x) + w2 * bflo(a2.x)) * silu_f(bflo(gg.x)), (w0 * bfhi(a0.x) + w1 * bfhi(a1.x) + w2 * bfhi(a2.x)) * silu_f(bfhi(gg.x)));
        w.y = cvt_pk_bf16((w0 * bflo(a0.y) + w1 * bflo(a1.y) + w2 * bflo(a2.y)) * silu_f(bflo(gg.y)), (w0 * bfhi(a0.y) + w1 * bfhi(a1.y) + w2 * bfhi(a2.y)) * silu_f(bfhi(gg.y)));
        w.z = cvt_pk_bf16((w0 * bflo(a0.z) + w1 * bflo(a1.z) + w2 * bflo(a2.z)) * silu_f(bflo(gg.z)), (w0 * bfhi(a0.z) + w1 * bfhi(a1.z) + w2 * bfhi(a2.z)) * silu_f(bfhi(gg.z)));
        w.w = cvt_pk_bf16((w0 * bflo(a0.w) + w1 * bflo(a1.w) + w2 * bflo(a2.w)) * silu_f(bflo(gg.w)), (w0 * bfhi(a0.w) + w1 * bfhi(a1.w) + w2 * bfhi(a2.w)) * silu_f(bfhi(gg.w)));
        *(u32x4*)(T + off) = w;
    }
    const bf16* QKV = (const bf16*)(ws + WS_Z);
    constexpr int NKV0 = 2 * 128 * 512, NKV1 = 2 * 512 * 512, NKV2 = 2 * 2048 * 512;
    for (int item = blockIdx.x * 512 + ctid; item < NKV0 + NKV1 + NKV2; item += G * 512) {
        int idx = item, g = 0; if (idx >= NKV0) { idx -= NKV0; g = 1; if (idx >= NKV1) { idx -= NKV1; g = 2; } }
        const int dsh = 2 * g, lsh = 13 - dsh, wsh = 7 + dsh, win = 1 << wsh;
        const int d8 = idx & 15, h = (idx >> 4) & 15, kv = (idx >> 8) & 1, pp = (idx >> 9) & (win - 1), b = idx >> (9 + wsh);
        const int t = SEQ_ - win + pp, sp = ((t & ((1 << dsh) - 1)) << lsh) | (t >> dsh);
        const bf16* src = QKV + ((((size_t)((1 + kv) * 3 + g) * 2 + b) * 16 + h) * SEQ_ + sp) * 128;
        float* dst = a.out + (g == 0 ? OFF_KV128P : (g == 1 ? OFF_KV512P : OFF_KV2048P)) + (size_t)idx * 8;
        f32x4 o0, o1;
        if (kv == 0 && d8 < 4) {
            const u32x4 w0 = *(const u32x4*)(src + 16 * (d8 & 1)), w1 = *(const u32x4*)(src + 16 * (d8 & 1) + 8);
            if (d8 < 2) { o0 = (f32x4){bflo(w0.x), bflo(w0.y), bflo(w0.z), bflo(w0.w)}; o1 = (f32x4){bflo(w1.x), bflo(w1.y), bflo(w1.z), bflo(w1.w)}; }
            else        { o0 = (f32x4){bfhi(w0.x), bfhi(w0.y), bfhi(w0.z), bfhi(w0.w)}; o1 = (f32x4){bfhi(w1.x), bfhi(w1.y), bfhi(w1.z), bfhi(w1.w)}; }
        } else {
            const u32x4 w0 = *(const u32x4*)(src + 8 * d8);
            o0 = (f32x4){bflo(w0.x), bfhi(w0.x), bflo(w0.y), bfhi(w0.y)}; o1 = (f32x4){bflo(w0.z), bfhi(w0.z), bflo(w0.w), bfhi(w0.w)};
        }
        *(f32x4*)dst = o0; *(f32x4*)(dst + 4) = o1;
    }
}

__device__ __forceinline__ void final_phase(const Args& a, int G) {
    const int tid = opaque_tid(), lane = tid & 63, wave = tid >> 6;
    unsigned char* ws = a.ws;
    const bf16* hbf = (const bf16*)(ws + WS_HB); const float* ssq = (const float*)(ws + WS_SSQP) + (size_t)4 * M_ * 16; const float* fw = a.in[7];
    const int gw = blockIdx.x * NWAVES + wave, NGW = G * NWAVES;
    f32x4 wv[4];
#pragma unroll
    for (int j = 0; j < 4; ++j) wv[j] = *((const f32x4*)fw + lane + 64 * j);
    for (int m = gw; m < M_ + MS_; m += NGW) {
        const bool smp = m >= M_;
        f32x4 v[4]; float s = 0.f;
        if (smp) { const f32x4* xr = (const f32x4*)((const float*)(ws + WS_HS) + (size_t)(m - M_) * DM) + lane;
#pragma unroll
            for (int j = 0; j < 4; ++j) { v[j] = xr[64 * j]; s += (v[j][0] * v[j][0] + v[j][1] * v[j][1]) + (v[j][2] * v[j][2] + v[j][3] * v[j][3]); } }
        else { const u32x2* xr = (const u32x2*)(hbf + (size_t)m * DM) + lane;
#pragma unroll
            for (int j = 0; j < 4; ++j) { const u32x2 r = xr[64 * j]; v[j] = (f32x4){bflo(r.x), bfhi(r.x), bflo(r.y), bfhi(r.y)}; } }
        if (smp) s = wave_sum(s);
        else { float p = (lane < 16) ? ssq[(size_t)m * 16 + lane] : 0.f; s = wave_sum(p); }
        const float rstd = __builtin_amdgcn_rsqf(s * (1.0f / DM) + EPS_);
        f32x4* o = (f32x4*)(a.out + (smp ? OFF_YS + (size_t)(m - M_) * DM : OFF_Y + (size_t)m * DM)) + lane;
#pragma unroll
        for (int j = 0; j < 4; ++j) o[64 * j] = v[j] * rstd * wv[j];
    }
}

__global__ void __launch_bounds__(NWAVES * 64, 2) hybrid_fwd(Args args) {
    extern __shared__ __attribute__((aligned(16))) unsigned char lds_raw[];
    LAS unsigned char* lds = (LAS unsigned char*)lds_raw;
    volatile LAS unsigned* MISC = (volatile LAS unsigned*)(lds + MISC_OFF);
    const int tid = opaque_tid();
    const int G = gridDim.x;
    unsigned char* ws = args.ws;
    unsigned* ctl = (unsigned*)(ws + WS_CTL);
    if (tid < 32) MISC[tid] = 0u;
    __syncthreads();
    XcdBarrier bar; bar.bar = ctl + CW_BAR; bar.x = 0; bar.st = nullptr;
    if (!MK_SPLIT) bar = xcd_barrier_post(ctl + CW_BAR, MISC + 8);
    const int lo = args.ph_lo, hi = args.ph_hi;
#ifndef PHASE_MASK
#define PHASE_MASK 0x7fff
#endif
#define IN(k) (lo <= (k) && (k) < hi && ((PHASE_MASK >> (k)) & 1))
#define SEAM(k) do { if (IN(k) && IN((k) + 1)) xcd_barrier(bar); } while (0)
    float* ssqp = (float*)(ws + WS_SSQP);
    bf16* HB = (bf16*)(ws + WS_HB); float* HP = (float*)(ws + WS_HP); bf16* T = (bf16*)(ws + WS_T); bf16* Z = (bf16*)(ws + WS_Z);
    float* HS = (float*)(ws + WS_HS); float* ZS = (float*)(ws + WS_ZS); bf16* TS = (bf16*)(ws + WS_TS);

#ifndef STAGGER_TICKS
#define STAGGER_TICKS 0
#endif
#define STAGGER() do { if (STAGGER_TICKS) { const unsigned long long t0_ = __builtin_amdgcn_s_memrealtime(); const unsigned long long d_ = (unsigned long long)(((unsigned)blockIdx.x >> 3) & 3u) * STAGGER_TICKS; \
        while (__builtin_amdgcn_s_memrealtime() - t0_ < d_) __builtin_amdgcn_s_sleep(8); } } while (0)
#define GEMM_IN(WOFF, NN, SSQL, LNP, SLO, SHI) do { \
        pg8::Gemm g{HB, (const bf16*)(ws + (WOFF)), M_, (NN), DM}; pg8::StaticOrder S; S.init(M_, (NN), G, (int)blockIdx.x); \
        pg8::Unit u0_; u0_.pm = -1; if (S.next(0, u0_)) pg8::stage_rstd(lds, ssqp + (size_t)(SSQL) * M_ * 16, u0_.pm); \
        pg8::EpiIn E{Z, Z + (size_t)M_ * EW, ssqp + (size_t)(SSQL) * M_ * 16, (LNP), (SLO), (SHI), lds + pg8::RS_OFF, u0_.pm}; \
        pg8::gemm_phase<pg8::EpiIn, pg8::StaticOrder, true, true>(lds, g, S, E); \
        sample_in_gemm(lds, HS, (const bf16*)(ws + (WOFF)), (NN), ZS, G); } while (0)
#define GEMM_OUT(WOFF, RES, SSQL) do { \
        pg8::Gemm g{T, (const bf16*)(ws + (WOFF)), M_, DM, EW}; pg8::StaticOrder S; S.init(M_, DM, G, (int)blockIdx.x); \
        pg8::EpiOut E{HB, ssqp + (size_t)(SSQL) * M_ * 16}; \
        pg8::gemm_phase<pg8::EpiOut, pg8::StaticOrder, true, true>(lds, g, S, E); \
        sample_out_gemm(lds, TS, (const bf16*)(ws + (WOFF)), HS, G); } while (0)
#define GEMM_CIN() do { STAGGER(); \
        pg8::Gemm g{HB, (const bf16*)(ws + WS_WC_IN), M_, N_CIN, DM}; pg8::StaticOrder S; S.init(M_, N_CIN, G, (int)blockIdx.x); \
        pg8::Unit u0_; u0_.pm = -1; if (S.next(0, u0_)) pg8::stage_rstd(lds, ssqp + (size_t)2 * M_ * 16, u0_.pm); \
        pg8::EpiCin E{Z, (bf16*)(ws + WS_GATE), ssqp + (size_t)2 * M_ * 16, (const float*)(ws + WS_ROPE), args.out, lds + pg8::RS_OFF, u0_.pm}; \
        pg8::gemm_phase<pg8::EpiCin, pg8::StaticOrder, true, true>(lds, g, S, E); \
        sample_in_gemm(lds, HS, (const bf16*)(ws + WS_WC_IN), N_CIN, ZS, G); } while (0)
#define PH0 p0_prologue(args, lds, G)
#define PH1 GEMM_IN(WS_WA_IN0, N_AIN, 0, (float*)(ws + WS_LNP), 16, 16)
#define PH2 mix_a_phase(lds, args, 0, G)
#define PH3 GEMM_OUT(WS_WA_OUT0, args.in[0], 1)
#define PH4 GEMM_IN(WS_WB_IN, N_BIN, 1, (float*)nullptr, 16, 32)
#define PH5 conv_b_phase(args, G)
#define PH6 GEMM_OUT(WS_WB_OUT, HP, 2)
#define PH7 GEMM_CIN()
#define PH8 do { attn_c_phase(lds, args, G); if ((DUPMASK >> 16) & 1) attn_c_phase(lds, args, G); attn_c_sample(lds, args, G); if ((DUPMASK >> 15) & 1) attn_c_sample(lds, args, G); } while (0)
#define PH9 combine_c_phase(args, G)
#define PH10 GEMM_OUT(WS_WC_OUT, HP, 3)
#define PH11 GEMM_IN(WS_WA_IN1, N_AIN, 3, (float*)(ws + WS_LNP), 16, 16)
#define PH12 mix_a_phase(lds, args, 1, G)
#define PH13 GEMM_OUT(WS_WA_OUT1, HP, 4)
#define PH14 final_phase(args, G)
#define RUN(k) do { if (IN(k)) { PH##k; if ((DUPMASK >> (k)) & 1) { PH##k; } } SEAM(k); } while (0)
    RUN(0);
    RUN(1); RUN(2); RUN(3);
    RUN(4); RUN(5); RUN(6);
    RUN(7); RUN(8); RUN(9); RUN(10);
    RUN(11); RUN(12); RUN(13);
    RUN(14);
#undef IN
#undef SEAM
}

extern "C" void kernel_launch(void* const* d_in, const int* in_sizes, int n_in, void* d_out, int out_size, void* d_ws, size_t ws_size, hipStream_t stream) {
    static int grid = 0;
    if (grid == 0) {
        if (n_in != 19 || (size_t)out_size != OUT_TOTAL || ws_size < WS_END) { fprintf(stderr, "kernel_launch: unexpected shapes: n_in %d out %d ws %zu\n", n_in, out_size, ws_size); grid = -1; return; }
        int dev = 0, cus = 0, per_cu = 0;
        if (hipGetDevice(&dev) != hipSuccess || hipDeviceGetAttribute(&cus, hipDeviceAttributeMultiprocessorCount, dev) != hipSuccess) { grid = -1; return; }
        if (hipFuncSetAttribute((const void*)hybrid_fwd, hipFuncAttributeMaxDynamicSharedMemorySize, LDS_BYTES) != hipSuccess) { fprintf(stderr, "kernel_launch: hipFuncSetAttribute failed\n"); grid = -1; return; }
        if (hipOccupancyMaxActiveBlocksPerMultiprocessor(&per_cu, (const void*)hybrid_fwd, NWAVES * 64, LDS_BYTES) != hipSuccess || per_cu < 1) { fprintf(stderr, "kernel_launch: occupancy query says %d\n", per_cu); }
        (void)hipGetLastError();
        grid = cus;
    }
    if (grid < 0) return;
    (void)hipMemsetAsync((char*)d_ws + WS_CTL, 0, CTL_ZERO_BYTES, stream);
    Args a{};
    for (int i = 0; i < 19; ++i) a.in[i] = (const float*)d_in[i];
    a.out = (float*)d_out; a.ws = (unsigned char*)d_ws;
#if MK_SPLIT
    for (int k = 0; k < NPH; ++k) { a.ph_lo = k; a.ph_hi = k + 1; hipLaunchKernelGGL(hybrid_fwd, dim3(grid), dim3(NWAVES * 64), LDS_BYTES, stream, a); }
#else
    a.ph_lo = 0; a.ph_hi = NPH;
    hipLaunchKernelGGL(hybrid_fwd, dim3(grid), dim3(NWAVES * 64), LDS_BYTES, stream, a);
#endif
    const hipError_t le = hipPeekAtLastError();
    if (le != hipSuccess) fprintf(stderr, "kernel_launch: launch failed: %s\n", hipGetErrorName(le));
}
```

```cpp
#include <hip/hip_runtime.h>
#include <cstdio>
#include <cstdint>

#ifndef MK_SPLIT
#define MK_SPLIT 0
#endif

#ifndef DUPMASK
#define DUPMASK 0
#endif
#define LAS __attribute__((address_space(3)))
#define GAS __attribute__((address_space(1)))
typedef unsigned short bf16;
typedef short bf16x8 __attribute__((ext_vector_type(8)));
typedef short s16x4 __attribute__((ext_vector_type(4)));
typedef float f32x2 __attribute__((ext_vector_type(2)));
typedef float f32x4 __attribute__((ext_vector_type(4)));
typedef float f32x16 __attribute__((ext_vector_type(16)));
typedef unsigned u32x2 __attribute__((ext_vector_type(2)));
typedef unsigned u32x4 __attribute__((ext_vector_type(4)));

constexpr int M_ = 16384, MS_ = 32, DM = 1024, EW = 2048, SEQ_ = 8192;
constexpr int N_AIN = 3 * EW, N_BIN = 4 * EW, N_CIN = 10 * EW;
constexpr float EPS_ = 1e-6f;
constexpr float LOG2E = 1.4426950408889634f;
constexpr float ATT_SCALE = 0.08838834764831845f;

constexpr size_t OFF_Y = 0, OFF_YS = 16777216, OFF_SV = 16809984, OFF_SCP = 16941056, OFF_SCS = 16949248;
constexpr size_t OFF_KV128P = 17080320, OFF_KV128S = 18128896, OFF_KV512P = 18259968, OFF_KV512S = 22454272, OFF_KV2048P = 22585344, OFF_KV2048S = 39362560;
constexpr size_t OUT_TOTAL = 39493632;

constexpr size_t MiB = 1u << 20;
constexpr size_t WS_CTL = 0, CTL_ZERO_BYTES = 32 * 1024;
constexpr size_t WS_ROPE = 1 * MiB;
constexpr size_t WS_WTRIL = 3 * MiB;
constexpr size_t WS_WA_IN0 = 4 * MiB, WS_WA_IN1 = 16 * MiB, WS_WB_IN = 28 * MiB, WS_WC_IN = 44 * MiB;
constexpr size_t WS_WA_OUT0 = 84 * MiB, WS_WA_OUT1 = 88 * MiB, WS_WB_OUT = 92 * MiB, WS_WC_OUT = 96 * MiB;
constexpr size_t WS_HP = 100 * MiB;
constexpr size_t WS_HB = 164 * MiB;
constexpr size_t WS_T = 196 * MiB;
constexpr size_t WS_SSQP = 260 * MiB;
constexpr size_t WS_LNP = 266 * MiB;
constexpr size_t WS_HS = 270 * MiB;
constexpr size_t WS_ZS = 271 * MiB;
constexpr size_t WS_TS = 274 * MiB;
constexpr size_t WS_LSE = 275 * MiB;
constexpr size_t WS_Z = 288 * MiB;
constexpr size_t WS_GATE = WS_Z + 576 * MiB;
constexpr size_t WS_OG = 928 * MiB;
constexpr size_t WS_END = 1120 * MiB;

constexpr int CW_BAR = 4096;

constexpr int LDS_BYTES = 147456;
constexpr int MISC_OFF = 140 * 1024;
constexpr int NWAVES = 8;
constexpr int NPH = 15;

__device__ __forceinline__ unsigned cvt_pk_bf16(float lo, float hi) { unsigned r; asm("v_cvt_pk_bf16_f32 %0, %1, %2" : "=v"(r) : "v"(lo), "v"(hi)); return r; }
__device__ __forceinline__ float bflo(unsigned w) { return __uint_as_float(w << 16); }
__device__ __forceinline__ float bfhi(unsigned w) { return __uint_as_float(w & 0xffff0000u); }
__device__ __forceinline__ float silu_f(float x) { return x * __builtin_amdgcn_rcpf(1.0f + __builtin_amdgcn_exp2f(-x * LOG2E)); }
__device__ __forceinline__ float wave_sum(float v) {
#pragma unroll
    for (int o = 1; o < 64; o <<= 1) v += __shfl_xor(v, o);
    return v;
}
__device__ __forceinline__ float wave_max(float v) {
#pragma unroll
    for (int o = 1; o < 64; o <<= 1) v = fmaxf(v, __shfl_xor(v, o));
    return v;
}
__device__ __forceinline__ int opaque_tid() { int t = threadIdx.x; asm volatile("" : "+v"(t)); return t; }
#define LDS_WAIT() asm volatile("s_waitcnt lgkmcnt(0)" ::: "memory")
#define VM_WAIT() asm volatile("s_waitcnt vmcnt(0)" ::: "memory")

namespace pg8 {
constexpr int BM = 256, BK = 64, HALF = 128, HTB = HALF * BK * 2, STAGE_BYTES = 8 * HTB, NXCD = 8, WGM = 8;
__host__ __device__ __forceinline__ int lds_byte(int r, int c) { const int st = (r >> 4) * 2 + (c >> 5), rr = r & 15, cc = c & 31, ob = rr * 64 + cc * 2; return st * 1024 + (ob ^ (((ob >> 9) & 1) << 5)); }
__host__ __device__ __forceinline__ void stage_rc(int b, int& R, int& C) { const int st = b / 1024, sb = b % 1024, swz = sb ^ (((sb >> 9) & 1) << 5); R = (st >> 1) * 16 + swz / 64; C = (st & 1) * 32 + (swz % 64) / 2; }
__host__ __device__ __forceinline__ int perm32(int rho) { const int n = rho >> 4, i = rho & 15; return 8 * (i >> 2) + 4 * n + (i & 3); }

struct Unit { int pm, pn; };
struct Gemm { const bf16* A; const bf16* Bt; int M, N, K; };

struct StaticOrder {
    int nM, nN, nwg, G, c;
    __host__ __device__ void init(int M, int N, int G_, int c_) { nM = M / BM; nN = N / BM; nwg = nM * nN; G = G_; c = c_; }
    __host__ __device__ __forceinline__ bool next(int i, Unit& u) const {
        const long L = (long)i * G + c; if (L >= nwg) return false;
        int wgid = (int)L; { const int q = nwg / NXCD, r = nwg % NXCD, xcd = wgid % NXCD, off = wgid / NXCD; wgid = (xcd < r ? xcd * (q + 1) : r * (q + 1) + (xcd - r) * q) + off; }
        const int nig = WGM * nN, gid = wgid / nig, fm = gid * WGM, gsz = (nM - fm) < WGM ? (nM - fm) : WGM;
        u.pm = fm + ((wgid % nig) % gsz); u.pn = (wgid % nig) / gsz; return true;
    }
    __device__ __forceinline__ void a_ready(const Unit&) const {}
    __device__ __forceinline__ void done(const Unit&) const {}
};

struct COrder : StaticOrder {
    __device__ __forceinline__ bool next(int i, Unit& u) const {
        if (!StaticOrder::next(i, u)) return false;
        const int lp = u.pn;
        if (lp < 8) u.pn = 72 + lp; else { const int r = lp - 8, hp = r / 9, w = r - 9 * hp; u.pn = (w / 3) * 24 + (w % 3) * 8 + hp; }
        return true;
    }
};

template <class Epi, class Sched, bool ALIGN_EPI = false, bool SP2 = false>
__device__ __forceinline__ void gemm_phase(LAS unsigned char* lds, const Gemm g, const Sched& S, const Epi& E) {
    const int tid = opaque_tid(), wid = __builtin_amdgcn_readfirstlane(tid >> 6), lane = tid & 63, wr = wid >> 2, wc = wid & 3, fr = lane & 15, fq = lane >> 4;
    const int K = g.K, nt = K / BK;
    unsigned voffA[2], voffB[2];
#pragma unroll
    for (int i = 0; i < 2; ++i) { int R, C; stage_rc(tid * 16 + i * 8192, R, C); const int Rb = Epi::PERM ? ((R & ~31) + perm32(R & 31)) : R;
        voffA[i] = (unsigned)(R * K + C) * 2u; voffB[i] = (unsigned)(Rb * K + C) * 2u; }
    const size_t kstep = (size_t)(BK * 2);
    const size_t hstep = (size_t)HALF * K * 2;
    const size_t tstep = 2 * hstep;
    const unsigned ldsw = (unsigned)wid * 1024u;
    const int aoff = lds_byte(wr * 64 + fr, fq * 8), boff = lds_byte(wc * 32 + fr, fq * 8);
#define PG8_SA(b, h) (((b) * 2 + (h)) * HTB)
#define PG8_SB(b, h) ((4 + (b) * 2 + (h)) * HTB)
#define PG8_STAGE(bufoff, gbase, voff) do { _Pragma("unroll") for (int _i = 0; _i < 2; ++_i) \
        __builtin_amdgcn_global_load_lds((const unsigned*)((const char*)(gbase) + (voff)[_i]), (LAS unsigned*)(lds + (bufoff) + ldsw + _i * 8192), 16, 0, 0); } while (0)
#define PG8_LDA(dst, b, h) do { _Pragma("unroll") for (int m = 0; m < 4; ++m) _Pragma("unroll") for (int k = 0; k < 2; ++k) dst[m][k] = *(const LAS bf16x8*)(lds + PG8_SA(b, h) + aoff + m * 2048 + k * 1024); } while (0)
#define PG8_LDB(dst, b, h) do { _Pragma("unroll") for (int n = 0; n < 2; ++n) _Pragma("unroll") for (int k = 0; k < 2; ++k) dst[n][k] = *(const LAS bf16x8*)(lds + PG8_SB(b, h) + boff + n * 2048 + k * 1024); } while (0)
#define PG8_MMA(ai, bj, At, Bt) do { __builtin_amdgcn_s_setprio(1); _Pragma("unroll") for (int m = 0; m < 4; ++m) _Pragma("unroll") for (int n = 0; n < 2; ++n) _Pragma("unroll") for (int k = 0; k < 2; ++k) \
        acc[ai][bj][m][n] = __builtin_amdgcn_mfma_f32_16x16x32_bf16(Bt[n][k], At[m][k], acc[ai][bj][m][n], 0, 0, 0); __builtin_amdgcn_s_setprio(0); } while (0)
#define PG8_WAIT_V(n) asm volatile("s_waitcnt vmcnt(" #n ")" ::: "memory")
#define PG8_WAIT_L(n) asm volatile("s_waitcnt lgkmcnt(" #n ")" ::: "memory")
#define PG8_BAR __builtin_amdgcn_s_barrier()
#define PG8_SCHED __builtin_amdgcn_sched_barrier(0)
    Unit cur, nxt; int ui = 0;
    if (!S.next(0, cur)) return;
    f32x4 acc[2][2][4][2];
#pragma unroll
    for (int a = 0; a < 2; ++a)
#pragma unroll
        for (int b = 0; b < 2; ++b)
#pragma unroll
            for (int m = 0; m < 4; ++m)
#pragma unroll
                for (int n = 0; n < 2; ++n) acc[a][b][m][n] = (f32x4){0.f, 0.f, 0.f, 0.f};
    bf16x8 At[4][2], B0[2][2], B1[2][2];
    const char* cA = (const char*)g.A + (size_t)cur.pm * tstep; const char* cB = (const char*)g.Bt + (size_t)cur.pn * tstep;
    S.a_ready(cur);
    if constexpr (SP2) {
        PG8_STAGE(PG8_SB(0, 0), cB, voffB); PG8_STAGE(PG8_SB(0, 1), cB + hstep, voffB); PG8_STAGE(PG8_SA(0, 0), cA, voffA); PG8_STAGE(PG8_SA(0, 1), cA + hstep, voffA);
        if (wr == 1) PG8_BAR;
        PG8_WAIT_V(2); PG8_BAR;
        PG8_STAGE(PG8_SB(1, 0), cB + kstep, voffB); PG8_STAGE(PG8_SA(1, 0), cA + kstep, voffA); PG8_STAGE(PG8_SB(1, 1), cB + hstep + kstep, voffB);
        PG8_WAIT_V(6); PG8_BAR;
    } else {
        PG8_STAGE(PG8_SB(0, 0), cB, voffB); PG8_STAGE(PG8_SA(0, 0), cA, voffA); PG8_STAGE(PG8_SB(0, 1), cB + hstep, voffB); PG8_STAGE(PG8_SA(0, 1), cA + hstep, voffA);
        if (wr == 1) PG8_BAR;
        PG8_WAIT_V(4); PG8_BAR;
        PG8_STAGE(PG8_SB(1, 0), cB + kstep, voffB); PG8_STAGE(PG8_SA(1, 0), cA + kstep, voffA); PG8_STAGE(PG8_SB(1, 1), cB + hstep + kstep, voffB);
        PG8_WAIT_V(6); PG8_BAR;
    }
    for (;;) {
        const bool has_next = S.next(ui + 1, nxt);
        const char* nA = has_next ? (const char*)g.A + (size_t)nxt.pm * tstep : cA; const char* nB = has_next ? (const char*)g.Bt + (size_t)nxt.pn * tstep : cB;
        for (int t = 0; t < nt; t += 2) {
            const bool last = (t == nt - 2);
            const char* a1 = cA + (size_t)(t + 1) * kstep;
            const char* a2 = last ? nA : cA + (size_t)(t + 2) * kstep; const char* b2 = last ? nB : cB + (size_t)(t + 2) * kstep;
            const char* a3 = a2 + kstep; const char* b3 = b2 + kstep;
            if (last && has_next) S.a_ready(nxt);
            if constexpr (SP2) {
            PG8_LDB(B0, 0, 0); PG8_LDB(B1, 0, 1); PG8_SCHED; PG8_LDA(At, 0, 0); PG8_STAGE(PG8_SA(1, 1), a1 + hstep, voffA);
            PG8_WAIT_V(8); PG8_WAIT_L(0); PG8_BAR; PG8_MMA(0, 0, At, B0); PG8_MMA(0, 1, At, B1); PG8_BAR; PG8_SCHED;
            PG8_LDA(At, 0, 1); PG8_STAGE(PG8_SB(0, 0), b2, voffB); PG8_STAGE(PG8_SB(0, 1), b2 + hstep, voffB); PG8_STAGE(PG8_SA(0, 0), a2, voffA);
            PG8_WAIT_V(8); PG8_WAIT_L(0); PG8_BAR; PG8_MMA(1, 0, At, B0); PG8_MMA(1, 1, At, B1); PG8_BAR; PG8_SCHED;
            PG8_LDB(B0, 1, 0); PG8_LDB(B1, 1, 1); PG8_SCHED; PG8_LDA(At, 1, 0); PG8_STAGE(PG8_SA(0, 1), a2 + hstep, voffA);
            PG8_WAIT_V(8); PG8_WAIT_L(0); PG8_BAR; PG8_MMA(0, 0, At, B0); PG8_MMA(0, 1, At, B1); PG8_BAR; PG8_SCHED;
            PG8_LDA(At, 1, 1); PG8_STAGE(PG8_SB(1, 0), b3, voffB); PG8_STAGE(PG8_SB(1, 1), b3 + hstep, voffB); PG8_STAGE(PG8_SA(1, 0), a3, voffA);
            PG8_WAIT_V(8); PG8_WAIT_L(0); PG8_BAR; PG8_MMA(1, 0, At, B0); PG8_MMA(1, 1, At, B1); PG8_BAR; PG8_SCHED;
            } else {
            PG8_LDB(B0, 0, 0); PG8_SCHED; PG8_LDA(At, 0, 0); PG8_STAGE(PG8_SA(1, 1), a1 + hstep, voffA);
            PG8_WAIT_L(8); PG8_BAR; PG8_WAIT_L(0); PG8_MMA(0, 0, At, B0); PG8_BAR; PG8_SCHED;
            PG8_LDB(B1, 0, 1); PG8_STAGE(PG8_SB(0, 0), b2, voffB);
            PG8_BAR; PG8_WAIT_L(0); PG8_MMA(0, 1, At, B1); PG8_BAR;
            PG8_LDA(At, 0, 1); PG8_STAGE(PG8_SA(0, 0), a2, voffA);
            PG8_BAR; PG8_WAIT_L(0); PG8_MMA(1, 0, At, B0); PG8_BAR; PG8_SCHED;
            PG8_STAGE(PG8_SB(0, 1), b2 + hstep, voffB);
            PG8_WAIT_V(6); PG8_BAR; PG8_MMA(1, 1, At, B1); PG8_BAR;
            PG8_LDB(B0, 1, 0); PG8_SCHED; PG8_LDA(At, 1, 0); PG8_STAGE(PG8_SA(0, 1), a2 + hstep, voffA);
            PG8_WAIT_L(8); PG8_BAR; PG8_WAIT_L(0); PG8_MMA(0, 0, At, B0); PG8_BAR; PG8_SCHED;
            PG8_LDB(B1, 1, 1); PG8_STAGE(PG8_SB(1, 0), b3, voffB);
            PG8_BAR; PG8_WAIT_L(0); PG8_MMA(0, 1, At, B1); PG8_BAR;
            PG8_LDA(At, 1, 1); PG8_STAGE(PG8_SA(1, 0), a3, voffA);
            PG8_BAR; PG8_WAIT_L(0); PG8_MMA(1, 0, At, B0); PG8_BAR; PG8_SCHED;
            PG8_STAGE(PG8_SB(1, 1), b3 + hstep, voffB);
            PG8_WAIT_V(6); PG8_BAR; PG8_MMA(1, 1, At, B1); PG8_BAR;
            }
        }
        if constexpr (ALIGN_EPI) { if (wr == 0) PG8_BAR; }
        E(acc, cur, wr, wc, fr, fq); S.done(cur);
        if (!has_next) break;
#pragma unroll
        for (int a = 0; a < 2; ++a)
#pragma unroll
            for (int b = 0; b < 2; ++b)
#pragma unroll
                for (int m = 0; m < 4; ++m)
#pragma unroll
                    for (int n = 0; n < 2; ++n) acc[a][b][m][n] = (f32x4){0.f, 0.f, 0.f, 0.f};
        cur = nxt; cA = nA; cB = nB; ++ui;
        if constexpr (ALIGN_EPI) { if (wr == 1) PG8_BAR; }
    }
    PG8_WAIT_V(0);
    if constexpr (!ALIGN_EPI) { if (wr == 0) PG8_BAR; }
    PG8_BAR;
#undef PG8_SA
#undef PG8_SB
#undef PG8_STAGE
#undef PG8_LDA
#undef PG8_LDB
#undef PG8_MMA
#undef PG8_WAIT_V
#undef PG8_WAIT_L
#undef PG8_BAR
#undef PG8_SCHED
}

#ifndef EPI_AUX
#define EPI_AUX 16
#endif
__device__ __forceinline__ __amdgpu_buffer_rsrc_t epi_rsrc(const void* base) { return __builtin_amdgcn_make_buffer_rsrc((void*)base, 0, 0x7fffffff, 0x00020000); }
__device__ __forceinline__ void epi_st16(__amdgpu_buffer_rsrc_t r, size_t elem_off, u32x4 v) { __builtin_amdgcn_raw_buffer_store_b128(v, r, (unsigned)(elem_off * 2), 0, EPI_AUX); }

__device__ __forceinline__ float row_rstd(const float* ssqp, int row, int fq) {
    const f32x4 pp = *(const f32x4*)(ssqp + (size_t)row * 16 + 4 * fq);
    float s = (pp[0] + pp[1]) + (pp[2] + pp[3]);
    s += __shfl_xor(s, 16); s += __shfl_xor(s, 32);
    return __builtin_amdgcn_rsqf(s * (1.0f / DM) + EPS_);
}

constexpr int RS_OFF = 132 * 1024;
__device__ __forceinline__ void stage_rstd(LAS unsigned char* lds, const float* ssqp, int pm) {
    const int tid = opaque_tid(), row = tid >> 1, half = tid & 1;
    const f32x4* p = (const f32x4*)(ssqp + ((size_t)pm * BM + row) * 16 + 8 * half);
    const f32x4 a = p[0], b = p[1];
    float s = ((a[0] + a[1]) + (a[2] + a[3])) + ((b[0] + b[1]) + (b[2] + b[3]));
    s += __shfl_xor(s, 1);
    if (half == 0) ((LAS float*)(lds + RS_OFF))[row] = __builtin_amdgcn_rsqf(s * (1.0f / DM) + EPS_);
    __syncthreads();
}
#define ROW_RSTD(row) ((u.pm == pm0) ? ((const LAS float*)(rsl))[(row) - pm0 * BM] : row_rstd(ssqp, (row), fq))

struct EpiIn {
    static constexpr bool PERM = true;
    bf16* O1; bf16* O2; const float* ssqp; float* lnp; int silu_hi, prod_hi; const LAS unsigned char* rsl; int pm0;
    __device__ __forceinline__ void operator()(const f32x4 (&acc)[2][2][4][2], const Unit& u, int wr, int wc, int fr, int fq) const {
        const int row0 = u.pm * BM + wr * 64 + fr, cw = wc * 32 + 8 * fq;
        if (u.pn < prod_hi) {
            const bool sl = u.pn < silu_hi;
            const __amdgpu_buffer_rsrc_t rs_ = epi_rsrc(O1);
            const size_t ob = sl ? (size_t)128 * u.pn : (size_t)(O2 - O1) + 128 * (u.pn - silu_hi);
#pragma unroll
            for (int ai = 0; ai < 2; ++ai)
#pragma unroll
                for (int m = 0; m < 4; ++m) {
                    const int row = row0 + ai * HALF + m * 16;
                    const float rstd = ROW_RSTD(row);
                    const f32x4 x0 = acc[ai][0][m][0] * rstd, x1 = acc[ai][0][m][1] * rstd; f32x4 y0 = acc[ai][1][m][0] * rstd, y1 = acc[ai][1][m][1] * rstd;
                    if (sl) {
#pragma unroll
                        for (int j = 0; j < 4; ++j) { y0[j] = silu_f(y0[j]); y1[j] = silu_f(y1[j]); }
                    }
                    u32x4 w; w.x = cvt_pk_bf16(x0[0] * y0[0], x0[1] * y0[1]); w.y = cvt_pk_bf16(x0[2] * y0[2], x0[3] * y0[3]); w.z = cvt_pk_bf16(x1[0] * y1[0], x1[1] * y1[1]); w.w = cvt_pk_bf16(x1[2] * y1[2], x1[3] * y1[3]);
                    epi_st16(rs_, ob + (size_t)row * EW + cw, w);
                }
            return;
        }
        const int tn = u.pn - prod_hi;
        const __amdgpu_buffer_rsrc_t rs2_ = epi_rsrc(O2);
#pragma unroll
        for (int ai = 0; ai < 2; ++ai)
#pragma unroll
            for (int m = 0; m < 4; ++m) {
                const int row = row0 + ai * HALF + m * 16;
                const float rstd = ROW_RSTD(row);
                const size_t rowo = (size_t)row * EW + tn * BM + cw;
                float ps = 0.f, pq = 0.f;
#pragma unroll
                for (int bj = 0; bj < 2; ++bj) {
                    const f32x4 v0 = acc[ai][bj][m][0] * rstd, v1 = acc[ai][bj][m][1] * rstd;
                    u32x4 w; w.x = cvt_pk_bf16(v0[0], v0[1]); w.y = cvt_pk_bf16(v0[2], v0[3]); w.z = cvt_pk_bf16(v1[0], v1[1]); w.w = cvt_pk_bf16(v1[2], v1[3]);
                    epi_st16(rs2_, rowo + bj * HALF, w);
                    ps += ((v0[0] + v0[1]) + (v0[2] + v0[3])) + ((v1[0] + v1[1]) + (v1[2] + v1[3]));
                    pq += ((v0[0] * v0[0] + v0[1] * v0[1]) + (v0[2] * v0[2] + v0[3] * v0[3])) + ((v1[0] * v1[0] + v1[1] * v1[1]) + (v1[2] * v1[2] + v1[3] * v1[3]));
                }
                ps += __shfl_xor(ps, 16); ps += __shfl_xor(ps, 32); pq += __shfl_xor(pq, 16); pq += __shfl_xor(pq, 32);
                if (fq == 0) *(f32x2*)(lnp + ((size_t)row * 32 + tn * 4 + wc) * 2) = (f32x2){ps, pq};
            }
    }
};

struct EpiOut {
    static constexpr bool PERM = true;
    bf16* hb; float* ssqn;
    __device__ __forceinline__ void operator()(const f32x4 (&acc)[2][2][4][2], const Unit& u, int wr, int wc, int fr, int fq) const {
        const int row0 = u.pm * BM + wr * 64 + fr, col0 = u.pn * BM + wc * 32 + 8 * fq;
        const __amdgpu_buffer_rsrc_t rsh_ = epi_rsrc(hb);
        u32x4 rv[2][4][2];
#pragma unroll
        for (int ai = 0; ai < 2; ++ai)
#pragma unroll
            for (int m = 0; m < 4; ++m)
#pragma unroll
                for (int bj = 0; bj < 2; ++bj) rv[ai][m][bj] = *(const u32x4*)(hb + (size_t)(row0 + ai * HALF + m * 16) * DM + col0 + bj * HALF);
#pragma unroll
        for (int ai = 0; ai < 2; ++ai)
#pragma unroll
            for (int m = 0; m < 4; ++m) {
                const int row = row0 + ai * HALF + m * 16;
                const size_t off = (size_t)row * DM + col0;
                float sq = 0.f;
#pragma unroll
                for (int bj = 0; bj < 2; ++bj) {
                    const u32x4 r = rv[ai][m][bj];
                    const f32x4 v0 = acc[ai][bj][m][0] + (f32x4){bflo(r.x), bfhi(r.x), bflo(r.y), bfhi(r.y)}, v1 = acc[ai][bj][m][1] + (f32x4){bflo(r.z), bfhi(r.z), bflo(r.w), bfhi(r.w)};
                    u32x4 w; w.x = cvt_pk_bf16(v0[0], v0[1]); w.y = cvt_pk_bf16(v0[2], v0[3]); w.z = cvt_pk_bf16(v1[0], v1[1]); w.w = cvt_pk_bf16(v1[2], v1[3]);
                    epi_st16(rsh_, off + bj * HALF, w);
                    sq += ((v0[0] * v0[0] + v0[1] * v0[1]) + (v0[2] * v0[2] + v0[3] * v0[3])) + ((v1[0] * v1[0] + v1[1] * v1[1]) + (v1[2] * v1[2] + v1[3] * v1[3]));
                }
                sq += __shfl_xor(sq, 16); sq += __shfl_xor(sq, 32);
                if (fq == 0) ssqn[(size_t)row * 16 + u.pn * 4 + wc] = sq;
            }
    }
};

struct EpiCin {
    static constexpr bool PERM = true;
    bf16* QKV; bf16* GATE; const float* ssqp; const float* rope; float* out; const LAS unsigned char* rsl; int pm0;
    __device__ __forceinline__ void operator()(const f32x4 (&acc)[2][2][4][2], const Unit& u, int wr, int wc, int fr, int fq) const {
        const int row0 = u.pm * BM + wr * 64 + fr;
        if (u.pn >= 72) {
            const int col0 = (u.pn - 72) * BM + wc * 32 + 8 * fq;
            const __amdgpu_buffer_rsrc_t rsg_ = epi_rsrc(GATE);
#pragma unroll
            for (int ai = 0; ai < 2; ++ai)
#pragma unroll
                for (int m = 0; m < 4; ++m) {
                    const int row = row0 + ai * HALF + m * 16;
                    const float rstd = ROW_RSTD(row);
                    const size_t rowo = (size_t)row * EW + col0;
#pragma unroll
                    for (int bj = 0; bj < 2; ++bj) {
                        const f32x4 v0 = acc[ai][bj][m][0] * rstd, v1 = acc[ai][bj][m][1] * rstd;
                        u32x4 w; w.x = cvt_pk_bf16(v0[0], v0[1]); w.y = cvt_pk_bf16(v0[2], v0[3]); w.z = cvt_pk_bf16(v1[0], v1[1]); w.w = cvt_pk_bf16(v1[2], v1[3]);
                        epi_st16(rsg_, rowo + bj * HALF, w);
                    }
                }
            return;
        }
        const int which = u.pn / 24, g = (u.pn % 24) >> 3, hp2 = u.pn & 7;
        const int dsh = 2 * g, lsh = 13 - dsh, dmask = (1 << dsh) - 1, win = 128 << dsh;
        const int b = u.pm >> 5;
        const bool do_rope = (which < 2) && (wc == 0);
        const __amdgpu_buffer_rsrc_t rsq_ = epi_rsrc(QKV);
        float ivr[4];
#pragma unroll
        for (int q = 0; q < 4; ++q) ivr[q] = __builtin_amdgcn_exp2f(-(float)(4 * fq + q) * 1.1832230355827609f - 2.651496129472319f);
#pragma unroll
        for (int ai = 0; ai < 2; ++ai)
#pragma unroll
            for (int m = 0; m < 4; ++m) {
                const int row = row0 + ai * HALF + m * 16;
                const int t = row & (SEQ_ - 1);
                const int sp = ((t & dmask) << lsh) | (t >> dsh);
                const float rstd = ROW_RSTD(row);
                f32x4 cs0 = (f32x4){1.f, 0.f, 1.f, 0.f}, cs1 = cs0;
                if (do_rope) { const float tf = (float)t;
                    const float r0 = __builtin_amdgcn_fractf(tf * ivr[0]), r1 = __builtin_amdgcn_fractf(tf * ivr[1]), r2 = __builtin_amdgcn_fractf(tf * ivr[2]), r3 = __builtin_amdgcn_fractf(tf * ivr[3]);
                    cs0 = (f32x4){__builtin_amdgcn_cosf(r0), __builtin_amdgcn_sinf(r0), __builtin_amdgcn_cosf(r1), __builtin_amdgcn_sinf(r1)};
                    cs1 = (f32x4){__builtin_amdgcn_cosf(r2), __builtin_amdgcn_sinf(r2), __builtin_amdgcn_cosf(r3), __builtin_amdgcn_sinf(r3)}; }
#pragma unroll
                for (int bj = 0; bj < 2; ++bj) {
                    const int h = 2 * hp2 + bj;
                    f32x4 v0 = acc[ai][bj][m][0] * rstd, v1 = acc[ai][bj][m][1] * rstd;
                    if (do_rope) {
                        const f32x4 a = v0, c = v1;
                        v0[0] = a[0] * cs0[0] - a[1] * cs0[1]; v0[1] = a[1] * cs0[0] + a[0] * cs0[1];
                        v0[2] = a[2] * cs0[2] - a[3] * cs0[3]; v0[3] = a[3] * cs0[2] + a[2] * cs0[3];
                        v1[0] = c[0] * cs1[0] - c[1] * cs1[1]; v1[1] = c[1] * cs1[0] + c[0] * cs1[1];
                        v1[2] = c[2] * cs1[2] - c[3] * cs1[3]; v1[3] = c[3] * cs1[2] + c[2] * cs1[3];
                    }
                    u32x4 w; w.x = cvt_pk_bf16(v0[0], v0[1]); w.y = cvt_pk_bf16(v0[2], v0[3]); w.z = cvt_pk_bf16(v1[0], v1[1]); w.w = cvt_pk_bf16(v1[2], v1[3]);
                    epi_st16(rsq_, ((((size_t)(which * 3 + g) * 2 + b) * 16 + h) * SEQ_ + sp) * 128 + wc * 32 + 8 * fq, w);
                }
            }
    }
};
}

#define XB_TMO      128
#define XB_XCNT(j)  (256  + 64 * (j))
#define XB_XSUB(j)  (1280 + 64 * (j))
#define XB_XGEN(j)  (2304 + 64 * (j))
#define XB_TOP      3328
#define XB_TOPGEN   3392
#define XCD_BAR_WORDS 3456
#define XB_SPIN_CAP (1u << 18)

__device__ __forceinline__ unsigned xb_ld(unsigned* p)              { return __hip_atomic_load(p, __ATOMIC_RELAXED, __HIP_MEMORY_SCOPE_AGENT); }
__device__ __forceinline__ unsigned xb_add(unsigned* p, unsigned v) { return __hip_atomic_fetch_add(p, v, __ATOMIC_RELAXED, __HIP_MEMORY_SCOPE_AGENT); }
__device__ __forceinline__ unsigned xb_xcc_id() { return (unsigned)__builtin_amdgcn_s_getreg((3 << 11) | 20) & 0xFu; }
#define XB_SPIN(cond, bar) do { unsigned _sp = 0; while (cond) { __builtin_amdgcn_s_sleep(1); \
    if ((++_sp & 255u) == 0u) { if (xb_ld(&(bar)[XB_TMO])) break; if (_sp > XB_SPIN_CAP) { atomicAdd(&(bar)[XB_TMO], 1u); break; } } } } while (0)

struct XcdBarrier { unsigned* bar; unsigned x; volatile LAS unsigned* st; };

__device__ __forceinline__ XcdBarrier xcd_barrier_post(unsigned* bar, volatile LAS unsigned* st) {
    XcdBarrier b; b.bar = bar; b.x = xb_xcc_id(); b.st = st;
    if (threadIdx.x == 0) (void)xb_add(&bar[XB_XCNT(b.x)], 1u);
    return b;
}
__device__ __forceinline__ void xcd_barrier_complete(unsigned* bar, unsigned x, unsigned& nloc, unsigned& nx) {
    const unsigned G = gridDim.x * gridDim.y * gridDim.z;
    unsigned sum, cnt, mine, sp = 0u;
    for (;;) {
        sum = 0u; cnt = 0u; mine = 0u;
#pragma unroll
        for (unsigned j = 0; j < 16; ++j) { const unsigned c = xb_ld(&bar[XB_XCNT(j)]); sum += c; cnt += (c > 0u) ? 1u : 0u; mine = (j == x) ? c : mine; }
        if (sum == G) break;
        __builtin_amdgcn_s_sleep(1);
        if ((++sp & 255u) == 0u) { if (xb_ld(&bar[XB_TMO])) break; if (sp > XB_SPIN_CAP) { atomicAdd(&bar[XB_TMO], 1u); break; } }
    }
    nloc = mine > 0u ? mine : 1u; nx = cnt > 0u ? cnt : 1u;
}
__device__ __forceinline__ void xcd_barrier(const XcdBarrier& b) {
    asm volatile("s_waitcnt vmcnt(0)" ::: "memory");
    __syncthreads();
    if (threadIdx.x == 0) {
        unsigned* bar = b.bar;
        __builtin_amdgcn_s_waitcnt(0);
        unsigned nloc = b.st[0], nx = b.st[1];
        if (nloc == 0u) { xcd_barrier_complete(bar, b.x, nloc, nx); b.st[0] = nloc; b.st[1] = nx; }
        const unsigned old = xb_add(&bar[XB_XSUB(b.x)], 1u);
        const unsigned gen = old / nloc;
        if (old + 1u == (gen + 1u) * nloc) {
            __builtin_amdgcn_fence(__ATOMIC_RELEASE, "agent");
            asm volatile("s_waitcnt vmcnt(0)" ::: "memory");
            const unsigned og = xb_add(&bar[XB_TOP], 1u);
            const unsigned tg = og / nx;
            if (og + 1u == (tg + 1u) * nx) xb_add(&bar[XB_TOPGEN], 1u);
            else XB_SPIN(xb_ld(&bar[XB_TOPGEN]) == tg, bar);
            __builtin_amdgcn_fence(__ATOMIC_ACQUIRE, "agent");
            xb_add(&bar[XB_XGEN(b.x)], 1u);
            asm volatile("s_waitcnt vmcnt(0)" ::: "memory");
        } else {
            XB_SPIN(xb_ld(&bar[XB_XGEN(b.x)]) == gen, bar);
            __builtin_amdgcn_fence(__ATOMIC_ACQUIRE, "agent");
            asm volatile("s_waitcnt vmcnt(0)" ::: "memory");
        }
    }
    __syncthreads();
}

struct Args { const float* in[19]; float* out; unsigned char* ws; int ph_lo, ph_hi; };

__device__ __forceinline__ void p0_transpose_item(const float* W, int K, int N, bf16* WT, const float* scale, bool ropeperm, LAS float* scr, int kb, int nb, int lane, int sn0) {
    const int k0 = 64 * kb, n0 = 32 * nb;
    float tv[32];
#pragma unroll
    for (int i = 0; i < 32; ++i) { const int kk = 2 * i + (lane >> 5); tv[i] = W[(size_t)(k0 + kk) * N + sn0 + (lane & 31)]; }
    const float sc0 = scale ? scale[k0 + lane] : 1.0f;
#pragma unroll
    for (int i = 0; i < 32; ++i) { const int kk = 2 * i + (lane >> 5); scr[kk * 33 + (lane & 31)] = tv[i] * __shfl(sc0, kk); }
    LDS_WAIT(); asm volatile("" ::: "memory");
    const int c = lane & 7;
#pragma unroll
    for (int j = 0; j < 4; ++j) { const int n = (lane >> 3) + 8 * j; const int sn = ropeperm ? ((n >> 1) + ((n & 1) << 4)) : n; const LAS float* s = scr + (8 * c) * 33 + sn;
        u32x4 o; o.x = cvt_pk_bf16(s[0 * 33], s[1 * 33]); o.y = cvt_pk_bf16(s[2 * 33], s[3 * 33]); o.z = cvt_pk_bf16(s[4 * 33], s[5 * 33]); o.w = cvt_pk_bf16(s[6 * 33], s[7 * 33]);
        *(u32x4*)(WT + (size_t)(n0 + n) * K + k0 + 8 * c) = o; }
    LDS_WAIT(); asm volatile("" ::: "memory");
}

__device__ __forceinline__ void p0_prologue(const Args& a, LAS unsigned char* lds, int G) {
    const int tid = opaque_tid(), lane = tid & 63, wave = tid >> 6;
    unsigned char* ws = a.ws;
    LAS float* scr = (LAS float*)(lds + wave * 16384);
    const int gw = blockIdx.x * NWAVES + wave, NGW = G * NWAVES;
    constexpr int I_AIN = (DM / 64) * (N_AIN / 32), I_BIN = (DM / 64) * (N_BIN / 32), I_CIN = (DM / 64) * (N_CIN / 32), I_OUT = (EW / 64) * (DM / 32);
    constexpr int NITEMS = 2 * I_AIN + I_BIN + I_CIN + 4 * I_OUT;
    for (int it = gw; it < NITEMS; it += NGW) {
        int r = it;
        if (r < 2 * I_AIN) { const int la = r >= I_AIN; if (la) r -= I_AIN; const int nb = r % (N_AIN / 32), n0 = 32 * nb, tile = n0 >> 8, wi = n0 & 255;
            const int sn0 = tile < 16 ? (wi < 128 ? 128 * tile + wi : 2 * EW + 128 * tile + wi - 128) : EW + 256 * (tile - 16) + wi;
            p0_transpose_item(a.in[8] + (size_t)la * DM * N_AIN, DM, N_AIN, (bf16*)(ws + (la ? WS_WA_IN1 : WS_WA_IN0)), a.in[6] + (la ? 3 : 0) * DM, false, scr, r / (N_AIN / 32), nb, lane, sn0); continue; } r -= 2 * I_AIN;
        if (r < I_BIN) { const int nb = r % (N_BIN / 32), n0 = 32 * nb, tile = n0 >> 8, wi = n0 & 255, t2 = tile - 16;
            const int sn0 = tile < 16 ? (wi < 128 ? 128 * tile + wi : 3 * EW + 128 * tile + wi - 128) : (wi < 128 ? EW + 128 * t2 + wi : 2 * EW + 128 * t2 + wi - 128);
            p0_transpose_item(a.in[14], DM, N_BIN, (bf16*)(ws + WS_WB_IN), a.in[6] + 1 * DM, false, scr, r / (N_BIN / 32), nb, lane, sn0); continue; } r -= I_BIN;
        if (r < I_CIN) { const int nb = r % (N_CIN / 32);
            const bool ropeperm = (nb * 32 < 2 * 3 * EW) && ((nb & 3) == 0);
            p0_transpose_item(a.in[17], DM, N_CIN, (bf16*)(ws + WS_WC_IN), a.in[6] + 2 * DM, ropeperm, scr, r / (N_CIN / 32), nb, lane, 32 * nb); continue; } r -= I_CIN;
        const int which = r / I_OUT; r -= which * I_OUT;
        const float* src = which == 0 ? a.in[13] : (which == 1 ? a.in[13] + (size_t)EW * DM : (which == 2 ? a.in[16] : a.in[18]));
        bf16* dst = (bf16*)(ws + (which == 0 ? WS_WA_OUT0 : (which == 1 ? WS_WA_OUT1 : (which == 2 ? WS_WB_OUT : WS_WC_OUT))));
        p0_transpose_item(src, EW, DM, dst, nullptr, false, scr, r / (DM / 32), r % (DM / 32), lane, 32 * (r % (DM / 32)));
    }
    {
        const float* x = a.in[0]; bf16* hb = (bf16*)(ws + WS_HB); float* ssq0 = (float*)(ws + WS_SSQP);
        for (int m = gw; m < M_; m += NGW) {
            const f32x4* xr = (const f32x4*)(x + (size_t)m * DM) + lane;
            f32x4 v[4]; float s = 0.f;
#pragma unroll
            for (int j = 0; j < 4; ++j) { v[j] = xr[64 * j]; s += (v[j][0] * v[j][0] + v[j][1] * v[j][1]) + (v[j][2] * v[j][2] + v[j][3] * v[j][3]); }
            s = wave_sum(s);
            u32x2* o8 = (u32x2*)(hb + (size_t)m * DM) + lane;
#pragma unroll
            for (int j = 0; j < 4; ++j) { u32x2 w; w.x = cvt_pk_bf16(v[j][0], v[j][1]); w.y = cvt_pk_bf16(v[j][2], v[j][3]); o8[64 * j] = w; }
            if (lane < 16) ssq0[(size_t)m * 16 + lane] = (lane == 0) ? s : 0.f;
        }
    }
    const int gt = blockIdx.x * (NWAVES * 64) + tid, NGT = G * NWAVES * 64;
    { const float* xs = a.in[1]; float* hs = (float*)(ws + WS_HS); for (int i = gt; i < MS_ * DM; i += NGT) hs[i] = xs[i]; }
    { f32x2* rope = (f32x2*)(ws + WS_ROPE);
      for (int i = SEQ_ * 16 + gt; i < (SEQ_ + 1) * 16; i += NGT) { const int pos = i >> 4, k = i & 15;
          const float inv = (float)pow(500000.0, -(double)k / 16.0); const float ang = (float)pos * inv;
          rope[i] = (f32x2){(float)cos((double)ang), (float)sin((double)ang)}; } }
    { const float* wsrc = a.in[11]; bf16* wt = (bf16*)(ws + WS_WTRIL);
      for (int i = gt; i < 2 * 8 * 128 * 128 / 2; i += NGT) { const int e = 2 * i, ii = (e >> 7) & 127, jj = e & 127;
          const float v0 = (jj <= ii) ? wsrc[e] : 0.f, v1 = (jj + 1 <= ii) ? wsrc[e + 1] : 0.f;
          ((unsigned*)wt)[i] = cvt_pk_bf16(v0, v1); } }
}

__device__ __forceinline__ void sample_in_gemm(LAS unsigned char* lds, const float* hs, const bf16* Wt, int N, float* zs, int G) {
    const int tid = opaque_tid(), lane = tid & 63, wave = tid >> 6, fr = lane & 15, fq = lane >> 4;
    constexpr int PITCH = 2064;
    LAS float* rs = (LAS float*)(lds + 32 * PITCH);
    {
        const int row = tid >> 4, c0 = (tid & 15) * 64;
        const f32x4* src = (const f32x4*)(hs + (size_t)row * DM + c0);
        float s = 0.f;
#pragma unroll
        for (int i = 0; i < 8; ++i) { const f32x4 a0 = src[2 * i], a1 = src[2 * i + 1];
            s += ((a0[0] * a0[0] + a0[1] * a0[1]) + (a0[2] * a0[2] + a0[3] * a0[3])) + ((a1[0] * a1[0] + a1[1] * a1[1]) + (a1[2] * a1[2] + a1[3] * a1[3]));
            u32x4 w; w.x = cvt_pk_bf16(a0[0], a0[1]); w.y = cvt_pk_bf16(a0[2], a0[3]); w.z = cvt_pk_bf16(a1[0], a1[1]); w.w = cvt_pk_bf16(a1[2], a1[3]);
            *(LAS u32x4*)(lds + row * PITCH + (c0 + 8 * i) * 2) = w; }
        s += __shfl_xor(s, 1); s += __shfl_xor(s, 2); s += __shfl_xor(s, 4); s += __shfl_xor(s, 8);
        if ((tid & 15) == 0) rs[row] = __builtin_amdgcn_rsqf(s * (1.0f / DM) + EPS_);
    }
    __syncthreads();
    const int ntiles = N / 16;
    for (int nt = blockIdx.x + G * wave; nt < ntiles; nt += G * NWAVES) {
        f32x4 acc0 = (f32x4){0.f, 0.f, 0.f, 0.f}, acc1 = acc0;
        const bf16* bp = Wt + (size_t)(nt * 16 + fr) * DM + 8 * fq;
        int apo = fr * PITCH + fq * 16; asm volatile("" : "+v"(apo));
        const LAS unsigned char* ap = lds + apo;
        for (int kh = 0; kh < 2; ++kh) {
            bf16x8 bw[16];
#pragma unroll
            for (int k = 0; k < 16; ++k) bw[k] = *(const bf16x8*)(bp + 32 * (16 * kh + k));
#pragma unroll
            for (int k = 0; k < 16; ++k) {
                const bf16x8 a0 = *(const LAS bf16x8*)(ap + (16 * kh + k) * 64), a1 = *(const LAS bf16x8*)(ap + 16 * PITCH + (16 * kh + k) * 64);
                acc0 = __builtin_amdgcn_mfma_f32_16x16x32_bf16(bw[k], a0, acc0, 0, 0, 0);
                acc1 = __builtin_amdgcn_mfma_f32_16x16x32_bf16(bw[k], a1, acc1, 0, 0, 0);
            }
        }
        const float r0 = rs[fr], r1 = rs[16 + fr];
        *(f32x4*)(zs + (size_t)fr * N + nt * 16 + 4 * fq) = acc0 * r0;
        *(f32x4*)(zs + (size_t)(16 + fr) * N + nt * 16 + 4 * fq) = acc1 * r1;
    }
    __syncthreads();
}
__device__ __forceinline__ void sample_out_gemm(LAS unsigned char* lds, const bf16* ts, const bf16* Wt, float* hs, int G) {
    const int tid = opaque_tid(), lane = tid & 63, wave = tid >> 6, fr = lane & 15, fq = lane >> 4;
    LAS f32x4* red = (LAS f32x4*)lds;
    for (int nt = blockIdx.x; nt < DM / 16; nt += G) {
        f32x4 acc0 = (f32x4){0.f, 0.f, 0.f, 0.f}, acc1 = acc0;
        const bf16* bp = Wt + (size_t)(nt * 16 + fr) * EW + 256 * wave + 8 * fq;
        const bf16* ap = ts + (size_t)fr * EW + 256 * wave + 8 * fq;
        bf16x8 bw[8], a0[8], a1[8];
#pragma unroll
        for (int k = 0; k < 8; ++k) { bw[k] = *(const bf16x8*)(bp + 32 * k); a0[k] = *(const bf16x8*)(ap + 32 * k); a1[k] = *(const bf16x8*)(ap + 16 * EW + 32 * k); }
#pragma unroll
        for (int k = 0; k < 8; ++k) {
            acc0 = __builtin_amdgcn_mfma_f32_16x16x32_bf16(bw[k], a0[k], acc0, 0, 0, 0);
            acc1 = __builtin_amdgcn_mfma_f32_16x16x32_bf16(bw[k], a1[k], acc1, 0, 0, 0);
        }
        red[(wave * 2 + 0) * 64 + lane] = acc0; red[(wave * 2 + 1) * 64 + lane] = acc1;
        __syncthreads();
        if (wave < 2) {
            f32x4 sum = red[(0 * 2 + wave) * 64 + lane];
#pragma unroll
            for (int w = 1; w < 8; ++w) sum = sum + red[(w * 2 + wave) * 64 + lane];
            f32x4* p0 = (f32x4*)(hs + (size_t)(16 * wave + fr) * DM + nt * 16 + 4 * fq);
            *p0 = *p0 + sum;
        }
        __syncthreads();
    }
}

__device__ __forceinline__ void mix_a_phase(LAS unsigned char* lds, const Args& a, int layerA, int G) {
    const int tid = opaque_tid(), lane = tid & 63, wave = __builtin_amdgcn_readfirstlane(tid >> 6), fr = lane & 15, fq = lane >> 4, wr = wave >> 2, wc = wave & 3;
    unsigned char* ws = a.ws;
    const bf16* UG = (const bf16*)(ws + WS_Z); const bf16* Vb = UG + (size_t)M_ * EW; bf16* T = (bf16*)(ws + WS_T);
    const float* lnp = (const float*)(ws + WS_LNP);
    const float* lg = a.in[9] + layerA * EW; const float* lb = a.in[10] + layerA * EW;
    const float* bs = a.in[12] + layerA * 8 * 128;
    const bf16* wtril = (const bf16*)(ws + WS_WTRIL) + (size_t)layerA * 8 * 128 * 128;
    constexpr int VP = 272;
    LAS unsigned char* vT = lds;
    LAS f32x2* stat = (LAS f32x2*)(lds + 256 * VP);
    LAS unsigned char* wA = lds + 72 * 1024;
    u32x4 vraw[2][4]; f32x4 lnq[4]; u32x4 ugr[4][2]; u32x4 war[4];
    const int sj = tid >> 2, sq4 = tid & 3;
#define MIX_LOADV(uu) do { const int c_ = (uu) >> 3, g_ = (uu) & 7; \
        const f32x4* p_ = (const f32x4*)(lnp + ((size_t)(128 * c_ + sj) * 32 + sq4 * 8) * 2); \
        _Pragma("unroll") for (int i = 0; i < 4; ++i) lnq[i] = p_[i]; \
        _Pragma("unroll") for (int it = 0; it < 2; ++it) { const int item = tid + it * 512, ec = item & 31, jb = item >> 5; \
            _Pragma("unroll") for (int rr = 0; rr < 4; ++rr) vraw[it][rr] = *(const u32x4*)(Vb + (size_t)(128 * c_ + 4 * jb + rr) * EW + 256 * g_ + 8 * ec); } \
        _Pragma("unroll") for (int q = 0; q < 4; ++q) { const int idx = tid + 512 * q; war[q] = *(const u32x4*)(wtril + (size_t)g_ * 128 * 128 + (size_t)(idx >> 4) * 128 + (idx & 15) * 8); } } while (0)
#define MIX_LOADUG(uu) do { const int c_ = (uu) >> 3, g_ = (uu) & 7; \
        _Pragma("unroll") for (int m = 0; m < 4; ++m) _Pragma("unroll") for (int np = 0; np < 2; ++np) \
            ugr[m][np] = *(const u32x4*)(UG + ((size_t)128 * c_ + 64 * wr + 16 * m + fr) * EW + 256 * g_ + 64 * wc + 32 * np + 8 * fq); } while (0)
    if ((int)blockIdx.x < 1024) { MIX_LOADV((int)blockIdx.x); MIX_LOADUG((int)blockIdx.x); }
    for (int u = blockIdx.x; u < 1024; u += G) {
        const int c = u >> 3, g = u & 7, un = (u + G < 1024) ? u + G : u;
        {
#pragma unroll
            for (int q = 0; q < 4; ++q) { const int idx = tid + 512 * q; *(LAS u32x4*)(wA + (idx >> 4) * VP + (idx & 15) * 16) = war[q]; }
            float s = 0.f, ss = 0.f;
#pragma unroll
            for (int i = 0; i < 4; ++i) { const f32x4 x = lnq[i]; s += x[0] + x[2]; ss += x[1] + x[3]; }
            s += __shfl_xor(s, 1); s += __shfl_xor(s, 2); ss += __shfl_xor(ss, 1); ss += __shfl_xor(ss, 2);
            const float mean = s * (1.0f / EW); const float var = fmaxf(ss * (1.0f / EW) - mean * mean, 0.f);
            if (sq4 == 0) stat[sj] = (f32x2){mean, __builtin_amdgcn_rsqf(var + EPS_)};
        }
        __syncthreads();
#pragma unroll
        for (int it = 0; it < 2; ++it) {
            const int item = tid + it * 512, ec = item & 31, jb = item >> 5;
            const f32x4 g0 = *(const f32x4*)(lg + 256 * g + 8 * ec), g1 = *(const f32x4*)(lg + 256 * g + 8 * ec + 4);
            const f32x4 b0 = *(const f32x4*)(lb + 256 * g + 8 * ec), b1 = *(const f32x4*)(lb + 256 * g + 8 * ec + 4);
            float vals[4][8];
#pragma unroll
            for (int rr = 0; rr < 4; ++rr) {
                const int j = 4 * jb + rr;
                const u32x4 raw = vraw[it][rr];
                const f32x2 st = stat[j];
                vals[rr][0] = (bflo(raw.x) - st.x) * st.y * g0[0] + b0[0]; vals[rr][1] = (bfhi(raw.x) - st.x) * st.y * g0[1] + b0[1];
                vals[rr][2] = (bflo(raw.y) - st.x) * st.y * g0[2] + b0[2]; vals[rr][3] = (bfhi(raw.y) - st.x) * st.y * g0[3] + b0[3];
                vals[rr][4] = (bflo(raw.z) - st.x) * st.y * g1[0] + b1[0]; vals[rr][5] = (bfhi(raw.z) - st.x) * st.y * g1[1] + b1[1];
                vals[rr][6] = (bflo(raw.w) - st.x) * st.y * g1[2] + b1[2]; vals[rr][7] = (bfhi(raw.w) - st.x) * st.y * g1[3] + b1[3];
            }
#pragma unroll
            for (int q = 0; q < 8; ++q) {
                const int e = 8 * ec + q, c32 = e & 31, slot = (e & ~31) + 16 * ((c32 >> 2) & 1) + 4 * (c32 >> 3) + (c32 & 3);
                u32x2 w; w.x = cvt_pk_bf16(vals[0][q], vals[1][q]); w.y = cvt_pk_bf16(vals[2][q], vals[3][q]);
                const int gsw = ((slot >> 5) & 3) + 4 * ((slot >> 3) & 1);
                *(LAS u32x2*)(vT + slot * VP + 16 * ((jb >> 1) ^ gsw) + 8 * (jb & 1)) = w;
            }
        }
        MIX_LOADV(un);
        __syncthreads();
        f32x4 acc[4][4];
#pragma unroll
        for (int m = 0; m < 4; ++m)
#pragma unroll
            for (int n = 0; n < 4; ++n) acc[m][n] = (f32x4){0.f, 0.f, 0.f, 0.f};
        const int kmax = wr ? 4 : 2;
        for (int k = 0; k < kmax; ++k) {
            bf16x8 af[4], bfv[4];
#pragma unroll
            for (int m = 0; m < 4; ++m) af[m] = *(const LAS bf16x8*)(wA + (64 * wr + 16 * m + fr) * VP + (32 * k + 8 * fq) * 2);
#pragma unroll
            for (int n = 0; n < 4; ++n) { const int R = 64 * wc + 16 * n + fr, gsw = ((R >> 5) & 3) + 4 * ((R >> 3) & 1);
                bfv[n] = *(const LAS bf16x8*)(vT + R * VP + 16 * ((4 * k + fq) ^ gsw)); }
#pragma unroll
            for (int m = 0; m < 4; ++m)
#pragma unroll
                for (int n = 0; n < 4; ++n) acc[m][n] = __builtin_amdgcn_mfma_f32_16x16x32_bf16(bfv[n], af[m], acc[m][n], 0, 0, 0);
        }
#pragma unroll
        for (int m = 0; m < 4; ++m) {
            const int i = 64 * wr + 16 * m + fr; const size_t row = (size_t)128 * c + i;
            const float bsv = bs[g * 128 + i];
#pragma unroll
            for (int np = 0; np < 2; ++np) {
                const int e0 = 256 * g + 64 * wc + 32 * np + 8 * fq;
                const u32x4 uu = ugr[m][np];
                const f32x4 x0 = acc[m][2 * np] + bsv, x1 = acc[m][2 * np + 1] + bsv;
                u32x4 w;
                w.x = cvt_pk_bf16(bflo(uu.x) * x0[0], bfhi(uu.x) * x0[1]);
                w.y = cvt_pk_bf16(bflo(uu.y) * x0[2], bfhi(uu.y) * x0[3]);
                w.z = cvt_pk_bf16(bflo(uu.z) * x1[0], bfhi(uu.z) * x1[1]);
                w.w = cvt_pk_bf16(bflo(uu.w) * x1[2], bfhi(uu.w) * x1[3]);
                *(u32x4*)(T + row * EW + e0) = w;
            }
        }
        MIX_LOADUG(un);
        __syncthreads();
    }
#undef MIX_LOADV
#undef MIX_LOADUG
    const int gw = blockIdx.x * NWAVES + wave;
    if (gw < MS_) {
        const int b = gw; const float* zs = (const float*)(ws + WS_ZS) + (size_t)b * N_AIN;
        const float* wsrc = a.in[11] + (size_t)layerA * 8 * 128 * 128;
        f32x4 v[8]; float s = 0.f;
#pragma unroll
        for (int i = 0; i < 8; ++i) { v[i] = *(const f32x4*)(zs + 2 * EW + 256 * i + 4 * lane); s += (v[i][0] + v[i][1]) + (v[i][2] + v[i][3]); }
        const float mean = wave_sum(s) * (1.0f / EW); float q = 0.f;
#pragma unroll
        for (int i = 0; i < 8; ++i) { v[i] = v[i] - mean; q += (v[i][0] * v[i][0] + v[i][1] * v[i][1]) + (v[i][2] * v[i][2] + v[i][3] * v[i][3]); }
        const float rstd = __builtin_amdgcn_rsqf(wave_sum(q) * (1.0f / EW) + EPS_);
        float* sv = a.out + OFF_SV + ((size_t)layerA * MS_ + b) * EW; bf16* ts = (bf16*)(ws + WS_TS) + (size_t)b * EW;
#pragma unroll
        for (int i = 0; i < 8; ++i) {
            const int e = 256 * i + 4 * lane;
            const f32x4 vn = v[i] * rstd * *(const f32x4*)(lg + e) + *(const f32x4*)(lb + e);
            *(f32x4*)(sv + e) = vn;
            const float w00 = wsrc[(size_t)i * 128 * 128], b00 = bs[i * 128];
            const int pe = 256 * (e >> 7) + (e & 127);
            const f32x4 uu = *(const f32x4*)(zs + pe), gg = *(const f32x4*)(zs + pe + 128);
            u32x2 w; w.x = cvt_pk_bf16(uu[0] * (w00 * vn[0] + b00) * silu_f(gg[0]), uu[1] * (w00 * vn[1] + b00) * silu_f(gg[1]));
            w.y = cvt_pk_bf16(uu[2] * (w00 * vn[2] + b00) * silu_f(gg[2]), uu[3] * (w00 * vn[3] + b00) * silu_f(gg[3]));
            *(u32x2*)(ts + e) = w;
        }
    }
}

__device__ __forceinline__ void conv_b_phase(const Args& a, int G) {
    const int tid = opaque_tid();
    unsigned char* ws = a.ws;
    const bf16* BGG = (const bf16*)(ws + WS_Z); const bf16* P = BGG + (size_t)M_ * EW; bf16* T = (bf16*)(ws + WS_T);
    const float* cw = a.in[15];
    const int NIT = (M_ / 32) * 256;
#define UNPK8(dst, v) do { dst[0] = bflo(v.x); dst[1] = bfhi(v.x); dst[2] = bflo(v.y); dst[3] = bfhi(v.y); dst[4] = bflo(v.z); dst[5] = bfhi(v.z); dst[6] = bflo(v.w); dst[7] = bfhi(v.w); } while (0)
    for (int item = blockIdx.x * 512 + tid; item < NIT; item += G * 512) {
        const int cc = item & 255, rb = item >> 8, r0 = 32 * rb, c0 = 8 * cc;
        float w0[8], w1[8], w2[8];
#pragma unroll
        for (int q = 0; q < 8; ++q) { w0[q] = cw[c0 + q]; w1[q] = cw[EW + c0 + q]; w2[q] = cw[2 * EW + c0 + q]; }
        float p2[8], p1[8];
        if ((r0 & (SEQ_ - 1)) == 0) {
#pragma unroll
            for (int q = 0; q < 8; ++q) { p2[q] = 0.f; p1[q] = 0.f; }
        } else {
            const u32x4 pa = *(const u32x4*)(P + (size_t)(r0 - 2) * EW + c0), pb = *(const u32x4*)(P + (size_t)(r0 - 1) * EW + c0);
            UNPK8(p2, pa); UNPK8(p1, pb);
        }
#pragma unroll 8
        for (int rr = 0; rr < 32; ++rr) {
            const size_t row = (size_t)r0 + rr;
            const u32x4 bgv = *(const u32x4*)(BGG + row * EW + c0), pv = *(const u32x4*)(P + row * EW + c0);
            float p0[8], bgf[8];
            UNPK8(p0, pv); UNPK8(bgf, bgv);
            float o[8];
#pragma unroll
            for (int q = 0; q < 8; ++q) { o[q] = bgf[q] * (w0[q] * p2[q] + w1[q] * p1[q] + w2[q] * p0[q]); }
            u32x4 w; w.x = cvt_pk_bf16(o[0], o[1]); w.y = cvt_pk_bf16(o[2], o[3]); w.z = cvt_pk_bf16(o[4], o[5]); w.w = cvt_pk_bf16(o[6], o[7]);
            *(u32x4*)(T + row * EW + c0) = w;
            const int t = (int)(row & (SEQ_ - 1));
            if (t >= SEQ_ - 2) {
                float* sp = a.out + OFF_SCP + ((size_t)(row >> 13) * 2 + (t - (SEQ_ - 2))) * EW + c0;
                *(f32x4*)sp = (f32x4){p0[0], p0[1], p0[2], p0[3]}; *(f32x4*)(sp + 4) = (f32x4){p0[4], p0[5], p0[6], p0[7]};
            }
#pragma unroll
            for (int q = 0; q < 8; ++q) { p2[q] = p1[q]; p1[q] = p0[q]; }
        }
    }
#undef UNPK8
    for (int item = blockIdx.x * 512 + tid; item < MS_ * EW; item += G * 512) {
        const int b = item >> 11, c = item & (EW - 1), pc = 256 * (c >> 7) + (c & 127);
        const float* zs = (const float*)(ws + WS_ZS) + (size_t)b * N_BIN;
        const float* st = a.in[2] + (size_t)b * 2 * EW;
        const float pr0 = st[c], pr1 = st[EW + c], pn = zs[2 * EW + pc] * zs[2 * EW + pc + 128];
        const float conv = cw[c] * pr0 + cw[EW + c] * pr1 + cw[2 * EW + c] * pn;
        const float o = zs[pc] * conv * silu_f(zs[pc + 128]);
        ((bf16*)(ws + WS_TS))[(size_t)b * EW + c] = (bf16)(cvt_pk_bf16(o, 0.f) & 0xffffu);
        float* so = a.out + OFF_SCS + (size_t)b * 2 * EW; so[c] = pr1; so[EW + c] = pn;
    }
}

namespace att {
#define KSWZ(row, colB) ((row) * 256 + ((colB) ^ (((row) & 7) << 4)))
__device__ __forceinline__ int crow(int r, int hi) { return (r & 3) + 8 * (r >> 2) + 4 * hi; }
__device__ __forceinline__ int v_st(int k, int c) { const int kk = (k & ~0xC) | ((k & 4) << 1) | ((k & 8) >> 1); return ((kk >> 3) * 4 + (c >> 5)) * 512 + ((kk & 7) * 32 + (c & 31)) * 2; }
__device__ __forceinline__ int v_rd_base(int lane) { return ((lane & 3) << 3) | (((lane >> 2) & 3) << 6) | (((lane >> 4) & 1) << 5) | (((lane >> 5) & 1) << 8); }
constexpr int v_rd_off(int d0, int ks, int half) { return d0 * 512 + ks * 4096 + half * 2048; }
template <int OFF> __device__ __forceinline__ s16x4 tr_read(int vb) { s16x4 r; asm volatile("ds_read_b64_tr_b16 %0, %1 offset:%2" : "=&v"(r) : "v"(vb), "i"(OFF) : "memory"); return r; }
constexpr int SHM_T = 16384;
constexpr int OST_OFF = 4 * SHM_T, OST_PITCH = 272, OST_WAVE = 32 * OST_PITCH;

template <int OFF>
__device__ __forceinline__ void qkt_half(f32x16& p, int kbase, int r32, int hi, const bf16x8 (&qr)[8]) {
    p = (f32x16){};
    asm volatile("" : "+v"(r32), "+v"(hi));
    const int rowb = kbase + r32 * 256, sw = (r32 & 7) << 4;
#pragma unroll
    for (int d0 = 0; d0 < 8; ++d0) {
        const bf16x8 b0 = *(const LAS bf16x8*)(uintptr_t)(unsigned)(rowb + ((((d0 & 3) * 32) + hi * 16) ^ sw) + (d0 >> 2) * 128 + OFF);
        p = __builtin_amdgcn_mfma_f32_32x32x16_bf16(b0, qr[d0], p, 0, 0, 0); }
}
template <int D0, int KS0, int BUFOFF> __device__ __forceinline__ void pv_half(f32x16& od, int vb, bf16x8 pa0, bf16x8 pa1) {
    const s16x4 l0 = tr_read<v_rd_off(D0, KS0, 0) + BUFOFF>(vb), h0 = tr_read<v_rd_off(D0, KS0, 1) + BUFOFF>(vb), l1 = tr_read<v_rd_off(D0, KS0 + 1, 0) + BUFOFF>(vb), h1 = tr_read<v_rd_off(D0, KS0 + 1, 1) + BUFOFF>(vb);
    asm volatile("s_waitcnt lgkmcnt(0)" ::: "memory"); __builtin_amdgcn_sched_barrier(0);
#define PKV(L, H) (bf16x8){L[0], L[1], L[2], L[3], H[0], H[1], H[2], H[3]}
    od = __builtin_amdgcn_mfma_f32_32x32x16_bf16(PKV(l0, h0), pa0, od, 0, 0, 0);
    od = __builtin_amdgcn_mfma_f32_32x32x16_bf16(PKV(l1, h1), pa1, od, 0, 0, 0);
#undef PKV
}
struct UnitInfo { int g, b, h, qbg, first, dsh; };
__device__ __forceinline__ UnitInfo decode(int U) { UnitInfo u; u.qbg = U & 31; u.h = (U >> 5) & 15; u.b = (U >> 9) & 1; u.g = U >> 10; u.dsh = 2 * u.g; u.first = ((u.qbg & ((32 >> u.dsh) - 1)) == 0) ? 1 : 0; return u; }
}

__device__ __forceinline__ void attn_c_phase(LAS unsigned char* lds, const Args& a, int G) {
    using namespace att;
    const int tid = threadIdx.x, lane = tid & 63, wave = __builtin_amdgcn_readfirstlane(tid >> 6), r32 = lane & 31, hi = lane >> 5, wp = wave >> 1;
    unsigned char* ws = a.ws;
    const bf16* QKV = (const bf16*)(ws + WS_Z); bf16* OG = (bf16*)(ws + WS_OG); float* LSE = (float*)(ws + WS_LSE);
    LAS unsigned char* V_lds = lds; LAS unsigned char* K_lds = lds + 2 * SHM_T;
    LAS unsigned char* ost = lds + OST_OFF + wave * OST_WAVE;
    constexpr float C = ATT_SCALE * LOG2E;
    const int kbase = (int)(uintptr_t)K_lds;
    constexpr int NU = 3 * 2 * 16 * 32;
    const bool contig = (NU % G) == 0; const int upb = contig ? NU / G : (NU + G - 1) / G;
    const int hupb = upb >> 1;
#define UNIT_HALF(L_, hbase_) ((((L_) >> 8) * 16 + (hbase_) + (((L_) >> 5) & 7)) * 32 + ((L_) & 31))
#define UNIT_ID(i) ((contig && (upb & 1) == 0) ? ((i) < hupb ? UNIT_HALF((int)blockIdx.x * hupb + (i), 8) : UNIT_HALF((int)blockIdx.x * hupb + (i) - hupb, 0)) : (contig ? (int)blockIdx.x * upb + (i) : (int)blockIdx.x + G * (i)))
#define UNIT_OK(i) ((i) < upb && UNIT_ID(i) < NU)
    int nun = 0; for (int i = 0; i < upb; ++i) nun += UNIT_OK(i) ? 1 : 0;
#define RUN_LEN(i0_, out_) do { int n_ = 1; while ((i0_) + n_ < nun && UNIT_ID((i0_) + n_) == UNIT_ID((i0_) + n_ - 1) + 1 && !decode(UNIT_ID((i0_) + n_)).first) ++n_; out_ = n_; } while (0)
    int l_i0 = 0, l_nu = 1, l_tau = 0; const bf16* l_kp = QKV; const bf16* l_vp = QKV;
    if (nun > 0) { RUN_LEN(0, l_nu); l_tau = decode(UNIT_ID(0)).first ? 2 : 0; }
    bf16x8 ra_k0 = {}, ra_k1 = {}, ra_v0 = {}, ra_v1 = {}, rb_k0 = {}, rb_k1 = {}, rb_v0 = {}, rb_v1 = {};
#define ISSUE(K0, K1, V0, V1) do { if (l_i0 < nun) { const UnitInfo _u = decode(UNIT_ID(l_i0)); \
            const size_t _hb = (((size_t)(_u.g) * 2 + _u.b) * 16 + _u.h) * SEQ_; const long _sp = (long)256 * _u.qbg - 128 + 64 * l_tau; \
            l_kp = QKV + ((size_t)(1 * 3) * 2 * 16 * SEQ_ + _hb + _sp) * 128; l_vp = QKV + ((size_t)(2 * 3) * 2 * 16 * SEQ_ + _hb + _sp) * 128; \
            l_tau += 1; if (l_tau > 4 * l_nu + 1) { l_i0 += l_nu; if (l_i0 < nun) { RUN_LEN(l_i0, l_nu); l_tau = decode(UNIT_ID(l_i0)).first ? 2 : 0; } } } \
        int t_ = tid; asm volatile("" : "+v"(t_)); const unsigned ldoff = (unsigned)((t_ >> 4) * 256 + (t_ & 15) * 16);     \
        K0 = *(const bf16x8*)((const char*)l_kp + ldoff); K1 = *(const bf16x8*)((const char*)l_kp + 8192 + ldoff); \
        V0 = *(const bf16x8*)((const char*)l_vp + ldoff); V1 = *(const bf16x8*)((const char*)l_vp + 8192 + ldoff); } while (0)
#define SWRITE(buf, K0, K1, V0, V1) do { int t_ = tid; asm volatile("" : "+v"(t_)); const int sr_ = t_ >> 4, sc_ = (t_ & 15) * 8; \
        const int vstA = (int)(uintptr_t)V_lds + v_st(sr_, sc_), kstA = (int)(uintptr_t)K_lds + KSWZ(sr_, sc_ * 2); \
        *(LAS bf16x8*)(uintptr_t)(unsigned)(vstA + (buf) * SHM_T) = V0; *(LAS bf16x8*)(uintptr_t)(unsigned)(vstA + (buf) * SHM_T + 8192) = V1; \
        *(LAS bf16x8*)(uintptr_t)(unsigned)(kstA + (buf) * SHM_T) = K0; *(LAS bf16x8*)(uintptr_t)(unsigned)(kstA + (buf) * SHM_T + 8192) = K1; } while (0)
#define QLOAD(uidx) do { const UnitInfo _q = decode(UNIT_ID(uidx)); \
        const bf16* qp = QKV + (((((size_t)_q.g) * 2 + _q.b) * 16 + _q.h) * SEQ_ + 256 * _q.qbg + 32 * wave + r32) * 128 + hi * 8; \
        _Pragma("unroll") for (int d0 = 0; d0 < 8; ++d0) qr[d0] = *(const bf16x8*)(qp + d0 * 16); } while (0)
#define EPILOGUE(uidx) do { const UnitInfo _e = decode(UNIT_ID(uidx)); const float inv = __builtin_amdgcn_rcpf(l_reg); \
        _Pragma("unroll") for (int d0 = 0; d0 < 4; ++d0) _Pragma("unroll") for (int i = 0; i < 4; ++i) { \
            u32x2 w_; w_.x = cvt_pk_bf16(o[d0][4 * i] * inv, o[d0][4 * i + 1] * inv); w_.y = cvt_pk_bf16(o[d0][4 * i + 2] * inv, o[d0][4 * i + 3] * inv); \
            *(LAS u32x2*)(ost + r32 * OST_PITCH + (32 * d0 + 8 * i + 4 * hi) * 2) = w_; } \
        const int lsh_ = 13 - _e.dsh, lmask_ = (1 << lsh_) - 1; \
        { const int sp_ = 256 * _e.qbg + 32 * wave + r32; const int t_ = (sp_ >> lsh_) + ((sp_ & lmask_) << _e.dsh); \
            LSE[((size_t)_e.g * M_ + (size_t)_e.b * SEQ_ + t_) * 16 + _e.h] = m_reg * ATT_SCALE + __logf(l_reg); } \
        LDS_WAIT(); asm volatile("" ::: "memory"); \
        _Pragma("unroll") for (int i = 0; i < 8; ++i) { const int ch_ = lane + 64 * i, row_ = ch_ >> 4, c16_ = ch_ & 15; \
            const u32x4 w_ = *(const LAS u32x4*)(ost + row_ * OST_PITCH + c16_ * 16); \
            const int sp_ = 256 * _e.qbg + 32 * wave + row_; const int t_ = (sp_ >> lsh_) + ((sp_ & lmask_) << _e.dsh); \
            *(u32x4*)(OG + ((size_t)_e.g * M_ + (size_t)_e.b * SEQ_ + t_) * EW + _e.h * 128 + c16_ * 8) = w_; \
            if (i & 1) asm volatile("" ::: "memory"); } \
        LDS_WAIT(); asm volatile("" ::: "memory"); } while (0)
    if (nun > 0) {
        ISSUE(ra_k0, ra_k1, ra_v0, ra_v1); ISSUE(rb_k0, rb_k1, rb_v0, rb_v1);
        SWRITE(0, ra_k0, ra_k1, ra_v0, ra_v1);
        __syncthreads();
        bf16x8 qr[8];
        float m_reg = -1e30f, l_reg = 0.f; f32x16 o[4] = {};
        int i0 = 0;
        while (i0 < nun) {
            int nu; RUN_LEN(i0, nu);
            const int tau0 = decode(UNIT_ID(i0)).first ? 2 : 0;
            QLOAD(i0);
            for (int tau = tau0; tau <= 4 * nu + 1; tau += 2) {
#pragma unroll
                for (int par = 0; par < 2; ++par) {
                    const int tt = tau + par, k = tt - wp, n = k >> 2, ph = k & 3;
                    const bool valid = (k >= 0) && (n < nu);
                    if (valid && ph == 3) {
                        EPILOGUE(i0 + n);
                        QLOAD(i0 + (n + 1 < nu ? n + 1 : n));
                        if (par == 0) ISSUE(ra_k0, ra_k1, ra_v0, ra_v1); else ISSUE(rb_k0, rb_k1, rb_v0, rb_v1);
                        if (par == 0) SWRITE(1, rb_k0, rb_k1, rb_v0, rb_v1); else SWRITE(0, ra_k0, ra_k1, ra_v0, ra_v1);
                    } else {
                        if (par == 0) ISSUE(ra_k0, ra_k1, ra_v0, ra_v1); else ISSUE(rb_k0, rb_k1, rb_v0, rb_v1);
                        if (valid) {
                            const int jj = ph + wp;
                            if (ph == 0 || tt == tau0) { m_reg = -1e30f; l_reg = 0.f;
#pragma unroll
                                for (int d = 0; d < 4; ++d) o[d] = (f32x16){}; }
#define HALF_STEP(HH, PAR) do { \
        const bool skip_ = (HH == 0) ? ((wave & 1) && ph == 0) : (!(wave & 1) && ph == 2); \
        if (!skip_) { \
            f32x16 p; qkt_half<(PAR) * SHM_T + (HH) * 8192>(p, kbase, r32, hi, qr); \
            const bool lowb_ = (ph == 0) && ((wave & 1) ? (HH == 1) : (HH == 0)); const bool upb_ = (ph == 2) && ((wave & 1) ? (HH == 1) : (HH == 0)); \
            if (lowb_ || upb_) { const int base = 64 * jj + 32 * (HH) - 32 * wave - r32 + 4 * hi; \
                _Pragma("unroll") for (int r = 0; r < 16; ++r) { const int kx = base + (r & 3) + 8 * (r >> 2); p[r] = ((unsigned)kx <= 128u) ? p[r] : -INFINITY; } } \
            float pmax = p[0]; \
            _Pragma("unroll") for (int r = 1; r < 16; ++r) pmax = fmaxf(pmax, p[r]); \
            { auto rr = __builtin_amdgcn_permlane32_swap(__float_as_uint(pmax), __float_as_uint(pmax), false, false); pmax = fmaxf(__uint_as_float(rr[0]), __uint_as_float(rr[1])); } \
            const float mn = fmaxf(m_reg, pmax); const float alpha = __builtin_amdgcn_exp2f((m_reg - mn) * C); m_reg = mn; \
            const float mnC = -mn * C; \
            _Pragma("unroll") for (int r = 0; r < 16; ++r) p[r] = __builtin_amdgcn_exp2f(fmaf(p[r], C, mnC)); \
            float ps = 0.f; \
            _Pragma("unroll") for (int r = 0; r < 16; ++r) ps += p[r]; \
            { auto rr = __builtin_amdgcn_permlane32_swap(__float_as_uint(ps), __float_as_uint(ps), false, false); ps = __uint_as_float(rr[0]) + __uint_as_float(rr[1]); } \
            l_reg = l_reg * alpha + ps; \
            if (!__all(alpha == 1.0f)) { _Pragma("unroll") for (int d = 0; d < 4; ++d) _Pragma("unroll") for (int r = 0; r < 16; ++r) o[d][r] *= alpha; } \
            bf16x8 pa0, pa1; \
            PK4(p, 0, pa0); PK4(p, 8, pa1); \
            int l_ = lane; asm volatile("" : "+v"(l_)); const int vb0 = (int)(uintptr_t)V_lds + v_rd_base(l_); \
            pv_half<0, 2 * (HH), (PAR) * SHM_T>(o[0], vb0, pa0, pa1); pv_half<1, 2 * (HH), (PAR) * SHM_T>(o[1], vb0, pa0, pa1); \
            pv_half<2, 2 * (HH), (PAR) * SHM_T>(o[2], vb0, pa0, pa1); pv_half<3, 2 * (HH), (PAR) * SHM_T>(o[3], vb0, pa0, pa1); } } while (0)
#define PK4(P, BASE, OUT) do { unsigned a0 = cvt_pk_bf16(P[BASE + 0], P[BASE + 1]), a1 = cvt_pk_bf16(P[BASE + 2], P[BASE + 3]); \
    unsigned b0 = cvt_pk_bf16(P[BASE + 4], P[BASE + 5]), b1 = cvt_pk_bf16(P[BASE + 6], P[BASE + 7]); \
    auto r0 = __builtin_amdgcn_permlane32_swap(a0, b0, false, false); auto r1 = __builtin_amdgcn_permlane32_swap(a1, b1, false, false); \
    u32x4 w = {r0[0], r1[0], r0[1], r1[1]}; OUT = __builtin_bit_cast(bf16x8, w); } while (0)
                            if (par == 0) { HALF_STEP(0, 0); HALF_STEP(1, 0); } else { HALF_STEP(0, 1); HALF_STEP(1, 1); }
#undef PK4
#undef HALF_STEP
                        }
                        if (par == 0) SWRITE(1, rb_k0, rb_k1, rb_v0, rb_v1); else SWRITE(0, ra_k0, ra_k1, ra_v0, ra_v1);
                    }
                    __syncthreads();
                }
            }
            if (wp == 3) EPILOGUE(i0 + nu - 1);
            i0 += nu;
        }
    }
    __syncthreads();
#undef ISSUE
#undef SWRITE
#undef QLOAD
#undef EPILOGUE
#undef RUN_LEN
#undef UNIT_ID
#undef UNIT_HALF
#undef UNIT_OK
}

__device__ __forceinline__ void attn_c_sample(LAS unsigned char* lds, const Args& a, int G) {
    const int tid = opaque_tid(), lane = tid & 63, wave = __builtin_amdgcn_readfirstlane(tid >> 6);
    unsigned char* ws = a.ws;
    const float* rope = (const float*)(ws + WS_ROPE) + (size_t)SEQ_ * 16 * 2;
    constexpr int TSK = 768 * 4;
    for (int pp = blockIdx.x; pp < 256; pp += G) {
        __syncthreads();
        if (wave < 6) {
            const int pr = wave / 3, g = wave - 3 * pr, P = 2 * pp + pr, b = P >> 4, h = P & 15;
            LAS float* sm = (LAS float*)(lds + wave * TSK);
            LAS float* qs = sm, *ks = sm + 128, *vs = sm + 256, *psm = sm + 384, *os = sm + 512, *misc = sm + 640;
            const float* zs = (const float*)(ws + WS_ZS) + (size_t)b * N_CIN;
            const int dil = 1 << (2 * g), win = 128 << (2 * g);
            const float* cache = a.in[3 + g] + (size_t)b * win * 4096;
            float* kvs = a.out + (g == 0 ? OFF_KV128S : (g == 1 ? OFF_KV512S : OFF_KV2048S)) + (size_t)b * 4096 + h * 128;
            {
                const int cq = g * EW + h * 128 + 2 * lane;
                const f32x2 qv = *(const f32x2*)(zs + cq), kv = *(const f32x2*)(zs + 3 * EW + cq), vv = *(const f32x2*)(zs + 6 * EW + cq);
                if (lane < 16) { const float c = rope[2 * lane], s = rope[2 * lane + 1];
                    const float q1 = qv.x * c - qv.y * s, q2 = qv.y * c + qv.x * s, k1 = kv.x * c - kv.y * s, k2 = kv.y * c + kv.x * s;
                    qs[lane] = q1; qs[lane + 16] = q2; ks[lane] = k1; ks[lane + 16] = k2; kvs[lane] = k1; kvs[lane + 16] = k2; }
                else { qs[2 * lane] = qv.x; qs[2 * lane + 1] = qv.y; ks[2 * lane] = kv.x; ks[2 * lane + 1] = kv.y; kvs[2 * lane] = kv.x; kvs[2 * lane + 1] = kv.y; }
                vs[2 * lane] = vv.x; vs[2 * lane + 1] = vv.y; kvs[2048 + 2 * lane] = vv.x; kvs[2048 + 2 * lane + 1] = vv.y;
            }
            LDS_WAIT(); asm volatile("" ::: "memory");
            const float* k0p = cache + ((size_t)(dil * lane) * 2) * 2048 + h * 128; const float* k1p = cache + ((size_t)(dil * (lane + 64)) * 2) * 2048 + h * 128;
            float s0 = 0.f, s1 = 0.f;
#pragma unroll 8
            for (int dc = 0; dc < 32; ++dc) { const f32x4 q4 = *(const LAS f32x4*)(qs + 4 * dc); const f32x4 ka = *(const f32x4*)(k0p + 4 * dc), kb = *(const f32x4*)(k1p + 4 * dc);
                s0 += (q4[0] * ka[0] + q4[1] * ka[1]) + (q4[2] * ka[2] + q4[3] * ka[3]); s1 += (q4[0] * kb[0] + q4[1] * kb[1]) + (q4[2] * kb[2] + q4[3] * kb[3]); }
            float sn = qs[2 * lane] * ks[2 * lane] + qs[2 * lane + 1] * ks[2 * lane + 1]; sn = wave_sum(sn);
            s0 *= ATT_SCALE; s1 *= ATT_SCALE; sn *= ATT_SCALE;
            const float mx = fmaxf(wave_max(fmaxf(s0, s1)), sn);
            const float e0 = __expf(s0 - mx), e1 = __expf(s1 - mx), en = __expf(sn - mx);
            const float den = wave_sum(e0 + e1) + en;
            psm[lane] = e0; psm[lane + 64] = e1;
            LDS_WAIT(); asm volatile("" ::: "memory");
            f32x2 acc = (f32x2){en * vs[2 * lane], en * vs[2 * lane + 1]};
            const float* vp = cache + 2048 + h * 128 + 2 * lane;
#pragma unroll 16
            for (int i = 0; i < 128; ++i) { const f32x2 vv = *(const f32x2*)(vp + (size_t)(dil * i) * 4096); const float pi = psm[i]; acc.x += pi * vv.x; acc.y += pi * vv.y; }
            const float rden = 1.0f / den;
            os[2 * lane] = acc.x * rden; os[2 * lane + 1] = acc.y * rden;
            if (lane == 0) misc[0] = mx + __logf(den);
        }
        __syncthreads();
        if (wave < 2) {
            const int P = 2 * pp + wave, b = P >> 4, h = P & 15;
            LAS float* s0 = (LAS float*)(lds + (3 * wave + 0) * TSK), *s1 = (LAS float*)(lds + (3 * wave + 1) * TSK), *s2 = (LAS float*)(lds + (3 * wave + 2) * TSK);
            const float l0 = s0[640], l1 = s1[640], l2 = s2[640]; const float mx = fmaxf(l0, fmaxf(l1, l2));
            const float w0 = __expf(l0 - mx), w1 = __expf(l1 - mx), w2 = __expf(l2 - mx); const float rs = 1.0f / (w0 + w1 + w2);
            const float* zs = (const float*)(ws + WS_ZS) + (size_t)b * N_CIN + 9 * EW + h * 128;
            const float oa = (w0 * s0[512 + 2 * lane] + w1 * s1[512 + 2 * lane] + w2 * s2[512 + 2 * lane]) * rs;
            const float ob = (w0 * s0[512 + 2 * lane + 1] + w1 * s1[512 + 2 * lane + 1] + w2 * s2[512 + 2 * lane + 1]) * rs;
            ((unsigned*)(ws + WS_TS))[((size_t)b * EW + h * 128) / 2 + lane] = cvt_pk_bf16(oa * silu_f(zs[2 * lane]), ob * silu_f(zs[2 * lane + 1]));
        }
    }
    __syncthreads();
}

__device__ __forceinline__ void combine_c_phase(const Args& a, int G) {
    unsigned char* ws = a.ws;
    const bf16* OG = (const bf16*)(ws + WS_OG); const float* LSE = (const float*)(ws + WS_LSE); const bf16* GATE = (const bf16*)(ws + WS_GATE); bf16* T = (bf16*)(ws + WS_T);
    const int NIT = M_ * 256;
    const int ctid = opaque_tid();
    for (int item = blockIdx.x * 512 + ctid; item < NIT; item += G * 512) {
        const int row = item >> 8, ch = item & 255, h = ch >> 4;
        const float l0 = LSE[((size_t)0 * M_ + row) * 16 + h], l1 = LSE[((size_t)1 * M_ + row) * 16 + h], l2 = LSE[((size_t)2 * M_ + row) * 16 + h];
        const float mx = fmaxf(l0, fmaxf(l1, l2)); float w0 = __expf(l0 - mx), w1 = __expf(l1 - mx), w2 = __expf(l2 - mx); const float rs = 1.0f / (w0 + w1 + w2); w0 *= rs; w1 *= rs; w2 *= rs;
        const size_t off = (size_t)row * EW + ch * 8;
        const u32x4 a0 = *(const u32x4*)(OG + off), a1 = *(const u32x4*)(OG + (size_t)M_ * EW + off), a2 = *(const u32x4*)(OG + (size_t)2 * M_ * EW + off), gg = *(const u32x4*)(GATE + off);
        u32x4 w;
        w.x = cvt_pk_bf16((w0 * bflo(a0.x) + w1 * bflo(a1.x) + w2 * bflo(a2.x)) * silu_f(bflo(gg.x)), (w0 * bfhi(a0.x) + w1 * bfhi(a1.x) + w2 * bfhi(a2.x)) * silu_f(bfhi(gg.x)));
        w.y = cvt_pk_bf16((w0 * bflo(a0.y) + w1 * bflo(a1.y) + w2 * bflo(a2.y)) * silu_f(bflo(gg.y)), (w0 * bfhi(a0.y) + w1 * bfhi(a1.y) + w2 * bfhi(a2.y)) * silu_f(bfhi(gg.y)));
        w.z = cvt_pk_bf16((w0 * bflo(a0.z) + w1 * bflo(a1.z) + w2 * bflo(a2.z)) * silu_f(bflo(gg.z)), (w0 * bfhi(a0.z) + w1 * bfhi(a1.z) + w2 * bfhi(a2.z)) * silu_f(bfhi(gg.z)));
        w.w = cvt_pk_bf16((w0 * bflo(a0.w) + w1 * bflo(a1.w) + w2 * bflo(a2.w)) * silu_f(bflo(gg.w)), (w0 * bfhi(a0.w) + w1 * bfhi(a1.w) + w2 * bfhi(a2.w)) * silu_f(bfhi(gg.w)));
        *(u32x4*)(T + off) = w;
    }
    const bf16* QKV = (const bf16*)(ws + WS_Z);
    constexpr int NKV0 = 2 * 128 * 512, NKV1 = 2 * 512 * 512, NKV2 = 2 * 2048 * 512;
    for (int item = blockIdx.x * 512 + ctid; item < NKV0 + NKV1 + NKV2; item += G * 512) {
        int idx = item, g = 0; if (idx >= NKV0) { idx -= NKV0; g = 1; if (idx >= NKV1) { idx -= NKV1; g = 2; } }
        const int dsh = 2 * g, lsh = 13 - dsh, wsh = 7 + dsh, win = 1 << wsh;
        const int d8 = idx & 15, h = (idx >> 4) & 15, kv = (idx >> 8) & 1, pp = (idx >> 9) & (win - 1), b = idx >> (9 + wsh);
        const int t = SEQ_ - win + pp, sp = ((t & ((1 << dsh) - 1)) << lsh) | (t >> dsh);
        const bf16* src = QKV + ((((size_t)((1 + kv) * 3 + g) * 2 + b) * 16 + h) * SEQ_ + sp) * 128;
        float* dst = a.out + (g == 0 ? OFF_KV128P : (g == 1 ? OFF_KV512P : OFF_KV2048P)) + (size_t)idx * 8;
        f32x4 o0, o1;
        if (kv == 0 && d8 < 4) {
            const u32x4 w0 = *(const u32x4*)(src + 16 * (d8 & 1)), w1 = *(const u32x4*)(src + 16 * (d8 & 1) + 8);
            if (d8 < 2) { o0 = (f32x4){bflo(w0.x), bflo(w0.y), bflo(w0.z), bflo(w0.w)}; o1 = (f32x4){bflo(w1.x), bflo(w1.y), bflo(w1.z), bflo(w1.w)}; }
            else        { o0 = (f32x4){bfhi(w0.x), bfhi(w0.y), bfhi(w0.z), bfhi(w0.w)}; o1 = (f32x4){bfhi(w1.x), bfhi(w1.y), bfhi(w1.z), bfhi(w1.w)}; }
        } else {
            const u32x4 w0 = *(const u32x4*)(src + 8 * d8);
            o0 = (f32x4){bflo(w0.x), bfhi(w0.x), bflo(w0.y), bfhi(w0.y)}; o1 = (f32x4){bflo(w0.z), bfhi(w0.z), bflo(w0.w), bfhi(w0.w)};
        }
        *(f32x4*)dst = o0; *(f32x4*)(dst + 4) = o1;
    }
}

__device__ __forceinline__ void final_phase(const Args& a, int G) {
    const int tid = opaque_tid(), lane = tid & 63, wave = tid >> 6;
    unsigned char* ws = a.ws;
    const bf16* hbf = (const bf16*)(ws + WS_HB); const float* ssq = (const float*)(ws + WS_SSQP) + (size_t)4 * M_ * 16; const float* fw = a.in[7];
    const int gw = blockIdx.x * NWAVES + wave, NGW = G * NWAVES;
    f32x4 wv[4];
#pragma unroll
    for (int j = 0; j < 4; ++j) wv[j] = *((const f32x4*)fw + lane + 64 * j);
    for (int m = gw; m < M_ + MS_; m += NGW) {
        const bool smp = m >= M_;
        f32x4 v[4]; float s = 0.f;
        if (smp) { const f32x4* xr = (const f32x4*)((const float*)(ws + WS_HS) + (size_t)(m - M_) * DM) + lane;
#pragma unroll
            for (int j = 0; j < 4; ++j) { v[j] = xr[64 * j]; s += (v[j][0] * v[j][0] + v[j][1] * v[j][1]) + (v[j][2] * v[j][2] + v[j][3] * v[j][3]); } }
        else { const u32x2* xr = (const u32x2*)(hbf + (size_t)m * DM) + lane;
#pragma unroll
            for (int j = 0; j < 4; ++j) { const u32x2 r = xr[64 * j]; v[j] = (f32x4){bflo(r.x), bfhi(r.x), bflo(r.y), bfhi(r.y)}; } }
        if (smp) s = wave_sum(s);
        else { float p = (lane < 16) ? ssq[(size_t)m * 16 + lane] : 0.f; s = wave_sum(p); }
        const float rstd = __builtin_amdgcn_rsqf(s * (1.0f / DM) + EPS_);
        f32x4* o = (f32x4*)(a.out + (smp ? OFF_YS + (size_t)(m - M_) * DM : OFF_Y + (size_t)m * DM)) + lane;
#pragma unroll
        for (int j = 0; j < 4; ++j) o[64 * j] = v[j] * rstd * wv[j];
    }
}

__global__ void __launch_bounds__(NWAVES * 64, 2) hybrid_fwd(Args args) {
    extern __shared__ __attribute__((aligned(16))) unsigned char lds_raw[];
    LAS unsigned char* lds = (LAS unsigned char*)lds_raw;
    volatile LAS unsigned* MISC = (volatile LAS unsigned*)(lds + MISC_OFF);
    const int tid = opaque_tid();
    const int G = gridDim.x;
    unsigned char* ws = args.ws;
    unsigned* ctl = (unsigned*)(ws + WS_CTL);
    if (tid < 32) MISC[tid] = 0u;
    __syncthreads();
    XcdBarrier bar; bar.bar = ctl + CW_BAR; bar.x = 0; bar.st = nullptr;
    if (!MK_SPLIT) bar = xcd_barrier_post(ctl + CW_BAR, MISC + 8);
    const int lo = args.ph_lo, hi = args.ph_hi;
#ifndef PHASE_MASK
#define PHASE_MASK 0x7fff
#endif
#define IN(k) (lo <= (k) && (k) < hi && ((PHASE_MASK >> (k)) & 1))
#define SEAM(k) do { if (IN(k) && IN((k) + 1)) xcd_barrier(bar); } while (0)
    float* ssqp = (float*)(ws + WS_SSQP);
    bf16* HB = (bf16*)(ws + WS_HB); float* HP = (float*)(ws + WS_HP); bf16* T = (bf16*)(ws + WS_T); bf16* Z = (bf16*)(ws + WS_Z);
    float* HS = (float*)(ws + WS_HS); float* ZS = (float*)(ws + WS_ZS); bf16* TS = (bf16*)(ws + WS_TS);

#ifndef STAGGER_TICKS
#define STAGGER_TICKS 0
#endif
#define STAGGER() do { if (STAGGER_TICKS) { const unsigned long long t0_ = __builtin_amdgcn_s_memrealtime(); const unsigned long long d_ = (unsigned long long)(((unsigned)blockIdx.x >> 3) & 3u) * STAGGER_TICKS; \
        while (__builtin_amdgcn_s_memrealtime() - t0_ < d_) __builtin_amdgcn_s_sleep(8); } } while (0)
#define GEMM_IN(WOFF, NN, SSQL, LNP, SLO, SHI) do { \
        pg8::Gemm g{HB, (const bf16*)(ws + (WOFF)), M_, (NN), DM}; pg8::StaticOrder S; S.init(M_, (NN), G, (int)blockIdx.x); \
        pg8::Unit u0_; u0_.pm = -1; if (S.next(0, u0_)) pg8::stage_rstd(lds, ssqp + (size_t)(SSQL) * M_ * 16, u0_.pm); \
        pg8::EpiIn E{Z, Z + (size_t)M_ * EW, ssqp + (size_t)(SSQL) * M_ * 16, (LNP), (SLO), (SHI), lds + pg8::RS_OFF, u0_.pm}; \
        pg8::gemm_phase<pg8::EpiIn, pg8::StaticOrder, true, true>(lds, g, S, E); \
        sample_in_gemm(lds, HS, (const bf16*)(ws + (WOFF)), (NN), ZS, G); } while (0)
#define GEMM_OUT(WOFF, RES, SSQL) do { \
        pg8::Gemm g{T, (const bf16*)(ws + (WOFF)), M_, DM, EW}; pg8::StaticOrder S; S.init(M_, DM, G, (int)blockIdx.x); \
        pg8::EpiOut E{HB, ssqp + (size_t)(SSQL) * M_ * 16}; \
        pg8::gemm_phase<pg8::EpiOut, pg8::StaticOrder, true, true>(lds, g, S, E); \
        sample_out_gemm(lds, TS, (const bf16*)(ws + (WOFF)), HS, G); } while (0)
#define GEMM_CIN() do { STAGGER(); \
        pg8::Gemm g{HB, (const bf16*)(ws + WS_WC_IN), M_, N_CIN, DM}; pg8::COrder S; S.init(M_, N_CIN, G, (int)blockIdx.x); \
        pg8::Unit u0_; u0_.pm = -1; if (S.next(0, u0_)) pg8::stage_rstd(lds, ssqp + (size_t)2 * M_ * 16, u0_.pm); \
        pg8::EpiCin E{Z, (bf16*)(ws + WS_GATE), ssqp + (size_t)2 * M_ * 16, (const float*)(ws + WS_ROPE), args.out, lds + pg8::RS_OFF, u0_.pm}; \
        pg8::gemm_phase<pg8::EpiCin, pg8::COrder, true, true>(lds, g, S, E); \
        sample_in_gemm(lds, HS, (const bf16*)(ws + WS_WC_IN), N_CIN, ZS, G); } while (0)
#define PH0 p0_prologue(args, lds, G)
#define PH1 GEMM_IN(WS_WA_IN0, N_AIN, 0, (float*)(ws + WS_LNP), 16, 16)
#define PH2 mix_a_phase(lds, args, 0, G)
#define PH3 GEMM_OUT(WS_WA_OUT0, args.in[0], 1)
#define PH4 GEMM_IN(WS_WB_IN, N_BIN, 1, (float*)nullptr, 16, 32)
#define PH5 conv_b_phase(args, G)
#define PH6 GEMM_OUT(WS_WB_OUT, HP, 2)
#define PH7 GEMM_CIN()
#define PH8 do { attn_c_phase(lds, args, G); if ((DUPMASK >> 16) & 1) attn_c_phase(lds, args, G); attn_c_sample(lds, args, G); if ((DUPMASK >> 15) & 1) attn_c_sample(lds, args, G); } while (0)
#define PH9 combine_c_phase(args, G)
#define PH10 GEMM_OUT(WS_WC_OUT, HP, 3)
#define PH11 GEMM_IN(WS_WA_IN1, N_AIN, 3, (float*)(ws + WS_LNP), 16, 16)
#define PH12 mix_a_phase(lds, args, 1, G)
#define PH13 GEMM_OUT(WS_WA_OUT1, HP, 4)
#define PH14 final_phase(args, G)
#define RUN(k) do { if (IN(k)) { PH##k; if ((DUPMASK >> (k)) & 1) { PH##k; } } SEAM(k); } while (0)
    RUN(0);
    RUN(1); RUN(2); RUN(3);
    RUN(4); RUN(5); RUN(6);
    RUN(7); RUN(8); RUN(9); RUN(10);
    RUN(11); RUN(12); RUN(13);
    RUN(14);
#undef IN
#undef SEAM
}

extern "C" void kernel_launch(void* const* d_in, const int* in_sizes, int n_in, void* d_out, int out_size, void* d_ws, size_t ws_size, hipStream_t stream) {
    static int grid = 0;
    if (grid == 0) {
        if (n_in != 19 || (size_t)out_size != OUT_TOTAL || ws_size < WS_END) { fprintf(stderr, "kernel_launch: unexpected shapes: n_in %d out %d ws %zu\n", n_in, out_size, ws_size); grid = -1; return; }
        int dev = 0, cus = 0, per_cu = 0;
        if (hipGetDevice(&dev) != hipSuccess || hipDeviceGetAttribute(&cus, hipDeviceAttributeMultiprocessorCount, dev) != hipSuccess) { grid = -1; return; }
        if (hipFuncSetAttribute((const void*)hybrid_fwd, hipFuncAttributeMaxDynamicSharedMemorySize, LDS_BYTES) != hipSuccess) { fprintf(stderr, "kernel_launch: hipFuncSetAttribute failed\n"); grid = -1; return; }
        if (hipOccupancyMaxActiveBlocksPerMultiprocessor(&per_cu, (const void*)hybrid_fwd, NWAVES * 64, LDS_BYTES) != hipSuccess || per_cu < 1) { fprintf(stderr, "kernel_launch: occupancy query says %d\n", per_cu); }
        (void)hipGetLastError();
        grid = cus;
    }
    if (grid < 0) return;
    (void)hipMemsetAsync((char*)d_ws + WS_CTL, 0, CTL_ZERO_BYTES, stream);
    Args a{};
    for (int i = 0; i < 19; ++i) a.in[i] = (const float*)d_in[i];
    a.out = (float*)d_out; a.ws = (unsigned char*)d_ws;
#if MK_SPLIT
    for (int k = 0; k < NPH; ++k) { a.ph_lo = k; a.ph_hi = k + 1; hipLaunchKernelGGL(hybrid_fwd, dim3(grid), dim3(NWAVES * 64), LDS_BYTES, stream, a); }
#else
    a.ph_lo = 0; a.ph_hi = NPH;
    hipLaunchKernelGGL(hybrid_fwd, dim3(grid), dim3(NWAVES * 64), LDS_BYTES, stream, a);
#endif
    const hipError_t le = hipPeekAtLastError();
    if (le != hipSuccess) fprintf(stderr, "kernel_launch: launch failed: %s\n", hipGetErrorName(le));
}
```

```cpp
#include <hip/hip_runtime.h>
#include <cstdio>
#include <cstdint>

#ifndef MK_SPLIT
#define MK_SPLIT 0
#endif

#ifndef DUPMASK
#define DUPMASK 0
#endif
#define LAS __attribute__((address_space(3)))
#define GAS __attribute__((address_space(1)))
typedef unsigned short bf16;
typedef short bf16x8 __attribute__((ext_vector_type(8)));
typedef short s16x4 __attribute__((ext_vector_type(4)));
typedef float f32x2 __attribute__((ext_vector_type(2)));
typedef float f32x4 __attribute__((ext_vector_type(4)));
typedef float f32x16 __attribute__((ext_vector_type(16)));
typedef unsigned u32x2 __attribute__((ext_vector_type(2)));
typedef unsigned u32x4 __attribute__((ext_vector_type(4)));

constexpr int M_ = 16384, MS_ = 32, DM = 1024, EW = 2048, SEQ_ = 8192;
constexpr int N_AIN = 3 * EW, N_BIN = 4 * EW, N_CIN = 10 * EW;
constexpr float EPS_ = 1e-6f;
constexpr float LOG2E = 1.4426950408889634f;
constexpr float ATT_SCALE = 0.08838834764831845f;

constexpr size_t OFF_Y = 0, OFF_YS = 16777216, OFF_SV = 16809984, OFF_SCP = 16941056, OFF_SCS = 16949248;
constexpr size_t OFF_KV128P = 17080320, OFF_KV128S = 18128896, OFF_KV512P = 18259968, OFF_KV512S = 22454272, OFF_KV2048P = 22585344, OFF_KV2048S = 39362560;
constexpr size_t OUT_TOTAL = 39493632;

constexpr size_t MiB = 1u << 20;
constexpr size_t WS_CTL = 0, CTL_ZERO_BYTES = 32 * 1024;
constexpr size_t WS_ROPE = 1 * MiB;
constexpr size_t WS_WTRIL = 3 * MiB;
constexpr size_t WS_WA_IN0 = 4 * MiB, WS_WA_IN1 = 16 * MiB, WS_WB_IN = 28 * MiB, WS_WC_IN = 44 * MiB;
constexpr size_t WS_WA_OUT0 = 84 * MiB, WS_WA_OUT1 = 88 * MiB, WS_WB_OUT = 92 * MiB, WS_WC_OUT = 96 * MiB;
constexpr size_t WS_HP = 100 * MiB;
constexpr size_t WS_HB = 164 * MiB;
constexpr size_t WS_T = 196 * MiB;
constexpr size_t WS_SSQP = 260 * MiB;
constexpr size_t WS_LNP = 266 * MiB;
constexpr size_t WS_HS = 270 * MiB;
constexpr size_t WS_ZS = 271 * MiB;
constexpr size_t WS_TS = 274 * MiB;
constexpr size_t WS_LSE = 275 * MiB;
constexpr size_t WS_Z = 288 * MiB;
constexpr size_t WS_GATE = WS_Z + 576 * MiB;
constexpr size_t WS_OG = 928 * MiB;
constexpr size_t WS_END = 1120 * MiB;

constexpr int CW_BAR = 4096;

constexpr int LDS_BYTES = 147456;
constexpr int MISC_OFF = 140 * 1024;
constexpr int NWAVES = 8;
constexpr int NPH = 15;

__device__ __forceinline__ unsigned cvt_pk_bf16(float lo, float hi) { unsigned r; asm("v_cvt_pk_bf16_f32 %0, %1, %2" : "=v"(r) : "v"(lo), "v"(hi)); return r; }
__device__ __forceinline__ float bflo(unsigned w) { return __uint_as_float(w << 16); }
__device__ __forceinline__ float bfhi(unsigned w) { return __uint_as_float(w & 0xffff0000u); }
__device__ __forceinline__ float silu_f(float x) { return x * __builtin_amdgcn_rcpf(1.0f + __builtin_amdgcn_exp2f(-x * LOG2E)); }
__device__ __forceinline__ unsigned pk4_fp8(float a, float b, float c, float d) { int w = __builtin_amdgcn_cvt_pk_fp8_f32(a, b, 0, false); w = __builtin_amdgcn_cvt_pk_fp8_f32(c, d, w, true); return (unsigned)w; }
__device__ __forceinline__ void unpk4_fp8(unsigned w, float& a, float& b, float& c, float& d) { const f32x2 lo = __builtin_amdgcn_cvt_pk_f32_fp8((int)w, false), hi = __builtin_amdgcn_cvt_pk_f32_fp8((int)w, true); a = lo.x; b = lo.y; c = hi.x; d = hi.y; }
constexpr float OG_SCALE = 8.0f;

__device__ __forceinline__ float wave_sum(float v) {
#pragma unroll
    for (int o = 1; o < 64; o <<= 1) v += __shfl_xor(v, o);
    return v;
}
__device__ __forceinline__ float wave_max(float v) {
#pragma unroll
    for (int o = 1; o < 64; o <<= 1) v = fmaxf(v, __shfl_xor(v, o));
    return v;
}
__device__ __forceinline__ int opaque_tid() { int t = threadIdx.x; asm volatile("" : "+v"(t)); return t; }
#define LDS_WAIT() asm volatile("s_waitcnt lgkmcnt(0)" ::: "memory")
#define VM_WAIT() asm volatile("s_waitcnt vmcnt(0)" ::: "memory")

namespace pg8 {
constexpr int BM = 256, BK = 64, HALF = 128, HTB = HALF * BK * 2, STAGE_BYTES = 8 * HTB, NXCD = 8, WGM = 8;
__host__ __device__ __forceinline__ int lds_byte(int r, int c) { const int st = (r >> 4) * 2 + (c >> 5), rr = r & 15, cc = c & 31, ob = rr * 64 + cc * 2; return st * 1024 + (ob ^ (((ob >> 9) & 1) << 5)); }
__host__ __device__ __forceinline__ void stage_rc(int b, int& R, int& C) { const int st = b / 1024, sb = b % 1024, swz = sb ^ (((sb >> 9) & 1) << 5); R = (st >> 1) * 16 + swz / 64; C = (st & 1) * 32 + (swz % 64) / 2; }
__host__ __device__ __forceinline__ int perm32(int rho) { const int n = rho >> 4, i = rho & 15; return 8 * (i >> 2) + 4 * n + (i & 3); }

struct Unit { int pm, pn; };
struct Gemm { const bf16* A; const bf16* Bt; int M, N, K; };

struct StaticOrder {
    int nM, nN, nwg, G, c;
    __host__ __device__ void init(int M, int N, int G_, int c_) { nM = M / BM; nN = N / BM; nwg = nM * nN; G = G_; c = c_; }
    __host__ __device__ __forceinline__ bool next(int i, Unit& u) const {
        const long L = (long)i * G + c; if (L >= nwg) return false;
        int wgid = (int)L; { const int q = nwg / NXCD, r = nwg % NXCD, xcd = wgid % NXCD, off = wgid / NXCD; wgid = (xcd < r ? xcd * (q + 1) : r * (q + 1) + (xcd - r) * q) + off; }
        const int nig = WGM * nN, gid = wgid / nig, fm = gid * WGM, gsz = (nM - fm) < WGM ? (nM - fm) : WGM;
        u.pm = fm + ((wgid % nig) % gsz); u.pn = (wgid % nig) / gsz; return true;
    }
    __device__ __forceinline__ void a_ready(const Unit&) const {}
    __device__ __forceinline__ void done(const Unit&) const {}
};

template <class Epi, class Sched, bool ALIGN_EPI = false, bool SP2 = false>
__device__ __forceinline__ void gemm_phase(LAS unsigned char* lds, const Gemm g, const Sched& S, const Epi& E) {
    const int tid = opaque_tid(), wid = __builtin_amdgcn_readfirstlane(tid >> 6), lane = tid & 63, wr = wid >> 2, wc = wid & 3, fr = lane & 15, fq = lane >> 4;
    const int K = g.K, nt = K / BK;
    unsigned voffA[2], voffB[2];
#pragma unroll
    for (int i = 0; i < 2; ++i) { int R, C; stage_rc(tid * 16 + i * 8192, R, C); const int Rb = Epi::PERM ? ((R & ~31) + perm32(R & 31)) : R;
        voffA[i] = (unsigned)(R * K + C) * 2u; voffB[i] = (unsigned)(Rb * K + C) * 2u; }
    const size_t kstep = (size_t)(BK * 2);
    const size_t hstep = (size_t)HALF * K * 2;
    const size_t tstep = 2 * hstep;
    const unsigned ldsw = (unsigned)wid * 1024u;
    const int aoff = lds_byte(wr * 64 + fr, fq * 8), boff = lds_byte(wc * 32 + fr, fq * 8);
#define PG8_SA(b, h) (((b) * 2 + (h)) * HTB)
#define PG8_SB(b, h) ((4 + (b) * 2 + (h)) * HTB)
#define PG8_STAGE(bufoff, gbase, voff) do { _Pragma("unroll") for (int _i = 0; _i < 2; ++_i) \
        __builtin_amdgcn_global_load_lds((const unsigned*)((const char*)(gbase) + (voff)[_i]), (LAS unsigned*)(lds + (bufoff) + ldsw + _i * 8192), 16, 0, 0); } while (0)
#define PG8_LDA(dst, b, h) do { _Pragma("unroll") for (int m = 0; m < 4; ++m) _Pragma("unroll") for (int k = 0; k < 2; ++k) dst[m][k] = *(const LAS bf16x8*)(lds + PG8_SA(b, h) + aoff + m * 2048 + k * 1024); } while (0)
#define PG8_LDB(dst, b, h) do { _Pragma("unroll") for (int n = 0; n < 2; ++n) _Pragma("unroll") for (int k = 0; k < 2; ++k) dst[n][k] = *(const LAS bf16x8*)(lds + PG8_SB(b, h) + boff + n * 2048 + k * 1024); } while (0)
#define PG8_MMA(ai, bj, At, Bt) do { __builtin_amdgcn_s_setprio(1); _Pragma("unroll") for (int m = 0; m < 4; ++m) _Pragma("unroll") for (int n = 0; n < 2; ++n) _Pragma("unroll") for (int k = 0; k < 2; ++k) \
        acc[ai][bj][m][n] = __builtin_amdgcn_mfma_f32_16x16x32_bf16(Bt[n][k], At[m][k], acc[ai][bj][m][n], 0, 0, 0); __builtin_amdgcn_s_setprio(0); } while (0)
#define PG8_WAIT_V(n) asm volatile("s_waitcnt vmcnt(" #n ")" ::: "memory")
#define PG8_WAIT_L(n) asm volatile("s_waitcnt lgkmcnt(" #n ")" ::: "memory")
#define PG8_BAR __builtin_amdgcn_s_barrier()
#define PG8_SCHED __builtin_amdgcn_sched_barrier(0)
    Unit cur, nxt; int ui = 0;
    if (!S.next(0, cur)) return;
    f32x4 acc[2][2][4][2];
#pragma unroll
    for (int a = 0; a < 2; ++a)
#pragma unroll
        for (int b = 0; b < 2; ++b)
#pragma unroll
            for (int m = 0; m < 4; ++m)
#pragma unroll
                for (int n = 0; n < 2; ++n) acc[a][b][m][n] = (f32x4){0.f, 0.f, 0.f, 0.f};
    bf16x8 At[4][2], B0[2][2], B1[2][2];
    const char* cA = (const char*)g.A + (size_t)cur.pm * tstep; const char* cB = (const char*)g.Bt + (size_t)cur.pn * tstep;
    S.a_ready(cur);
    if constexpr (SP2) {
        PG8_STAGE(PG8_SB(0, 0), cB, voffB); PG8_STAGE(PG8_SB(0, 1), cB + hstep, voffB); PG8_STAGE(PG8_SA(0, 0), cA, voffA); PG8_STAGE(PG8_SA(0, 1), cA + hstep, voffA);
        if (wr == 1) PG8_BAR;
        PG8_WAIT_V(2); PG8_BAR;
        PG8_STAGE(PG8_SB(1, 0), cB + kstep, voffB); PG8_STAGE(PG8_SA(1, 0), cA + kstep, voffA); PG8_STAGE(PG8_SB(1, 1), cB + hstep + kstep, voffB);
        PG8_WAIT_V(6); PG8_BAR;
    } else {
        PG8_STAGE(PG8_SB(0, 0), cB, voffB); PG8_STAGE(PG8_SA(0, 0), cA, voffA); PG8_STAGE(PG8_SB(0, 1), cB + hstep, voffB); PG8_STAGE(PG8_SA(0, 1), cA + hstep, voffA);
        if (wr == 1) PG8_BAR;
        PG8_WAIT_V(4); PG8_BAR;
        PG8_STAGE(PG8_SB(1, 0), cB + kstep, voffB); PG8_STAGE(PG8_SA(1, 0), cA + kstep, voffA); PG8_STAGE(PG8_SB(1, 1), cB + hstep + kstep, voffB);
        PG8_WAIT_V(6); PG8_BAR;
    }
    for (;;) {
        const bool has_next = S.next(ui + 1, nxt);
        const char* nA = has_next ? (const char*)g.A + (size_t)nxt.pm * tstep : cA; const char* nB = has_next ? (const char*)g.Bt + (size_t)nxt.pn * tstep : cB;
        for (int t = 0; t < nt; t += 2) {
            const bool last = (t == nt - 2);
            const char* a1 = cA + (size_t)(t + 1) * kstep;
            const char* a2 = last ? nA : cA + (size_t)(t + 2) * kstep; const char* b2 = last ? nB : cB + (size_t)(t + 2) * kstep;
            const char* a3 = a2 + kstep; const char* b3 = b2 + kstep;
            if (last && has_next) S.a_ready(nxt);
            if constexpr (SP2) {
            PG8_LDB(B0, 0, 0); PG8_LDB(B1, 0, 1); PG8_SCHED; PG8_LDA(At, 0, 0); PG8_STAGE(PG8_SA(1, 1), a1 + hstep, voffA);
            PG8_WAIT_V(8); PG8_WAIT_L(0); PG8_BAR; PG8_MMA(0, 0, At, B0); PG8_MMA(0, 1, At, B1); PG8_BAR; PG8_SCHED;
            PG8_LDA(At, 0, 1); PG8_STAGE(PG8_SB(0, 0), b2, voffB); PG8_STAGE(PG8_SB(0, 1), b2 + hstep, voffB); PG8_STAGE(PG8_SA(0, 0), a2, voffA);
            PG8_WAIT_V(8); PG8_WAIT_L(0); PG8_BAR; PG8_MMA(1, 0, At, B0); PG8_MMA(1, 1, At, B1); PG8_BAR; PG8_SCHED;
            PG8_LDB(B0, 1, 0); PG8_LDB(B1, 1, 1); PG8_SCHED; PG8_LDA(At, 1, 0); PG8_STAGE(PG8_SA(0, 1), a2 + hstep, voffA);
            PG8_WAIT_V(8); PG8_WAIT_L(0); PG8_BAR; PG8_MMA(0, 0, At, B0); PG8_MMA(0, 1, At, B1); PG8_BAR; PG8_SCHED;
            PG8_LDA(At, 1, 1); PG8_STAGE(PG8_SB(1, 0), b3, voffB); PG8_STAGE(PG8_SB(1, 1), b3 + hstep, voffB); PG8_STAGE(PG8_SA(1, 0), a3, voffA);
            PG8_WAIT_V(8); PG8_WAIT_L(0); PG8_BAR; PG8_MMA(1, 0, At, B0); PG8_MMA(1, 1, At, B1); PG8_BAR; PG8_SCHED;
            } else {
            PG8_LDB(B0, 0, 0); PG8_SCHED; PG8_LDA(At, 0, 0); PG8_STAGE(PG8_SA(1, 1), a1 + hstep, voffA);
            PG8_WAIT_L(8); PG8_BAR; PG8_WAIT_L(0); PG8_MMA(0, 0, At, B0); PG8_BAR; PG8_SCHED;
            PG8_LDB(B1, 0, 1); PG8_STAGE(PG8_SB(0, 0), b2, voffB);
            PG8_BAR; PG8_WAIT_L(0); PG8_MMA(0, 1, At, B1); PG8_BAR;
            PG8_LDA(At, 0, 1); PG8_STAGE(PG8_SA(0, 0), a2, voffA);
            PG8_BAR; PG8_WAIT_L(0); PG8_MMA(1, 0, At, B0); PG8_BAR; PG8_SCHED;
            PG8_STAGE(PG8_SB(0, 1), b2 + hstep, voffB);
            PG8_WAIT_V(6); PG8_BAR; PG8_MMA(1, 1, At, B1); PG8_BAR;
            PG8_LDB(B0, 1, 0); PG8_SCHED; PG8_LDA(At, 1, 0); PG8_STAGE(PG8_SA(0, 1), a2 + hstep, voffA);
            PG8_WAIT_L(8); PG8_BAR; PG8_WAIT_L(0); PG8_MMA(0, 0, At, B0); PG8_BAR; PG8_SCHED;
            PG8_LDB(B1, 1, 1); PG8_STAGE(PG8_SB(1, 0), b3, voffB);
            PG8_BAR; PG8_WAIT_L(0); PG8_MMA(0, 1, At, B1); PG8_BAR;
            PG8_LDA(At, 1, 1); PG8_STAGE(PG8_SA(1, 0), a3, voffA);
            PG8_BAR; PG8_WAIT_L(0); PG8_MMA(1, 0, At, B0); PG8_BAR; PG8_SCHED;
            PG8_STAGE(PG8_SB(1, 1), b3 + hstep, voffB);
            PG8_WAIT_V(6); PG8_BAR; PG8_MMA(1, 1, At, B1); PG8_BAR;
            }
        }
        if constexpr (ALIGN_EPI) { if (wr == 0) PG8_BAR; }
        E(acc, cur, wr, wc, fr, fq); S.done(cur);
        if (!has_next) break;
#pragma unroll
        for (int a = 0; a < 2; ++a)
#pragma unroll
            for (int b = 0; b < 2; ++b)
#pragma unroll
                for (int m = 0; m < 4; ++m)
#pragma unroll
                    for (int n = 0; n < 2; ++n) acc[a][b][m][n] = (f32x4){0.f, 0.f, 0.f, 0.f};
        cur = nxt; cA = nA; cB = nB; ++ui;
        if constexpr (ALIGN_EPI) { if (wr == 1) PG8_BAR; }
    }
    PG8_WAIT_V(0);
    if constexpr (!ALIGN_EPI) { if (wr == 0) PG8_BAR; }
    PG8_BAR;
#undef PG8_SA
#undef PG8_SB
#undef PG8_STAGE
#undef PG8_LDA
#undef PG8_LDB
#undef PG8_MMA
#undef PG8_WAIT_V
#undef PG8_WAIT_L
#undef PG8_BAR
#undef PG8_SCHED
}

#ifndef EPI_AUX
#define EPI_AUX 16
#endif
__device__ __forceinline__ __amdgpu_buffer_rsrc_t epi_rsrc(const void* base) { return __builtin_amdgcn_make_buffer_rsrc((void*)base, 0, 0x7fffffff, 0x00020000); }
__device__ __forceinline__ void epi_st16(__amdgpu_buffer_rsrc_t r, size_t elem_off, u32x4 v) { __builtin_amdgcn_raw_buffer_store_b128(v, r, (unsigned)(elem_off * 2), 0, EPI_AUX); }

__device__ __forceinline__ void epi_st8_bytes(__amdgpu_buffer_rsrc_t r, size_t byte_off, u32x2 v) { __builtin_amdgcn_raw_buffer_store_b64(v, r, (unsigned)byte_off, 0, EPI_AUX); }

__device__ __forceinline__ float row_rstd(const float* ssqp, int row, int fq) {
    const f32x4 pp = *(const f32x4*)(ssqp + (size_t)row * 16 + 4 * fq);
    float s = (pp[0] + pp[1]) + (pp[2] + pp[3]);
    s += __shfl_xor(s, 16); s += __shfl_xor(s, 32);
    return __builtin_amdgcn_rsqf(s * (1.0f / DM) + EPS_);
}

constexpr int RS_OFF = 132 * 1024;
__device__ __forceinline__ void stage_rstd(LAS unsigned char* lds, const float* ssqp, int pm) {
    const int tid = opaque_tid(), row = tid >> 1, half = tid & 1;
    const f32x4* p = (const f32x4*)(ssqp + ((size_t)pm * BM + row) * 16 + 8 * half);
    const f32x4 a = p[0], b = p[1];
    float s = ((a[0] + a[1]) + (a[2] + a[3])) + ((b[0] + b[1]) + (b[2] + b[3]));
    s += __shfl_xor(s, 1);
    if (half == 0) ((LAS float*)(lds + RS_OFF))[row] = __builtin_amdgcn_rsqf(s * (1.0f / DM) + EPS_);
    __syncthreads();
}
#define ROW_RSTD(row) ((u.pm == pm0) ? ((const LAS float*)(rsl))[(row) - pm0 * BM] : row_rstd(ssqp, (row), fq))

struct EpiIn {
    static constexpr bool PERM = true;
    bf16* O1; bf16* O2; const float* ssqp; float* lnp; int silu_hi, prod_hi; const LAS unsigned char* rsl; int pm0;
    __device__ __forceinline__ void operator()(const f32x4 (&acc)[2][2][4][2], const Unit& u, int wr, int wc, int fr, int fq) const {
        const int row0 = u.pm * BM + wr * 64 + fr, cw = wc * 32 + 8 * fq;
        if (u.pn < prod_hi) {
            const bool sl = u.pn < silu_hi;
            const __amdgpu_buffer_rsrc_t rs_ = epi_rsrc(O1);
            const size_t ob = sl ? (size_t)128 * u.pn : (size_t)(O2 - O1) + 128 * (u.pn - silu_hi);
#pragma unroll
            for (int ai = 0; ai < 2; ++ai)
#pragma unroll
                for (int m = 0; m < 4; ++m) {
                    const int row = row0 + ai * HALF + m * 16;
                    const float rstd = ROW_RSTD(row);
                    const f32x4 x0 = acc[ai][0][m][0] * rstd, x1 = acc[ai][0][m][1] * rstd; f32x4 y0 = acc[ai][1][m][0] * rstd, y1 = acc[ai][1][m][1] * rstd;
                    if (sl) {
#pragma unroll
                        for (int j = 0; j < 4; ++j) { y0[j] = silu_f(y0[j]); y1[j] = silu_f(y1[j]); }
                    }
                    u32x4 w; w.x = cvt_pk_bf16(x0[0] * y0[0], x0[1] * y0[1]); w.y = cvt_pk_bf16(x0[2] * y0[2], x0[3] * y0[3]); w.z = cvt_pk_bf16(x1[0] * y1[0], x1[1] * y1[1]); w.w = cvt_pk_bf16(x1[2] * y1[2], x1[3] * y1[3]);
                    epi_st16(rs_, ob + (size_t)row * EW + cw, w);
                }
            return;
        }
        const int tn = u.pn - prod_hi;
        const __amdgpu_buffer_rsrc_t rs2_ = epi_rsrc(O2);
#pragma unroll
        for (int ai = 0; ai < 2; ++ai)
#pragma unroll
            for (int m = 0; m < 4; ++m) {
                const int row = row0 + ai * HALF + m * 16;
                const float rstd = ROW_RSTD(row);
                const size_t rowo = (size_t)row * EW + tn * BM + cw;
                float ps = 0.f, pq = 0.f;
#pragma unroll
                for (int bj = 0; bj < 2; ++bj) {
                    const f32x4 v0 = acc[ai][bj][m][0] * rstd, v1 = acc[ai][bj][m][1] * rstd;
                    u32x4 w; w.x = cvt_pk_bf16(v0[0], v0[1]); w.y = cvt_pk_bf16(v0[2], v0[3]); w.z = cvt_pk_bf16(v1[0], v1[1]); w.w = cvt_pk_bf16(v1[2], v1[3]);
                    epi_st16(rs2_, rowo + bj * HALF, w);
                    ps += ((v0[0] + v0[1]) + (v0[2] + v0[3])) + ((v1[0] + v1[1]) + (v1[2] + v1[3]));
                    pq += ((v0[0] * v0[0] + v0[1] * v0[1]) + (v0[2] * v0[2] + v0[3] * v0[3])) + ((v1[0] * v1[0] + v1[1] * v1[1]) + (v1[2] * v1[2] + v1[3] * v1[3]));
                }
                ps += __shfl_xor(ps, 16); ps += __shfl_xor(ps, 32); pq += __shfl_xor(pq, 16); pq += __shfl_xor(pq, 32);
                if (fq == 0) *(f32x2*)(lnp + ((size_t)row * 32 + tn * 4 + wc) * 2) = (f32x2){ps, pq};
            }
    }
};

struct EpiOut {
    static constexpr bool PERM = true;
    bf16* hb; float* ssqn;
    __device__ __forceinline__ void operator()(const f32x4 (&acc)[2][2][4][2], const Unit& u, int wr, int wc, int fr, int fq) const {
        const int row0 = u.pm * BM + wr * 64 + fr, col0 = u.pn * BM + wc * 32 + 8 * fq;
        const __amdgpu_buffer_rsrc_t rsh_ = epi_rsrc(hb);
        u32x4 rv[2][4][2];
#pragma unroll
        for (int ai = 0; ai < 2; ++ai)
#pragma unroll
            for (int m = 0; m < 4; ++m)
#pragma unroll
                for (int bj = 0; bj < 2; ++bj) rv[ai][m][bj] = *(const u32x4*)(hb + (size_t)(row0 + ai * HALF + m * 16) * DM + col0 + bj * HALF);
#pragma unroll
        for (int ai = 0; ai < 2; ++ai)
#pragma unroll
            for (int m = 0; m < 4; ++m) {
                const int row = row0 + ai * HALF + m * 16;
                const size_t off = (size_t)row * DM + col0;
                float sq = 0.f;
#pragma unroll
                for (int bj = 0; bj < 2; ++bj) {
                    const u32x4 r = rv[ai][m][bj];
                    const f32x4 v0 = acc[ai][bj][m][0] + (f32x4){bflo(r.x), bfhi(r.x), bflo(r.y), bfhi(r.y)}, v1 = acc[ai][bj][m][1] + (f32x4){bflo(r.z), bfhi(r.z), bflo(r.w), bfhi(r.w)};
                    u32x4 w; w.x = cvt_pk_bf16(v0[0], v0[1]); w.y = cvt_pk_bf16(v0[2], v0[3]); w.z = cvt_pk_bf16(v1[0], v1[1]); w.w = cvt_pk_bf16(v1[2], v1[3]);
                    epi_st16(rsh_, off + bj * HALF, w);
                    sq += ((v0[0] * v0[0] + v0[1] * v0[1]) + (v0[2] * v0[2] + v0[3] * v0[3])) + ((v1[0] * v1[0] + v1[1] * v1[1]) + (v1[2] * v1[2] + v1[3] * v1[3]));
                }
                sq += __shfl_xor(sq, 16); sq += __shfl_xor(sq, 32);
                if (fq == 0) ssqn[(size_t)row * 16 + u.pn * 4 + wc] = sq;
            }
    }
};

struct EpiCin {
    static constexpr bool PERM = true;
    bf16* QKV; bf16* GATE; const float* ssqp; const float* rope; float* out; const LAS unsigned char* rsl; int pm0;
    __device__ __forceinline__ void operator()(const f32x4 (&acc)[2][2][4][2], const Unit& u, int wr, int wc, int fr, int fq) const {
        const int row0 = u.pm * BM + wr * 64 + fr;
        if (u.pn >= 72) {
            const int col0 = (u.pn - 72) * BM + wc * 32 + 8 * fq;
            const __amdgpu_buffer_rsrc_t rsg_ = epi_rsrc(GATE);
#pragma unroll
            for (int ai = 0; ai < 2; ++ai)
#pragma unroll
                for (int m = 0; m < 4; ++m) {
                    const int row = row0 + ai * HALF + m * 16;
                    const float rstd = ROW_RSTD(row);
                    const size_t rowo = (size_t)row * EW + col0;
#pragma unroll
                    for (int bj = 0; bj < 2; ++bj) {
                        const f32x4 v0 = acc[ai][bj][m][0] * rstd, v1 = acc[ai][bj][m][1] * rstd;
                        u32x2 w; w.x = pk4_fp8(silu_f(v0[0]), silu_f(v0[1]), silu_f(v0[2]), silu_f(v0[3])); w.y = pk4_fp8(silu_f(v1[0]), silu_f(v1[1]), silu_f(v1[2]), silu_f(v1[3]));
                        epi_st8_bytes(rsg_, rowo + bj * HALF, w);
                    }
                }
            return;
        }
        const int which = u.pn / 24, g = (u.pn % 24) >> 3, hp2 = u.pn & 7;
        const int dsh = 2 * g, lsh = 13 - dsh, dmask = (1 << dsh) - 1, win = 128 << dsh;
        const int b = u.pm >> 5;
        const bool do_rope = (which < 2) && (wc == 0);
        const __amdgpu_buffer_rsrc_t rsq_ = epi_rsrc(QKV);
        float ivr[4];
#pragma unroll
        for (int q = 0; q < 4; ++q) ivr[q] = __builtin_amdgcn_exp2f(-(float)(4 * fq + q) * 1.1832230355827609f - 2.651496129472319f);
#pragma unroll
        for (int ai = 0; ai < 2; ++ai)
#pragma unroll
            for (int m = 0; m < 4; ++m) {
                const int row = row0 + ai * HALF + m * 16;
                const int t = row & (SEQ_ - 1);
                const int sp = ((t & dmask) << lsh) | (t >> dsh);
                const float rstd = ROW_RSTD(row);
                f32x4 cs0 = (f32x4){1.f, 0.f, 1.f, 0.f}, cs1 = cs0;
                if (do_rope) { const float tf = (float)t;
                    const float r0 = __builtin_amdgcn_fractf(tf * ivr[0]), r1 = __builtin_amdgcn_fractf(tf * ivr[1]), r2 = __builtin_amdgcn_fractf(tf * ivr[2]), r3 = __builtin_amdgcn_fractf(tf * ivr[3]);
                    cs0 = (f32x4){__builtin_amdgcn_cosf(r0), __builtin_amdgcn_sinf(r0), __builtin_amdgcn_cosf(r1), __builtin_amdgcn_sinf(r1)};
                    cs1 = (f32x4){__builtin_amdgcn_cosf(r2), __builtin_amdgcn_sinf(r2), __builtin_amdgcn_cosf(r3), __builtin_amdgcn_sinf(r3)}; }
#pragma unroll
                for (int bj = 0; bj < 2; ++bj) {
                    const int h = 2 * hp2 + bj;
                    f32x4 v0 = acc[ai][bj][m][0] * rstd, v1 = acc[ai][bj][m][1] * rstd;
                    if (do_rope) {
                        const f32x4 a = v0, c = v1;
                        v0[0] = a[0] * cs0[0] - a[1] * cs0[1]; v0[1] = a[1] * cs0[0] + a[0] * cs0[1];
                        v0[2] = a[2] * cs0[2] - a[3] * cs0[3]; v0[3] = a[3] * cs0[2] + a[2] * cs0[3];
                        v1[0] = c[0] * cs1[0] - c[1] * cs1[1]; v1[1] = c[1] * cs1[0] + c[0] * cs1[1];
                        v1[2] = c[2] * cs1[2] - c[3] * cs1[3]; v1[3] = c[3] * cs1[2] + c[2] * cs1[3];
                    }
                    u32x4 w; w.x = cvt_pk_bf16(v0[0], v0[1]); w.y = cvt_pk_bf16(v0[2], v0[3]); w.z = cvt_pk_bf16(v1[0], v1[1]); w.w = cvt_pk_bf16(v1[2], v1[3]);
                    epi_st16(rsq_, ((((size_t)(which * 3 + g) * 2 + b) * 16 + h) * SEQ_ + sp) * 128 + wc * 32 + 8 * fq, w);
                }
            }
    }
};
}

#define XB_TMO      128
#define XB_XCNT(j)  (256  + 64 * (j))
#define XB_XSUB(j)  (1280 + 64 * (j))
#define XB_XGEN(j)  (2304 + 64 * (j))
#define XB_TOP      3328
#define XB_TOPGEN   3392
#define XCD_BAR_WORDS 3456
#define XB_SPIN_CAP (1u << 18)

__device__ __forceinline__ unsigned xb_ld(unsigned* p)              { return __hip_atomic_load(p, __ATOMIC_RELAXED, __HIP_MEMORY_SCOPE_AGENT); }
__device__ __forceinline__ unsigned xb_add(unsigned* p, unsigned v) { return __hip_atomic_fetch_add(p, v, __ATOMIC_RELAXED, __HIP_MEMORY_SCOPE_AGENT); }
__device__ __forceinline__ unsigned xb_xcc_id() { return (unsigned)__builtin_amdgcn_s_getreg((3 << 11) | 20) & 0xFu; }
#define XB_SPIN(cond, bar) do { unsigned _sp = 0; while (cond) { __builtin_amdgcn_s_sleep(1); \
    if ((++_sp & 255u) == 0u) { if (xb_ld(&(bar)[XB_TMO])) break; if (_sp > XB_SPIN_CAP) { atomicAdd(&(bar)[XB_TMO], 1u); break; } } } } while (0)

struct XcdBarrier { unsigned* bar; unsigned x; volatile LAS unsigned* st; };

__device__ __forceinline__ XcdBarrier xcd_barrier_post(unsigned* bar, volatile LAS unsigned* st) {
    XcdBarrier b; b.bar = bar; b.x = xb_xcc_id(); b.st = st;
    if (threadIdx.x == 0) (void)xb_add(&bar[XB_XCNT(b.x)], 1u);
    return b;
}
__device__ __forceinline__ void xcd_barrier_complete(unsigned* bar, unsigned x, unsigned& nloc, unsigned& nx) {
    const unsigned G = gridDim.x * gridDim.y * gridDim.z;
    unsigned sum, cnt, mine, sp = 0u;
    for (;;) {
        sum = 0u; cnt = 0u; mine = 0u;
#pragma unroll
        for (unsigned j = 0; j < 16; ++j) { const unsigned c = xb_ld(&bar[XB_XCNT(j)]); sum += c; cnt += (c > 0u) ? 1u : 0u; mine = (j == x) ? c : mine; }
        if (sum == G) break;
        __builtin_amdgcn_s_sleep(1);
        if ((++sp & 255u) == 0u) { if (xb_ld(&bar[XB_TMO])) break; if (sp > XB_SPIN_CAP) { atomicAdd(&bar[XB_TMO], 1u); break; } }
    }
    nloc = mine > 0u ? mine : 1u; nx = cnt > 0u ? cnt : 1u;
}
__device__ __forceinline__ void xcd_barrier(const XcdBarrier& b) {
    asm volatile("s_waitcnt vmcnt(0)" ::: "memory");
    __syncthreads();
    if (threadIdx.x == 0) {
        unsigned* bar = b.bar;
        __builtin_amdgcn_s_waitcnt(0);
        unsigned nloc = b.st[0], nx = b.st[1];
        if (nloc == 0u) { xcd_barrier_complete(bar, b.x, nloc, nx); b.st[0] = nloc; b.st[1] = nx; }
        const unsigned old = xb_add(&bar[XB_XSUB(b.x)], 1u);
        const unsigned gen = old / nloc;
        if (old + 1u == (gen + 1u) * nloc) {
            __builtin_amdgcn_fence(__ATOMIC_RELEASE, "agent");
            asm volatile("s_waitcnt vmcnt(0)" ::: "memory");
            const unsigned og = xb_add(&bar[XB_TOP], 1u);
            const unsigned tg = og / nx;
            if (og + 1u == (tg + 1u) * nx) xb_add(&bar[XB_TOPGEN], 1u);
            else XB_SPIN(xb_ld(&bar[XB_TOPGEN]) == tg, bar);
            __builtin_amdgcn_fence(__ATOMIC_ACQUIRE, "agent");
            xb_add(&bar[XB_XGEN(b.x)], 1u);
            asm volatile("s_waitcnt vmcnt(0)" ::: "memory");
        } else {
            XB_SPIN(xb_ld(&bar[XB_XGEN(b.x)]) == gen, bar);
            __builtin_amdgcn_fence(__ATOMIC_ACQUIRE, "agent");
            asm volatile("s_waitcnt vmcnt(0)" ::: "memory");
        }
    }
    __syncthreads();
}

struct Args { const float* in[19]; float* out; unsigned char* ws; int ph_lo, ph_hi; };

__device__ __forceinline__ void p0_transpose_item(const float* W, int K, int N, bf16* WT, const float* scale, bool ropeperm, LAS float* scr, int kb, int nb, int lane, int sn0) {
    const int k0 = 64 * kb, n0 = 32 * nb;
    float tv[32];
#pragma unroll
    for (int i = 0; i < 32; ++i) { const int kk = 2 * i + (lane >> 5); tv[i] = W[(size_t)(k0 + kk) * N + sn0 + (lane & 31)]; }
    const float sc0 = scale ? scale[k0 + lane] : 1.0f;
#pragma unroll
    for (int i = 0; i < 32; ++i) { const int kk = 2 * i + (lane >> 5); scr[kk * 33 + (lane & 31)] = tv[i] * __shfl(sc0, kk); }
    LDS_WAIT(); asm volatile("" ::: "memory");
    const int c = lane & 7;
#pragma unroll
    for (int j = 0; j < 4; ++j) { const int n = (lane >> 3) + 8 * j; const int sn = ropeperm ? ((n >> 1) + ((n & 1) << 4)) : n; const LAS float* s = scr + (8 * c) * 33 + sn;
        u32x4 o; o.x = cvt_pk_bf16(s[0 * 33], s[1 * 33]); o.y = cvt_pk_bf16(s[2 * 33], s[3 * 33]); o.z = cvt_pk_bf16(s[4 * 33], s[5 * 33]); o.w = cvt_pk_bf16(s[6 * 33], s[7 * 33]);
        *(u32x4*)(WT + (size_t)(n0 + n) * K + k0 + 8 * c) = o; }
    LDS_WAIT(); asm volatile("" ::: "memory");
}

__device__ __forceinline__ void p0_prologue(const Args& a, LAS unsigned char* lds, int G) {
    const int tid = opaque_tid(), lane = tid & 63, wave = tid >> 6;
    unsigned char* ws = a.ws;
    LAS float* scr = (LAS float*)(lds + wave * 16384);
    const int gw = blockIdx.x * NWAVES + wave, NGW = G * NWAVES;
    constexpr int I_AIN = (DM / 64) * (N_AIN / 32), I_BIN = (DM / 64) * (N_BIN / 32), I_CIN = (DM / 64) * (N_CIN / 32), I_OUT = (EW / 64) * (DM / 32);
    constexpr int NITEMS = 2 * I_AIN + I_BIN + I_CIN + 4 * I_OUT;
    for (int it = gw; it < NITEMS; it += NGW) {
        int r = it;
        if (r < 2 * I_AIN) { const int la = r >= I_AIN; if (la) r -= I_AIN; const int nb = r % (N_AIN / 32), n0 = 32 * nb, tile = n0 >> 8, wi = n0 & 255;
            const int sn0 = tile < 16 ? (wi < 128 ? 128 * tile + wi : 2 * EW + 128 * tile + wi - 128) : EW + 256 * (tile - 16) + wi;
            p0_transpose_item(a.in[8] + (size_t)la * DM * N_AIN, DM, N_AIN, (bf16*)(ws + (la ? WS_WA_IN1 : WS_WA_IN0)), a.in[6] + (la ? 3 : 0) * DM, false, scr, r / (N_AIN / 32), nb, lane, sn0); continue; } r -= 2 * I_AIN;
        if (r < I_BIN) { const int nb = r % (N_BIN / 32), n0 = 32 * nb, tile = n0 >> 8, wi = n0 & 255, t2 = tile - 16;
            const int sn0 = tile < 16 ? (wi < 128 ? 128 * tile + wi : 3 * EW + 128 * tile + wi - 128) : (wi < 128 ? EW + 128 * t2 + wi : 2 * EW + 128 * t2 + wi - 128);
            p0_transpose_item(a.in[14], DM, N_BIN, (bf16*)(ws + WS_WB_IN), a.in[6] + 1 * DM, false, scr, r / (N_BIN / 32), nb, lane, sn0); continue; } r -= I_BIN;
        if (r < I_CIN) { const int nb = r % (N_CIN / 32);
            const bool ropeperm = (nb * 32 < 2 * 3 * EW) && ((nb & 3) == 0);
            p0_transpose_item(a.in[17], DM, N_CIN, (bf16*)(ws + WS_WC_IN), a.in[6] + 2 * DM, ropeperm, scr, r / (N_CIN / 32), nb, lane, 32 * nb); continue; } r -= I_CIN;
        const int which = r / I_OUT; r -= which * I_OUT;
        const float* src = which == 0 ? a.in[13] : (which == 1 ? a.in[13] + (size_t)EW * DM : (which == 2 ? a.in[16] : a.in[18]));
        bf16* dst = (bf16*)(ws + (which == 0 ? WS_WA_OUT0 : (which == 1 ? WS_WA_OUT1 : (which == 2 ? WS_WB_OUT : WS_WC_OUT))));
        p0_transpose_item(src, EW, DM, dst, nullptr, false, scr, r / (DM / 32), r % (DM / 32), lane, 32 * (r % (DM / 32)));
    }
    {
        const float* x = a.in[0]; bf16* hb = (bf16*)(ws + WS_HB); float* ssq0 = (float*)(ws + WS_SSQP);
        for (int m = gw; m < M_; m += NGW) {
            const f32x4* xr = (const f32x4*)(x + (size_t)m * DM) + lane;
            f32x4 v[4]; float s = 0.f;
#pragma unroll
            for (int j = 0; j < 4; ++j) { v[j] = xr[64 * j]; s += (v[j][0] * v[j][0] + v[j][1] * v[j][1]) + (v[j][2] * v[j][2] + v[j][3] * v[j][3]); }
            s = wave_sum(s);
            u32x2* o8 = (u32x2*)(hb + (size_t)m * DM) + lane;
#pragma unroll
            for (int j = 0; j < 4; ++j) { u32x2 w; w.x = cvt_pk_bf16(v[j][0], v[j][1]); w.y = cvt_pk_bf16(v[j][2], v[j][3]); o8[64 * j] = w; }
            if (lane < 16) ssq0[(size_t)m * 16 + lane] = (lane == 0) ? s : 0.f;
        }
    }
    const int gt = blockIdx.x * (NWAVES * 64) + tid, NGT = G * NWAVES * 64;
    { const float* xs = a.in[1]; float* hs = (float*)(ws + WS_HS); for (int i = gt; i < MS_ * DM; i += NGT) hs[i] = xs[i]; }
    { f32x2* rope = (f32x2*)(ws + WS_ROPE);
      for (int i = SEQ_ * 16 + gt; i < (SEQ_ + 1) * 16; i += NGT) { const int pos = i >> 4, k = i & 15;
          const float inv = (float)pow(500000.0, -(double)k / 16.0); const float ang = (float)pos * inv;
          rope[i] = (f32x2){(float)cos((double)ang), (float)sin((double)ang)}; } }
    { const float* wsrc = a.in[11]; bf16* wt = (bf16*)(ws + WS_WTRIL);
      for (int i = gt; i < 2 * 8 * 128 * 128 / 2; i += NGT) { const int e = 2 * i, ii = (e >> 7) & 127, jj = e & 127;
          const float v0 = (jj <= ii) ? wsrc[e] : 0.f, v1 = (jj + 1 <= ii) ? wsrc[e + 1] : 0.f;
          ((unsigned*)wt)[i] = cvt_pk_bf16(v0, v1); } }
}

__device__ __forceinline__ void sample_in_gemm(LAS unsigned char* lds, const float* hs, const bf16* Wt, int N, float* zs, int G) {
    const int tid = opaque_tid(), lane = tid & 63, wave = tid >> 6, fr = lane & 15, fq = lane >> 4;
    constexpr int PITCH = 2064;
    LAS float* rs = (LAS float*)(lds + 32 * PITCH);
    {
        const int row = tid >> 4, c0 = (tid & 15) * 64;
        const f32x4* src = (const f32x4*)(hs + (size_t)row * DM + c0);
        float s = 0.f;
#pragma unroll
        for (int i = 0; i < 8; ++i) { const f32x4 a0 = src[2 * i], a1 = src[2 * i + 1];
            s += ((a0[0] * a0[0] + a0[1] * a0[1]) + (a0[2] * a0[2] + a0[3] * a0[3])) + ((a1[0] * a1[0] + a1[1] * a1[1]) + (a1[2] * a1[2] + a1[3] * a1[3]));
            u32x4 w; w.x = cvt_pk_bf16(a0[0], a0[1]); w.y = cvt_pk_bf16(a0[2], a0[3]); w.z = cvt_pk_bf16(a1[0], a1[1]); w.w = cvt_pk_bf16(a1[2], a1[3]);
            *(LAS u32x4*)(lds + row * PITCH + (c0 + 8 * i) * 2) = w; }
        s += __shfl_xor(s, 1); s += __shfl_xor(s, 2); s += __shfl_xor(s, 4); s += __shfl_xor(s, 8);
        if ((tid & 15) == 0) rs[row] = __builtin_amdgcn_rsqf(s * (1.0f / DM) + EPS_);
    }
    __syncthreads();
    const int ntiles = N / 16;
    for (int nt = blockIdx.x + G * wave; nt < ntiles; nt += G * NWAVES) {
        f32x4 acc0 = (f32x4){0.f, 0.f, 0.f, 0.f}, acc1 = acc0;
        const bf16* bp = Wt + (size_t)(nt * 16 + fr) * DM + 8 * fq;
        int apo = fr * PITCH + fq * 16; asm volatile("" : "+v"(apo));
        const LAS unsigned char* ap = lds + apo;
        for (int kh = 0; kh < 2; ++kh) {
            bf16x8 bw[16];
#pragma unroll
            for (int k = 0; k < 16; ++k) bw[k] = *(const bf16x8*)(bp + 32 * (16 * kh + k));
#pragma unroll
            for (int k = 0; k < 16; ++k) {
                const bf16x8 a0 = *(const LAS bf16x8*)(ap + (16 * kh + k) * 64), a1 = *(const LAS bf16x8*)(ap + 16 * PITCH + (16 * kh + k) * 64);
                acc0 = __builtin_amdgcn_mfma_f32_16x16x32_bf16(bw[k], a0, acc0, 0, 0, 0);
                acc1 = __builtin_amdgcn_mfma_f32_16x16x32_bf16(bw[k], a1, acc1, 0, 0, 0);
            }
        }
        const float r0 = rs[fr], r1 = rs[16 + fr];
        *(f32x4*)(zs + (size_t)fr * N + nt * 16 + 4 * fq) = acc0 * r0;
        *(f32x4*)(zs + (size_t)(16 + fr) * N + nt * 16 + 4 * fq) = acc1 * r1;
    }
    __syncthreads();
}
__device__ __forceinline__ void sample_out_gemm(LAS unsigned char* lds, const bf16* ts, const bf16* Wt, float* hs, int G) {
    const int tid = opaque_tid(), lane = tid & 63, wave = tid >> 6, fr = lane & 15, fq = lane >> 4;
    LAS f32x4* red = (LAS f32x4*)lds;
    for (int nt = blockIdx.x; nt < DM / 16; nt += G) {
        f32x4 acc0 = (f32x4){0.f, 0.f, 0.f, 0.f}, acc1 = acc0;
        const bf16* bp = Wt + (size_t)(nt * 16 + fr) * EW + 256 * wave + 8 * fq;
        const bf16* ap = ts + (size_t)fr * EW + 256 * wave + 8 * fq;
        bf16x8 bw[8], a0[8], a1[8];
#pragma unroll
        for (int k = 0; k < 8; ++k) { bw[k] = *(const bf16x8*)(bp + 32 * k); a0[k] = *(const bf16x8*)(ap + 32 * k); a1[k] = *(const bf16x8*)(ap + 16 * EW + 32 * k); }
#pragma unroll
        for (int k = 0; k < 8; ++k) {
            acc0 = __builtin_amdgcn_mfma_f32_16x16x32_bf16(bw[k], a0[k], acc0, 0, 0, 0);
            acc1 = __builtin_amdgcn_mfma_f32_16x16x32_bf16(bw[k], a1[k], acc1, 0, 0, 0);
        }
        red[(wave * 2 + 0) * 64 + lane] = acc0; red[(wave * 2 + 1) * 64 + lane] = acc1;
        __syncthreads();
        if (wave < 2) {
            f32x4 sum = red[(0 * 2 + wave) * 64 + lane];
#pragma unroll
            for (int w = 1; w < 8; ++w) sum = sum + red[(w * 2 + wave) * 64 + lane];
            f32x4* p0 = (f32x4*)(hs + (size_t)(16 * wave + fr) * DM + nt * 16 + 4 * fq);
            *p0 = *p0 + sum;
        }
        __syncthreads();
    }
}

__device__ __forceinline__ void mix_a_phase(LAS unsigned char* lds, const Args& a, int layerA, int G) {
    const int tid = opaque_tid(), lane = tid & 63, wave = __builtin_amdgcn_readfirstlane(tid >> 6), fr = lane & 15, fq = lane >> 4, wr = wave >> 2, wc = wave & 3;
    unsigned char* ws = a.ws;
    const bf16* UG = (const bf16*)(ws + WS_Z); const bf16* Vb = UG + (size_t)M_ * EW; bf16* T = (bf16*)(ws + WS_T);
    const float* lnp = (const float*)(ws + WS_LNP);
    const float* lg = a.in[9] + layerA * EW; const float* lb = a.in[10] + layerA * EW;
    const float* bs = a.in[12] + layerA * 8 * 128;
    const bf16* wtril = (const bf16*)(ws + WS_WTRIL) + (size_t)layerA * 8 * 128 * 128;
    constexpr int VP = 272;
    LAS unsigned char* vT = lds;
    LAS f32x2* stat = (LAS f32x2*)(lds + 256 * VP);
    LAS unsigned char* wA = lds + 72 * 1024;
    u32x4 vraw[2][4]; f32x4 lnq[4]; u32x4 ugr[4][2]; u32x4 war[4];
    const int sj = tid >> 2, sq4 = tid & 3;
#define MIX_LOADV(uu) do { const int c_ = (uu) >> 3, g_ = (uu) & 7; \
        const f32x4* p_ = (const f32x4*)(lnp + ((size_t)(128 * c_ + sj) * 32 + sq4 * 8) * 2); \
        _Pragma("unroll") for (int i = 0; i < 4; ++i) lnq[i] = p_[i]; \
        _Pragma("unroll") for (int it = 0; it < 2; ++it) { const int item = tid + it * 512, ec = item & 31, jb = item >> 5; \
            _Pragma("unroll") for (int rr = 0; rr < 4; ++rr) vraw[it][rr] = *(const u32x4*)(Vb + (size_t)(128 * c_ + 4 * jb + rr) * EW + 256 * g_ + 8 * ec); } \
        _Pragma("unroll") for (int q = 0; q < 4; ++q) { const int idx = tid + 512 * q; war[q] = *(const u32x4*)(wtril + (size_t)g_ * 128 * 128 + (size_t)(idx >> 4) * 128 + (idx & 15) * 8); } } while (0)
#define MIX_LOADUG(uu) do { const int c_ = (uu) >> 3, g_ = (uu) & 7; \
        _Pragma("unroll") for (int m = 0; m < 4; ++m) _Pragma("unroll") for (int np = 0; np < 2; ++np) \
            ugr[m][np] = *(const u32x4*)(UG + ((size_t)128 * c_ + 64 * wr + 16 * m + fr) * EW + 256 * g_ + 64 * wc + 32 * np + 8 * fq); } while (0)
    if ((int)blockIdx.x < 1024) { MIX_LOADV((int)blockIdx.x); MIX_LOADUG((int)blockIdx.x); }
    for (int u = blockIdx.x; u < 1024; u += G) {
        const int c = u >> 3, g = u & 7, un = (u + G < 1024) ? u + G : u;
        {
#pragma unroll
            for (int q = 0; q < 4; ++q) { const int idx = tid + 512 * q; *(LAS u32x4*)(wA + (idx >> 4) * VP + (idx & 15) * 16) = war[q]; }
            float s = 0.f, ss = 0.f;
#pragma unroll
            for (int i = 0; i < 4; ++i) { const f32x4 x = lnq[i]; s += x[0] + x[2]; ss += x[1] + x[3]; }
            s += __shfl_xor(s, 1); s += __shfl_xor(s, 2); ss += __shfl_xor(ss, 1); ss += __shfl_xor(ss, 2);
            const float mean = s * (1.0f / EW); const float var = fmaxf(ss * (1.0f / EW) - mean * mean, 0.f);
            if (sq4 == 0) stat[sj] = (f32x2){mean, __builtin_amdgcn_rsqf(var + EPS_)};
        }
        __syncthreads();
#pragma unroll
        for (int it = 0; it < 2; ++it) {
            const int item = tid + it * 512, ec = item & 31, jb = item >> 5;
            const f32x4 g0 = *(const f32x4*)(lg + 256 * g + 8 * ec), g1 = *(const f32x4*)(lg + 256 * g + 8 * ec + 4);
            const f32x4 b0 = *(const f32x4*)(lb + 256 * g + 8 * ec), b1 = *(const f32x4*)(lb + 256 * g + 8 * ec + 4);
            float vals[4][8];
#pragma unroll
            for (int rr = 0; rr < 4; ++rr) {
                const int j = 4 * jb + rr;
                const u32x4 raw = vraw[it][rr];
                const f32x2 st = stat[j];
                vals[rr][0] = (bflo(raw.x) - st.x) * st.y * g0[0] + b0[0]; vals[rr][1] = (bfhi(raw.x) - st.x) * st.y * g0[1] + b0[1];
                vals[rr][2] = (bflo(raw.y) - st.x) * st.y * g0[2] + b0[2]; vals[rr][3] = (bfhi(raw.y) - st.x) * st.y * g0[3] + b0[3];
                vals[rr][4] = (bflo(raw.z) - st.x) * st.y * g1[0] + b1[0]; vals[rr][5] = (bfhi(raw.z) - st.x) * st.y * g1[1] + b1[1];
                vals[rr][6] = (bflo(raw.w) - st.x) * st.y * g1[2] + b1[2]; vals[rr][7] = (bfhi(raw.w) - st.x) * st.y * g1[3] + b1[3];
            }
#pragma unroll
            for (int q = 0; q < 8; ++q) {
                const int e = 8 * ec + q, c32 = e & 31, slot = (e & ~31) + 16 * ((c32 >> 2) & 1) + 4 * (c32 >> 3) + (c32 & 3);
                u32x2 w; w.x = cvt_pk_bf16(vals[0][q], vals[1][q]); w.y = cvt_pk_bf16(vals[2][q], vals[3][q]);
                const int gsw = ((slot >> 5) & 3) + 4 * ((slot >> 3) & 1);
                *(LAS u32x2*)(vT + slot * VP + 16 * ((jb >> 1) ^ gsw) + 8 * (jb & 1)) = w;
            }
        }
        MIX_LOADV(un);
        __syncthreads();
        f32x4 acc[4][4];
#pragma unroll
        for (int m = 0; m < 4; ++m)
#pragma unroll
            for (int n = 0; n < 4; ++n) acc[m][n] = (f32x4){0.f, 0.f, 0.f, 0.f};
        const int kmax = wr ? 4 : 2;
        for (int k = 0; k < kmax; ++k) {
            bf16x8 af[4], bfv[4];
#pragma unroll
            for (int m = 0; m < 4; ++m) af[m] = *(const LAS bf16x8*)(wA + (64 * wr + 16 * m + fr) * VP + (32 * k + 8 * fq) * 2);
#pragma unroll
            for (int n = 0; n < 4; ++n) { const int R = 64 * wc + 16 * n + fr, gsw = ((R >> 5) & 3) + 4 * ((R >> 3) & 1);
                bfv[n] = *(const LAS bf16x8*)(vT + R * VP + 16 * ((4 * k + fq) ^ gsw)); }
#pragma unroll
            for (int m = 0; m < 4; ++m)
#pragma unroll
                for (int n = 0; n < 4; ++n) acc[m][n] = __builtin_amdgcn_mfma_f32_16x16x32_bf16(bfv[n], af[m], acc[m][n], 0, 0, 0);
        }
#pragma unroll
        for (int m = 0; m < 4; ++m) {
            const int i = 64 * wr + 16 * m + fr; const size_t row = (size_t)128 * c + i;
            const float bsv = bs[g * 128 + i];
#pragma unroll
            for (int np = 0; np < 2; ++np) {
                const int e0 = 256 * g + 64 * wc + 32 * np + 8 * fq;
                const u32x4 uu = ugr[m][np];
                const f32x4 x0 = acc[m][2 * np] + bsv, x1 = acc[m][2 * np + 1] + bsv;
                u32x4 w;
                w.x = cvt_pk_bf16(bflo(uu.x) * x0[0], bfhi(uu.x) * x0[1]);
                w.y = cvt_pk_bf16(bflo(uu.y) * x0[2], bfhi(uu.y) * x0[3]);
                w.z = cvt_pk_bf16(bflo(uu.z) * x1[0], bfhi(uu.z) * x1[1]);
                w.w = cvt_pk_bf16(bflo(uu.w) * x1[2], bfhi(uu.w) * x1[3]);
                *(u32x4*)(T + row * EW + e0) = w;
            }
        }
        MIX_LOADUG(un);
        __syncthreads();
    }
#undef MIX_LOADV
#undef MIX_LOADUG
    const int gw = blockIdx.x * NWAVES + wave;
    if (gw < MS_) {
        const int b = gw; const float* zs = (const float*)(ws + WS_ZS) + (size_t)b * N_AIN;
        const float* wsrc = a.in[11] + (size_t)layerA * 8 * 128 * 128;
        f32x4 v[8]; float s = 0.f;
#pragma unroll
        for (int i = 0; i < 8; ++i) { v[i] = *(const f32x4*)(zs + 2 * EW + 256 * i + 4 * lane); s += (v[i][0] + v[i][1]) + (v[i][2] + v[i][3]); }
        const float mean = wave_sum(s) * (1.0f / EW); float q = 0.f;
#pragma unroll
        for (int i = 0; i < 8; ++i) { v[i] = v[i] - mean; q += (v[i][0] * v[i][0] + v[i][1] * v[i][1]) + (v[i][2] * v[i][2] + v[i][3] * v[i][3]); }
        const float rstd = __builtin_amdgcn_rsqf(wave_sum(q) * (1.0f / EW) + EPS_);
        float* sv = a.out + OFF_SV + ((size_t)layerA * MS_ + b) * EW; bf16* ts = (bf16*)(ws + WS_TS) + (size_t)b * EW;
#pragma unroll
        for (int i = 0; i < 8; ++i) {
            const int e = 256 * i + 4 * lane;
            const f32x4 vn = v[i] * rstd * *(const f32x4*)(lg + e) + *(const f32x4*)(lb + e);
            *(f32x4*)(sv + e) = vn;
            const float w00 = wsrc[(size_t)i * 128 * 128], b00 = bs[i * 128];
            const int pe = 256 * (e >> 7) + (e & 127);
            const f32x4 uu = *(const f32x4*)(zs + pe), gg = *(const f32x4*)(zs + pe + 128);
            u32x2 w; w.x = cvt_pk_bf16(uu[0] * (w00 * vn[0] + b00) * silu_f(gg[0]), uu[1] * (w00 * vn[1] + b00) * silu_f(gg[1]));
            w.y = cvt_pk_bf16(uu[2] * (w00 * vn[2] + b00) * silu_f(gg[2]), uu[3] * (w00 * vn[3] + b00) * silu_f(gg[3]));
            *(u32x2*)(ts + e) = w;
        }
    }
}

__device__ __forceinline__ void conv_b_phase(const Args& a, int G) {
    const int tid = opaque_tid();
    unsigned char* ws = a.ws;
    const bf16* BGG = (const bf16*)(ws + WS_Z); const bf16* P = BGG + (size_t)M_ * EW; bf16* T = (bf16*)(ws + WS_T);
    const float* cw = a.in[15];
    const int NIT = (M_ / 32) * 256;
#define UNPK8(dst, v) do { dst[0] = bflo(v.x); dst[1] = bfhi(v.x); dst[2] = bflo(v.y); dst[3] = bfhi(v.y); dst[4] = bflo(v.z); dst[5] = bfhi(v.z); dst[6] = bflo(v.w); dst[7] = bfhi(v.w); } while (0)
    for (int item = blockIdx.x * 512 + tid; item < NIT; item += G * 512) {
        const int cc = item & 255, rb = item >> 8, r0 = 32 * rb, c0 = 8 * cc;
        float w0[8], w1[8], w2[8];
#pragma unroll
        for (int q = 0; q < 8; ++q) { w0[q] = cw[c0 + q]; w1[q] = cw[EW + c0 + q]; w2[q] = cw[2 * EW + c0 + q]; }
        float p2[8], p1[8];
        if ((r0 & (SEQ_ - 1)) == 0) {
#pragma unroll
            for (int q = 0; q < 8; ++q) { p2[q] = 0.f; p1[q] = 0.f; }
        } else {
            const u32x4 pa = *(const u32x4*)(P + (size_t)(r0 - 2) * EW + c0), pb = *(const u32x4*)(P + (size_t)(r0 - 1) * EW + c0);
            UNPK8(p2, pa); UNPK8(p1, pb);
        }
#pragma unroll 8
        for (int rr = 0; rr < 32; ++rr) {
            const size_t row = (size_t)r0 + rr;
            const u32x4 bgv = *(const u32x4*)(BGG + row * EW + c0), pv = *(const u32x4*)(P + row * EW + c0);
            float p0[8], bgf[8];
            UNPK8(p0, pv); UNPK8(bgf, bgv);
            float o[8];
#pragma unroll
            for (int q = 0; q < 8; ++q) { o[q] = bgf[q] * (w0[q] * p2[q] + w1[q] * p1[q] + w2[q] * p0[q]); }
            u32x4 w; w.x = cvt_pk_bf16(o[0], o[1]); w.y = cvt_pk_bf16(o[2], o[3]); w.z = cvt_pk_bf16(o[4], o[5]); w.w = cvt_pk_bf16(o[6], o[7]);
            *(u32x4*)(T + row * EW + c0) = w;
            const int t = (int)(row & (SEQ_ - 1));
            if (t >= SEQ_ - 2) {
                float* sp = a.out + OFF_SCP + ((size_t)(row >> 13) * 2 + (t - (SEQ_ - 2))) * EW + c0;
                *(f32x4*)sp = (f32x4){p0[0], p0[1], p0[2], p0[3]}; *(f32x4*)(sp + 4) = (f32x4){p0[4], p0[5], p0[6], p0[7]};
            }
#pragma unroll
            for (int q = 0; q < 8; ++q) { p2[q] = p1[q]; p1[q] = p0[q]; }
        }
    }
#undef UNPK8
    for (int item = blockIdx.x * 512 + tid; item < MS_ * EW; item += G * 512) {
        const int b = item >> 11, c = item & (EW - 1), pc = 256 * (c >> 7) + (c & 127);
        const float* zs = (const float*)(ws + WS_ZS) + (size_t)b * N_BIN;
        const float* st = a.in[2] + (size_t)b * 2 * EW;
        const float pr0 = st[c], pr1 = st[EW + c], pn = zs[2 * EW + pc] * zs[2 * EW + pc + 128];
        const float conv = cw[c] * pr0 + cw[EW + c] * pr1 + cw[2 * EW + c] * pn;
        const float o = zs[pc] * conv * silu_f(zs[pc + 128]);
        ((bf16*)(ws + WS_TS))[(size_t)b * EW + c] = (bf16)(cvt_pk_bf16(o, 0.f) & 0xffffu);
        float* so = a.out + OFF_SCS + (size_t)b * 2 * EW; so[c] = pr1; so[EW + c] = pn;
    }
}

namespace att {
#define KSWZ(row, colB) ((row) * 256 + ((colB) ^ (((row) & 7) << 4)))
__device__ __forceinline__ int crow(int r, int hi) { return (r & 3) + 8 * (r >> 2) + 4 * hi; }
__device__ __forceinline__ int v_st(int k, int c) { const int kk = (k & ~0xC) | ((k & 4) << 1) | ((k & 8) >> 1); return ((kk >> 3) * 4 + (c >> 5)) * 512 + ((kk & 7) * 32 + (c & 31)) * 2; }
__device__ __forceinline__ int v_rd_base(int lane) { return ((lane & 3) << 3) | (((lane >> 2) & 3) << 6) | (((lane >> 4) & 1) << 5) | (((lane >> 5) & 1) << 8); }
constexpr int v_rd_off(int d0, int ks, int half) { return d0 * 512 + ks * 4096 + half * 2048; }
template <int OFF> __device__ __forceinline__ s16x4 tr_read(int vb) { s16x4 r; asm volatile("ds_read_b64_tr_b16 %0, %1 offset:%2" : "=&v"(r) : "v"(vb), "i"(OFF) : "memory"); return r; }
constexpr int SHM_T = 16384;
constexpr int OST_OFF = 4 * SHM_T, OST_PITCH = 272, OST_WAVE = 32 * OST_PITCH;
constexpr int OST8_PITCH = 144;

template <int OFF>
__device__ __forceinline__ void qkt_half(f32x16& p, int kbase, int r32, int hi, const bf16x8 (&qr)[8]) {
    p = (f32x16){};
    asm volatile("" : "+v"(r32), "+v"(hi));
    const int rowb = kbase + r32 * 256, sw = (r32 & 7) << 4;
#pragma unroll
    for (int d0 = 0; d0 < 8; ++d0) {
        const bf16x8 b0 = *(const LAS bf16x8*)(uintptr_t)(unsigned)(rowb + ((((d0 & 3) * 32) + hi * 16) ^ sw) + (d0 >> 2) * 128 + OFF);
        p = __builtin_amdgcn_mfma_f32_32x32x16_bf16(b0, qr[d0], p, 0, 0, 0); }
}
template <int D0, int KS0, int BUFOFF> __device__ __forceinline__ void pv_half(f32x16& od, int vb, bf16x8 pa0, bf16x8 pa1) {
    const s16x4 l0 = tr_read<v_rd_off(D0, KS0, 0) + BUFOFF>(vb), h0 = tr_read<v_rd_off(D0, KS0, 1) + BUFOFF>(vb), l1 = tr_read<v_rd_off(D0, KS0 + 1, 0) + BUFOFF>(vb), h1 = tr_read<v_rd_off(D0, KS0 + 1, 1) + BUFOFF>(vb);
    asm volatile("s_waitcnt lgkmcnt(0)" ::: "memory"); __builtin_amdgcn_sched_barrier(0);
#define PKV(L, H) (bf16x8){L[0], L[1], L[2], L[3], H[0], H[1], H[2], H[3]}
    od = __builtin_amdgcn_mfma_f32_32x32x16_bf16(PKV(l0, h0), pa0, od, 0, 0, 0);
    od = __builtin_amdgcn_mfma_f32_32x32x16_bf16(PKV(l1, h1), pa1, od, 0, 0, 0);
#undef PKV
}
struct UnitInfo { int g, b, h, qbg, first, dsh; };
__device__ __forceinline__ UnitInfo decode(int U) { UnitInfo u; u.qbg = U & 31; u.h = (U >> 5) & 15; u.b = (U >> 9) & 1; u.g = U >> 10; u.dsh = 2 * u.g; u.first = ((u.qbg & ((32 >> u.dsh) - 1)) == 0) ? 1 : 0; return u; }
}

__device__ __forceinline__ void attn_c_phase(LAS unsigned char* lds, const Args& a, int G) {
    using namespace att;
    const int tid = threadIdx.x, lane = tid & 63, wave = __builtin_amdgcn_readfirstlane(tid >> 6), r32 = lane & 31, hi = lane >> 5, wp = wave >> 1;
    unsigned char* ws = a.ws;
    const bf16* QKV = (const bf16*)(ws + WS_Z); unsigned char* OG8 = ws + WS_OG; float* LSE = (float*)(ws + WS_LSE);
    LAS unsigned char* V_lds = lds; LAS unsigned char* K_lds = lds + 2 * SHM_T;
    LAS unsigned char* ost = lds + OST_OFF + wave * OST_WAVE;
    constexpr float C = ATT_SCALE * LOG2E;
    const int kbase = (int)(uintptr_t)K_lds;
    constexpr int NU = 3 * 2 * 16 * 32;
    const bool contig = (NU % G) == 0; const int upb = contig ? NU / G : (NU + G - 1) / G;
#define UNIT_ID(i) (contig ? (int)blockIdx.x * upb + (i) : (int)blockIdx.x + G * (i))
#define UNIT_OK(i) ((i) < upb && UNIT_ID(i) < NU)
    int nun = 0; for (int i = 0; i < upb; ++i) nun += UNIT_OK(i) ? 1 : 0;
#define RUN_LEN(i0_, out_) do { int n_ = 1; while ((i0_) + n_ < nun && UNIT_ID((i0_) + n_) == UNIT_ID((i0_) + n_ - 1) + 1 && !decode(UNIT_ID((i0_) + n_)).first) ++n_; out_ = n_; } while (0)
    int l_i0 = 0, l_nu = 1, l_tau = 0; const bf16* l_kp = QKV; const bf16* l_vp = QKV;
    if (nun > 0) { RUN_LEN(0, l_nu); l_tau = decode(UNIT_ID(0)).first ? 2 : 0; }
    bf16x8 ra_k0 = {}, ra_k1 = {}, ra_v0 = {}, ra_v1 = {}, rb_k0 = {}, rb_k1 = {}, rb_v0 = {}, rb_v1 = {};
#define ISSUE(K0, K1, V0, V1) do { if (l_i0 < nun) { const UnitInfo _u = decode(UNIT_ID(l_i0)); \
            const size_t _hb = (((size_t)(_u.g) * 2 + _u.b) * 16 + _u.h) * SEQ_; const long _sp = (long)256 * _u.qbg - 128 + 64 * l_tau; \
            l_kp = QKV + ((size_t)(1 * 3) * 2 * 16 * SEQ_ + _hb + _sp) * 128; l_vp = QKV + ((size_t)(2 * 3) * 2 * 16 * SEQ_ + _hb + _sp) * 128; \
            l_tau += 1; if (l_tau > 4 * l_nu + 1) { l_i0 += l_nu; if (l_i0 < nun) { RUN_LEN(l_i0, l_nu); l_tau = decode(UNIT_ID(l_i0)).first ? 2 : 0; } } } \
        int t_ = tid; asm volatile("" : "+v"(t_)); const unsigned ldoff = (unsigned)((t_ >> 4) * 256 + (t_ & 15) * 16);     \
        K0 = *(const bf16x8*)((const char*)l_kp + ldoff); K1 = *(const bf16x8*)((const char*)l_kp + 8192 + ldoff); \
        V0 = *(const bf16x8*)((const char*)l_vp + ldoff); V1 = *(const bf16x8*)((const char*)l_vp + 8192 + ldoff); } while (0)
#define SWRITE(buf, K0, K1, V0, V1) do { int t_ = tid; asm volatile("" : "+v"(t_)); const int sr_ = t_ >> 4, sc_ = (t_ & 15) * 8; \
        const int vstA = (int)(uintptr_t)V_lds + v_st(sr_, sc_), kstA = (int)(uintptr_t)K_lds + KSWZ(sr_, sc_ * 2); \
        *(LAS bf16x8*)(uintptr_t)(unsigned)(vstA + (buf) * SHM_T) = V0; *(LAS bf16x8*)(uintptr_t)(unsigned)(vstA + (buf) * SHM_T + 8192) = V1; \
        *(LAS bf16x8*)(uintptr_t)(unsigned)(kstA + (buf) * SHM_T) = K0; *(LAS bf16x8*)(uintptr_t)(unsigned)(kstA + (buf) * SHM_T + 8192) = K1; } while (0)
#define QLOAD(uidx) do { const UnitInfo _q = decode(UNIT_ID(uidx)); \
        const bf16* qp = QKV + (((((size_t)_q.g) * 2 + _q.b) * 16 + _q.h) * SEQ_ + 256 * _q.qbg + 32 * wave + r32) * 128 + hi * 8; \
        _Pragma("unroll") for (int d0 = 0; d0 < 8; ++d0) qr[d0] = *(const bf16x8*)(qp + d0 * 16); } while (0)
#define EPILOGUE(uidx) do { const UnitInfo _e = decode(UNIT_ID(uidx)); const float inv = OG_SCALE * __builtin_amdgcn_rcpf(l_reg); \
        _Pragma("unroll") for (int d0 = 0; d0 < 4; ++d0) _Pragma("unroll") for (int i = 0; i < 4; ++i) \
            *(LAS unsigned*)(ost + r32 * OST8_PITCH + (32 * d0 + 8 * i + 4 * hi)) = pk4_fp8(o[d0][4 * i] * inv, o[d0][4 * i + 1] * inv, o[d0][4 * i + 2] * inv, o[d0][4 * i + 3] * inv); \
        const int lsh_ = 13 - _e.dsh, lmask_ = (1 << lsh_) - 1; \
        { const int sp_ = 256 * _e.qbg + 32 * wave + r32; const int t_ = (sp_ >> lsh_) + ((sp_ & lmask_) << _e.dsh); \
            LSE[((size_t)_e.g * M_ + (size_t)_e.b * SEQ_ + t_) * 16 + _e.h] = m_reg * ATT_SCALE + __logf(l_reg); } \
        LDS_WAIT(); asm volatile("" ::: "memory"); \
        _Pragma("unroll") for (int i = 0; i < 4; ++i) { const int ch_ = lane + 64 * i, row_ = ch_ >> 3, c16_ = ch_ & 7; \
            const u32x4 w_ = *(const LAS u32x4*)(ost + row_ * OST8_PITCH + c16_ * 16); \
            const int sp_ = 256 * _e.qbg + 32 * wave + row_; const int t_ = (sp_ >> lsh_) + ((sp_ & lmask_) << _e.dsh); \
            *(u32x4*)(OG8 + ((size_t)_e.g * M_ + (size_t)_e.b * SEQ_ + t_) * EW + _e.h * 128 + c16_ * 16) = w_; } \
        LDS_WAIT(); asm volatile("" ::: "memory"); } while (0)
    if (nun > 0) {
        ISSUE(ra_k0, ra_k1, ra_v0, ra_v1); ISSUE(rb_k0, rb_k1, rb_v0, rb_v1);
        SWRITE(0, ra_k0, ra_k1, ra_v0, ra_v1);
        __syncthreads();
        bf16x8 qr[8];
        float m_reg = -1e30f, l_reg = 0.f; f32x16 o[4] = {};
        int i0 = 0;
        while (i0 < nun) {
            int nu; RUN_LEN(i0, nu);
            const int tau0 = decode(UNIT_ID(i0)).first ? 2 : 0;
            QLOAD(i0);
            for (int tau = tau0; tau <= 4 * nu + 1; tau += 2) {
#pragma unroll
                for (int par = 0; par < 2; ++par) {
                    const int tt = tau + par, k = tt - wp, n = k >> 2, ph = k & 3;
                    const bool valid = (k >= 0) && (n < nu);
                    if (valid && ph == 3) {
                        EPILOGUE(i0 + n);
                        QLOAD(i0 + (n + 1 < nu ? n + 1 : n));
                        if (par == 0) ISSUE(ra_k0, ra_k1, ra_v0, ra_v1); else ISSUE(rb_k0, rb_k1, rb_v0, rb_v1);
                        if (par == 0) SWRITE(1, rb_k0, rb_k1, rb_v0, rb_v1); else SWRITE(0, ra_k0, ra_k1, ra_v0, ra_v1);
                    } else {
                        if (par == 0) ISSUE(ra_k0, ra_k1, ra_v0, ra_v1); else ISSUE(rb_k0, rb_k1, rb_v0, rb_v1);
                        if (valid) {
                            const int jj = ph + wp;
                            if (ph == 0 || tt == tau0) { m_reg = -1e30f; l_reg = 0.f;
#pragma unroll
                                for (int d = 0; d < 4; ++d) o[d] = (f32x16){}; }
#define HALF_STEP(HH, PAR) do { \
        const bool skip_ = (HH == 0) ? ((wave & 1) && ph == 0) : (!(wave & 1) && ph == 2); \
        if (!skip_) { \
            f32x16 p; qkt_half<(PAR) * SHM_T + (HH) * 8192>(p, kbase, r32, hi, qr); \
            const bool lowb_ = (ph == 0) && ((wave & 1) ? (HH == 1) : (HH == 0)); const bool upb_ = (ph == 2) && ((wave & 1) ? (HH == 1) : (HH == 0)); \
            if (lowb_ || upb_) { const int base = 64 * jj + 32 * (HH) - 32 * wave - r32 + 4 * hi; \
                _Pragma("unroll") for (int r = 0; r < 16; ++r) { const int kx = base + (r & 3) + 8 * (r >> 2); p[r] = ((unsigned)kx <= 128u) ? p[r] : -INFINITY; } } \
            float pmax = p[0]; \
            _Pragma("unroll") for (int r = 1; r < 16; ++r) pmax = fmaxf(pmax, p[r]); \
            { auto rr = __builtin_amdgcn_permlane32_swap(__float_as_uint(pmax), __float_as_uint(pmax), false, false); pmax = fmaxf(__uint_as_float(rr[0]), __uint_as_float(rr[1])); } \
            const float mn = fmaxf(m_reg, pmax); const float alpha = __builtin_amdgcn_exp2f((m_reg - mn) * C); m_reg = mn; \
            const float mnC = -mn * C; \
            _Pragma("unroll") for (int r = 0; r < 16; ++r) p[r] = __builtin_amdgcn_exp2f(fmaf(p[r], C, mnC)); \
            float ps = 0.f; \
            _Pragma("unroll") for (int r = 0; r < 16; ++r) ps += p[r]; \
            { auto rr = __builtin_amdgcn_permlane32_swap(__float_as_uint(ps), __float_as_uint(ps), false, false); ps = __uint_as_float(rr[0]) + __uint_as_float(rr[1]); } \
            l_reg = l_reg * alpha + ps; \
            if (!__all(alpha == 1.0f)) { _Pragma("unroll") for (int d = 0; d < 4; ++d) _Pragma("unroll") for (int r = 0; r < 16; ++r) o[d][r] *= alpha; } \
            bf16x8 pa0, pa1; \
            PK4(p, 0, pa0); PK4(p, 8, pa1); \
            int l_ = lane; asm volatile("" : "+v"(l_)); const int vb0 = (int)(uintptr_t)V_lds + v_rd_base(l_); \
            pv_half<0, 2 * (HH), (PAR) * SHM_T>(o[0], vb0, pa0, pa1); pv_half<1, 2 * (HH), (PAR) * SHM_T>(o[1], vb0, pa0, pa1); \
            pv_half<2, 2 * (HH), (PAR) * SHM_T>(o[2], vb0, pa0, pa1); pv_half<3, 2 * (HH), (PAR) * SHM_T>(o[3], vb0, pa0, pa1); } } while (0)
#define PK4(P, BASE, OUT) do { unsigned a0 = cvt_pk_bf16(P[BASE + 0], P[BASE + 1]), a1 = cvt_pk_bf16(P[BASE + 2], P[BASE + 3]); \
    unsigned b0 = cvt_pk_bf16(P[BASE + 4], P[BASE + 5]), b1 = cvt_pk_bf16(P[BASE + 6], P[BASE + 7]); \
    auto r0 = __builtin_amdgcn_permlane32_swap(a0, b0, false, false); auto r1 = __builtin_amdgcn_permlane32_swap(a1, b1, false, false); \
    u32x4 w = {r0[0], r1[0], r0[1], r1[1]}; OUT = __builtin_bit_cast(bf16x8, w); } while (0)
                            if (par == 0) { HALF_STEP(0, 0); HALF_STEP(1, 0); } else { HALF_STEP(0, 1); HALF_STEP(1, 1); }
#undef PK4
#undef HALF_STEP
                        }
                        if (par == 0) SWRITE(1, rb_k0, rb_k1, rb_v0, rb_v1); else SWRITE(0, ra_k0, ra_k1, ra_v0, ra_v1);
                    }
                    __syncthreads();
                }
            }
            if (wp == 3) EPILOGUE(i0 + nu - 1);
            i0 += nu;
        }
    }
    __syncthreads();
#undef ISSUE
#undef SWRITE
#undef QLOAD
#undef EPILOGUE
#undef RUN_LEN
#undef UNIT_ID
#undef UNIT_OK
}

__device__ __forceinline__ void attn_c_sample(LAS unsigned char* lds, const Args& a, int G) {
    const int tid = opaque_tid(), lane = tid & 63, wave = __builtin_amdgcn_readfirstlane(tid >> 6);
    unsigned char* ws = a.ws;
    const float* rope = (const float*)(ws + WS_ROPE) + (size_t)SEQ_ * 16 * 2;
    constexpr int TSK = 768 * 4;
    for (int pp = blockIdx.x; pp < 256; pp += G) {
        __syncthreads();
        if (wave < 6) {
            const int pr = wave / 3, g = wave - 3 * pr, P = 2 * pp + pr, b = P >> 4, h = P & 15;
            LAS float* sm = (LAS float*)(lds + wave * TSK);
            LAS float* qs = sm, *ks = sm + 128, *vs = sm + 256, *psm = sm + 384, *os = sm + 512, *misc = sm + 640;
            const float* zs = (const float*)(ws + WS_ZS) + (size_t)b * N_CIN;
            const int dil = 1 << (2 * g), win = 128 << (2 * g);
            const float* cache = a.in[3 + g] + (size_t)b * win * 4096;
            float* kvs = a.out + (g == 0 ? OFF_KV128S : (g == 1 ? OFF_KV512S : OFF_KV2048S)) + (size_t)b * 4096 + h * 128;
            {
                const int cq = g * EW + h * 128 + 2 * lane;
                const f32x2 qv = *(const f32x2*)(zs + cq), kv = *(const f32x2*)(zs + 3 * EW + cq), vv = *(const f32x2*)(zs + 6 * EW + cq);
                if (lane < 16) { const float c = rope[2 * lane], s = rope[2 * lane + 1];
                    const float q1 = qv.x * c - qv.y * s, q2 = qv.y * c + qv.x * s, k1 = kv.x * c - kv.y * s, k2 = kv.y * c + kv.x * s;
                    qs[lane] = q1; qs[lane + 16] = q2; ks[lane] = k1; ks[lane + 16] = k2; kvs[lane] = k1; kvs[lane + 16] = k2; }
                else { qs[2 * lane] = qv.x; qs[2 * lane + 1] = qv.y; ks[2 * lane] = kv.x; ks[2 * lane + 1] = kv.y; kvs[2 * lane] = kv.x; kvs[2 * lane + 1] = kv.y; }
                vs[2 * lane] = vv.x; vs[2 * lane + 1] = vv.y; kvs[2048 + 2 * lane] = vv.x; kvs[2048 + 2 * lane + 1] = vv.y;
            }
            LDS_WAIT(); asm volatile("" ::: "memory");
            const float* k0p = cache + ((size_t)(dil * lane) * 2) * 2048 + h * 128; const float* k1p = cache + ((size_t)(dil * (lane + 64)) * 2) * 2048 + h * 128;
            float s0 = 0.f, s1 = 0.f;
#pragma unroll 8
            for (int dc = 0; dc < 32; ++dc) { const f32x4 q4 = *(const LAS f32x4*)(qs + 4 * dc); const f32x4 ka = *(const f32x4*)(k0p + 4 * dc), kb = *(const f32x4*)(k1p + 4 * dc);
                s0 += (q4[0] * ka[0] + q4[1] * ka[1]) + (q4[2] * ka[2] + q4[3] * ka[3]); s1 += (q4[0] * kb[0] + q4[1] * kb[1]) + (q4[2] * kb[2] + q4[3] * kb[3]); }
            float sn = qs[2 * lane] * ks[2 * lane] + qs[2 * lane + 1] * ks[2 * lane + 1]; sn = wave_sum(sn);
            s0 *= ATT_SCALE; s1 *= ATT_SCALE; sn *= ATT_SCALE;
            const float mx = fmaxf(wave_max(fmaxf(s0, s1)), sn);
            const float e0 = __expf(s0 - mx), e1 = __expf(s1 - mx), en = __expf(sn - mx);
            const float den = wave_sum(e0 + e1) + en;
            psm[lane] = e0; psm[lane + 64] = e1;
            LDS_WAIT(); asm volatile("" ::: "memory");
            f32x2 acc = (f32x2){en * vs[2 * lane], en * vs[2 * lane + 1]};
            const float* vp = cache + 2048 + h * 128 + 2 * lane;
#pragma unroll 16
            for (int i = 0; i < 128; ++i) { const f32x2 vv = *(const f32x2*)(vp + (size_t)(dil * i) * 4096); const float pi = psm[i]; acc.x += pi * vv.x; acc.y += pi * vv.y; }
            const float rden = 1.0f / den;
            os[2 * lane] = acc.x * rden; os[2 * lane + 1] = acc.y * rden;
            if (lane == 0) misc[0] = mx + __logf(den);
        }
        __syncthreads();
        if (wave < 2) {
            const int P = 2 * pp + wave, b = P >> 4, h = P & 15;
            LAS float* s0 = (LAS float*)(lds + (3 * wave + 0) * TSK), *s1 = (LAS float*)(lds + (3 * wave + 1) * TSK), *s2 = (LAS float*)(lds + (3 * wave + 2) * TSK);
            const float l0 = s0[640], l1 = s1[640], l2 = s2[640]; const float mx = fmaxf(l0, fmaxf(l1, l2));
            const float w0 = __expf(l0 - mx), w1 = __expf(l1 - mx), w2 = __expf(l2 - mx); const float rs = 1.0f / (w0 + w1 + w2);
            const float* zs = (const float*)(ws + WS_ZS) + (size_t)b * N_CIN + 9 * EW + h * 128;
            const float oa = (w0 * s0[512 + 2 * lane] + w1 * s1[512 + 2 * lane] + w2 * s2[512 + 2 * lane]) * rs;
            const float ob = (w0 * s0[512 + 2 * lane + 1] + w1 * s1[512 + 2 * lane + 1] + w2 * s2[512 + 2 * lane + 1]) * rs;
            ((unsigned*)(ws + WS_TS))[((size_t)b * EW + h * 128) / 2 + lane] = cvt_pk_bf16(oa * silu_f(zs[2 * lane]), ob * silu_f(zs[2 * lane + 1]));
        }
    }
    __syncthreads();
}

__device__ __forceinline__ void combine_c_phase(const Args& a, int G) {
    unsigned char* ws = a.ws;
    const unsigned char* OG8 = ws + WS_OG; const float* LSE = (const float*)(ws + WS_LSE); const unsigned char* GATE8 = ws + WS_GATE; bf16* T = (bf16*)(ws + WS_T);
    const int NIT = M_ * 128;
    const int ctid = opaque_tid();
    for (int item = blockIdx.x * 512 + ctid; item < NIT; item += G * 512) {
        const int row = item >> 7, ch = item & 127, h = ch >> 3;
        const float l0 = LSE[((size_t)0 * M_ + row) * 16 + h], l1 = LSE[((size_t)1 * M_ + row) * 16 + h], l2 = LSE[((size_t)2 * M_ + row) * 16 + h];
        const size_t off = (size_t)row * EW + ch * 16;
        const u32x4 a0 = *(const u32x4*)(OG8 + off), a1 = *(const u32x4*)(OG8 + (size_t)M_ * EW + off), a2 = *(const u32x4*)(OG8 + (size_t)2 * M_ * EW + off), gg = *(const u32x4*)(GATE8 + off);
        const float mx = fmaxf(l0, fmaxf(l1, l2)); float w0 = __expf(l0 - mx), w1 = __expf(l1 - mx), w2 = __expf(l2 - mx); const float rs = (1.0f / OG_SCALE) / (w0 + w1 + w2); w0 *= rs; w1 *= rs; w2 *= rs;
        u32x4 wo[2];
#pragma unroll
        for (int q = 0; q < 4; ++q) {
            float x0[4], x1[4], x2[4], sg[4];
            unpk4_fp8(a0[q], x0[0], x0[1], x0[2], x0[3]); unpk4_fp8(a1[q], x1[0], x1[1], x1[2], x1[3]); unpk4_fp8(a2[q], x2[0], x2[1], x2[2], x2[3]); unpk4_fp8(gg[q], sg[0], sg[1], sg[2], sg[3]);
            wo[q >> 1][2 * (q & 1)] = cvt_pk_bf16((w0 * x0[0] + w1 * x1[0] + w2 * x2[0]) * sg[0], (w0 * x0[1] + w1 * x1[1] + w2 * x2[1]) * sg[1]);
            wo[q >> 1][2 * (q & 1) + 1] = cvt_pk_bf16((w0 * x0[2] + w1 * x1[2] + w2 * x2[2]) * sg[2], (w0 * x0[3] + w1 * x1[3] + w2 * x2[3]) * sg[3]);
        }
        *(u32x4*)(T + off) = wo[0]; *(u32x4*)(T + off + 8) = wo[1];
    }
    const bf16* QKV = (const bf16*)(ws + WS_Z);
    constexpr int NKV0 = 2 * 128 * 512, NKV1 = 2 * 512 * 512, NKV2 = 2 * 2048 * 512;
    for (int item = blockIdx.x * 512 + ctid; item < NKV0 + NKV1 + NKV2; item += G * 512) {
        int idx = item, g = 0; if (idx >= NKV0) { idx -= NKV0; g = 1; if (idx >= NKV1) { idx -= NKV1; g = 2; } }
        const int dsh = 2 * g, lsh = 13 - dsh, wsh = 7 + dsh, win = 1 << wsh;
        const int d8 = idx & 15, h = (idx >> 4) & 15, kv = (idx >> 8) & 1, pp = (idx >> 9) & (win - 1), b = idx >> (9 + wsh);
        const int t = SEQ_ - win + pp, sp = ((t & ((1 << dsh) - 1)) << lsh) | (t >> dsh);
        const bf16* src = QKV + ((((size_t)((1 + kv) * 3 + g) * 2 + b) * 16 + h) * SEQ_ + sp) * 128;
        float* dst = a.out + (g == 0 ? OFF_KV128P : (g == 1 ? OFF_KV512P : OFF_KV2048P)) + (size_t)idx * 8;
        f32x4 o0, o1;
        if (kv == 0 && d8 < 4) {
            const u32x4 w0 = *(const u32x4*)(src + 16 * (d8 & 1)), w1 = *(const u32x4*)(src + 16 * (d8 & 1) + 8);
            if (d8 < 2) { o0 = (f32x4){bflo(w0.x), bflo(w0.y), bflo(w0.z), bflo(w0.w)}; o1 = (f32x4){bflo(w1.x), bflo(w1.y), bflo(w1.z), bflo(w1.w)}; }
            else        { o0 = (f32x4){bfhi(w0.x), bfhi(w0.y), bfhi(w0.z), bfhi(w0.w)}; o1 = (f32x4){bfhi(w1.x), bfhi(w1.y), bfhi(w1.z), bfhi(w1.w)}; }
        } else {
            const u32x4 w0 = *(const u32x4*)(src + 8 * d8);
            o0 = (f32x4){bflo(w0.x), bfhi(w0.x), bflo(w0.y), bfhi(w0.y)}; o1 = (f32x4){bflo(w0.z), bfhi(w0.z), bflo(w0.w), bfhi(w0.w)};
        }
        *(f32x4*)dst = o0; *(f32x4*)(dst + 4) = o1;
    }
}

__device__ __forceinline__ void final_phase(const Args& a, int G) {
    const int tid = opaque_tid(), lane = tid & 63, wave = tid >> 6;
    unsigned char* ws = a.ws;
    const bf16* hbf = (const bf16*)(ws + WS_HB); const float* ssq = (const float*)(ws + WS_SSQP) + (size_t)4 * M_ * 16; const float* fw = a.in[7];
    const int gw = blockIdx.x * NWAVES + wave, NGW = G * NWAVES;
    f32x4 wv[4];
#pragma unroll
    for (int j = 0; j < 4; ++j) wv[j] = *((const f32x4*)fw + lane + 64 * j);
    for (int m = gw; m < M_ + MS_; m += NGW) {
        const bool smp = m >= M_;
        f32x4 v[4]; float s = 0.f;
        if (smp) { const f32x4* xr = (const f32x4*)((const float*)(ws + WS_HS) + (size_t)(m - M_) * DM) + lane;
#pragma unroll
            for (int j = 0; j < 4; ++j) { v[j] = xr[64 * j]; s += (v[j][0] * v[j][0] + v[j][1] * v[j][1]) + (v[j][2] * v[j][2] + v[j][3] * v[j][3]); } }
        else { const u32x2* xr = (const u32x2*)(hbf + (size_t)m * DM) + lane;
#pragma unroll
            for (int j = 0; j < 4; ++j) { const u32x2 r = xr[64 * j]; v[j] = (f32x4){bflo(r.x), bfhi(r.x), bflo(r.y), bfhi(r.y)}; } }
        if (smp) s = wave_sum(s);
        else { float p = (lane < 16) ? ssq[(size_t)m * 16 + lane] : 0.f; s = wave_sum(p); }
        const float rstd = __builtin_amdgcn_rsqf(s * (1.0f / DM) + EPS_);
        f32x4* o = (f32x4*)(a.out + (smp ? OFF_YS + (size_t)(m - M_) * DM : OFF_Y + (size_t)m * DM)) + lane;
#pragma unroll
        for (int j = 0; j < 4; ++j) o[64 * j] = v[j] * rstd * wv[j];
    }
}

__global__ void __launch_bounds__(NWAVES * 64, 2) hybrid_fwd(Args args) {
    extern __shared__ __attribute__((aligned(16))) unsigned char lds_raw[];
    LAS unsigned char* lds = (LAS unsigned char*)lds_raw;
    volatile LAS unsigned* MISC = (volatile LAS unsigned*)(lds + MISC_OFF);
    const int tid = opaque_tid();
    const int G = gridDim.x;
    unsigned char* ws = args.ws;
    unsigned* ctl = (unsigned*)(ws + WS_CTL);
    if (tid < 32) MISC[tid] = 0u;
    __syncthreads();
    XcdBarrier bar; bar.bar = ctl + CW_BAR; bar.x = 0; bar.st = nullptr;
    if (!MK_SPLIT) bar = xcd_barrier_post(ctl + CW_BAR, MISC + 8);
    const int lo = args.ph_lo, hi = args.ph_hi;
#ifndef PHASE_MASK
#define PHASE_MASK 0x7fff
#endif
#define IN(k) (lo <= (k) && (k) < hi && ((PHASE_MASK >> (k)) & 1))
#define SEAM(k) do { if (IN(k) && IN((k) + 1)) xcd_barrier(bar); } while (0)
    float* ssqp = (float*)(ws + WS_SSQP);
    bf16* HB = (bf16*)(ws + WS_HB); float* HP = (float*)(ws + WS_HP); bf16* T = (bf16*)(ws + WS_T); bf16* Z = (bf16*)(ws + WS_Z);
    float* HS = (float*)(ws + WS_HS); float* ZS = (float*)(ws + WS_ZS); bf16* TS = (bf16*)(ws + WS_TS);

#ifndef STAGGER_TICKS
#define STAGGER_TICKS 0
#endif
#define STAGGER() do { if (STAGGER_TICKS) { const unsigned long long t0_ = __builtin_amdgcn_s_memrealtime(); const unsigned long long d_ = (unsigned long long)(((unsigned)blockIdx.x >> 3) & 3u) * STAGGER_TICKS; \
        while (__builtin_amdgcn_s_memrealtime() - t0_ < d_) __builtin_amdgcn_s_sleep(8); } } while (0)
#define GEMM_IN(WOFF, NN, SSQL, LNP, SLO, SHI) do { \
        pg8::Gemm g{HB, (const bf16*)(ws + (WOFF)), M_, (NN), DM}; pg8::StaticOrder S; S.init(M_, (NN), G, (int)blockIdx.x); \
        pg8::Unit u0_; u0_.pm = -1; if (S.next(0, u0_)) pg8::stage_rstd(lds, ssqp + (size_t)(SSQL) * M_ * 16, u0_.pm); \
        pg8::EpiIn E{Z, Z + (size_t)M_ * EW, ssqp + (size_t)(SSQL) * M_ * 16, (LNP), (SLO), (SHI), lds + pg8::RS_OFF, u0_.pm}; \
        pg8::gemm_phase<pg8::EpiIn, pg8::StaticOrder, true, true>(lds, g, S, E); \
        sample_in_gemm(lds, HS, (const bf16*)(ws + (WOFF)), (NN), ZS, G); } while (0)
#define GEMM_OUT(WOFF, RES, SSQL) do { \
        pg8::Gemm g{T, (const bf16*)(ws + (WOFF)), M_, DM, EW}; pg8::StaticOrder S; S.init(M_, DM, G, (int)blockIdx.x); \
        pg8::EpiOut E{HB, ssqp + (size_t)(SSQL) * M_ * 16}; \
        pg8::gemm_phase<pg8::EpiOut, pg8::StaticOrder, true, true>(lds, g, S, E); \
        sample_out_gemm(lds, TS, (const bf16*)(ws + (WOFF)), HS, G); } while (0)
#define GEMM_CIN() do { STAGGER(); \
        pg8::Gemm g{HB, (const bf16*)(ws + WS_WC_IN), M_, N_CIN, DM}; pg8::StaticOrder S; S.init(M_, N_CIN, G, (int)blockIdx.x); \
        pg8::Unit u0_; u0_.pm = -1; if (S.next(0, u0_)) pg8::stage_rstd(lds, ssqp + (size_t)2 * M_ * 16, u0_.pm); \
        pg8::EpiCin E{Z, (bf16*)(ws + WS_GATE), ssqp + (size_t)2 * M_ * 16, (const float*)(ws + WS_ROPE), args.out, lds + pg8::RS_OFF, u0_.pm}; \
        pg8::gemm_phase<pg8::EpiCin, pg8::StaticOrder, true, true>(lds, g, S, E); \
        sample_in_gemm(lds, HS, (const bf16*)(ws + WS_WC_IN), N_CIN, ZS, G); } while (0)
#define PH0 p0_prologue(args, lds, G)
#define PH1 GEMM_IN(WS_WA_IN0, N_AIN, 0, (float*)(ws + WS_LNP), 16, 16)
#define PH2 mix_a_phase(lds, args, 0, G)
#define PH3 GEMM_OUT(WS_WA_OUT0, args.in[0], 1)
#define PH4 GEMM_IN(WS_WB_IN, N_BIN, 1, (float*)nullptr, 16, 32)
#define PH5 conv_b_phase(args, G)
#define PH6 GEMM_OUT(WS_WB_OUT, HP, 2)
#define PH7 GEMM_CIN()
#define PH8 do { attn_c_phase(lds, args, G); if ((DUPMASK >> 16) & 1) attn_c_phase(lds, args, G); attn_c_sample(lds, args, G); if ((DUPMASK >> 15) & 1) attn_c_sample(lds, args, G); } while (0)
#define PH9 combine_c_phase(args, G)
#define PH10 GEMM_OUT(WS_WC_OUT, HP, 3)
#define PH11 GEMM_IN(WS_WA_IN1, N_AIN, 3, (float*)(ws + WS_LNP), 16, 16)
#define PH12 mix_a_phase(lds, args, 1, G)
#define PH13 GEMM_OUT(WS_WA_OUT1, HP, 4)
#define PH14 final_phase(args, G)
#define RUN(k) do { if (IN(k)) { PH##k; if ((DUPMASK >> (k)) & 1) { PH##k; } } SEAM(k); } while (0)
    RUN(0);
    RUN(1); RUN(2); RUN(3);
    RUN(4); RUN(5); RUN(6);
    RUN(7); RUN(8); RUN(9); RUN(10);
    RUN(11); RUN(12); RUN(13);
    RUN(14);
#undef IN
#undef SEAM
}

extern "C" void kernel_launch(void* const* d_in, const int* in_sizes, int n_in, void* d_out, int out_size, void* d_ws, size_t ws_size, hipStream_t stream) {
    static int grid = 0;
    if (grid == 0) {
        if (n_in != 19 || (size_t)out_size != OUT_TOTAL || ws_size < WS_END) { fprintf(stderr, "kernel_launch: unexpected shapes: n_in %d out %d ws %zu\n", n_in, out_size, ws_size); grid = -1; return; }
        int dev = 0, cus = 0, per_cu = 0;
        if (hipGetDevice(&dev) != hipSuccess || hipDeviceGetAttribute(&cus, hipDeviceAttributeMultiprocessorCount, dev) != hipSuccess) { grid = -1; return; }
        if (hipFuncSetAttribute((const void*)hybrid_fwd, hipFuncAttributeMaxDynamicSharedMemorySize, LDS_BYTES) != hipSuccess) { fprintf(stderr, "kernel_launch: hipFuncSetAttribute failed\n"); grid = -1; return; }
        if (hipOccupancyMaxActiveBlocksPerMultiprocessor(&per_cu, (const void*)hybrid_fwd, NWAVES * 64, LDS_BYTES) != hipSuccess || per_cu < 1) { fprintf(stderr, "kernel_launch: occupancy query says %d\n", per_cu); }
        (void)hipGetLastError();
        grid = cus;
    }
    if (grid < 0) return;
    (void)hipMemsetAsync((char*)d_ws + WS_CTL, 0, CTL_ZERO_BYTES, stream);
    Args a{};
    for (int i = 0; i < 19; ++i) a.in[i] = (const float*)d_in[i];
    a.out = (float*)d_out; a.ws = (unsigned char*)d_ws;
#if MK_SPLIT
    for (int k = 0; k < NPH; ++k) { a.ph_lo = k; a.ph_hi = k + 1; hipLaunchKernelGGL(hybrid_fwd, dim3(grid), dim3(NWAVES * 64), LDS_BYTES, stream, a); }
#else
    a.ph_lo = 0; a.ph_hi = NPH;
    hipLaunchKernelGGL(hybrid_fwd, dim3(grid), dim3(NWAVES * 64), LDS_BYTES, stream, a);
#endif
    const hipError_t le = hipPeekAtLastError();
    if (le != hipSuccess) fprintf(stderr, "kernel_launch: launch failed: %s\n", hipGetErrorName(le));
}
```

```cpp
#include <hip/hip_runtime.h>
#include <cstdio>
#include <cstdint>

#ifndef MK_SPLIT
#define MK_SPLIT 0
#endif

#ifndef DUPMASK
#define DUPMASK 0
#endif
#define LAS __attribute__((address_space(3)))
#define GAS __attribute__((address_space(1)))
typedef unsigned short bf16;
typedef short bf16x8 __attribute__((ext_vector_type(8)));
typedef short s16x4 __attribute__((ext_vector_type(4)));
typedef float f32x2 __attribute__((ext_vector_type(2)));
typedef float f32x4 __attribute__((ext_vector_type(4)));
typedef float f32x16 __attribute__((ext_vector_type(16)));
typedef unsigned u32x2 __attribute__((ext_vector_type(2)));
typedef unsigned u32x4 __attribute__((ext_vector_type(4)));

constexpr int M_ = 16384, MS_ = 32, DM = 1024, EW = 2048, SEQ_ = 8192;
constexpr int N_AIN = 3 * EW, N_BIN = 4 * EW, N_CIN = 10 * EW;
constexpr float EPS_ = 1e-6f;
constexpr float LOG2E = 1.4426950408889634f;
constexpr float ATT_SCALE = 0.08838834764831845f;

constexpr size_t OFF_Y = 0, OFF_YS = 16777216, OFF_SV = 16809984, OFF_SCP = 16941056, OFF_SCS = 16949248;
constexpr size_t OFF_KV128P = 17080320, OFF_KV128S = 18128896, OFF_KV512P = 18259968, OFF_KV512S = 22454272, OFF_KV2048P = 22585344, OFF_KV2048S = 39362560;
constexpr size_t OUT_TOTAL = 39493632;

constexpr size_t MiB = 1u << 20;
constexpr size_t WS_CTL = 0, CTL_ZERO_BYTES = 32 * 1024;
constexpr size_t WS_ROPE = 1 * MiB;
constexpr size_t WS_WTRIL = 3 * MiB;
constexpr size_t WS_WA_IN0 = 4 * MiB, WS_WA_IN1 = 16 * MiB, WS_WB_IN = 28 * MiB, WS_WC_IN = 44 * MiB;
constexpr size_t WS_WA_OUT0 = 84 * MiB, WS_WA_OUT1 = 88 * MiB, WS_WB_OUT = 92 * MiB, WS_WC_OUT = 96 * MiB;
constexpr size_t WS_HP = 100 * MiB;
constexpr size_t WS_HB = 164 * MiB;
constexpr size_t WS_T = 196 * MiB;
constexpr size_t WS_SSQP = 260 * MiB;
constexpr size_t WS_LNP = 266 * MiB;
constexpr size_t WS_HS = 270 * MiB;
constexpr size_t WS_ZS = 271 * MiB;
constexpr size_t WS_TS = 274 * MiB;
constexpr size_t WS_LSE = 275 * MiB;
constexpr size_t WS_Z = 288 * MiB;
constexpr size_t WS_GATE = WS_Z + 576 * MiB;
constexpr size_t WS_OG = 928 * MiB;
constexpr size_t WS_END = 1120 * MiB;

constexpr int CW_BAR = 4096;

constexpr int LDS_BYTES = 147456;
constexpr int MISC_OFF = 140 * 1024;
constexpr int NWAVES = 8;
constexpr int NPH = 15;

__device__ __forceinline__ unsigned cvt_pk_bf16(float lo, float hi) { unsigned r; asm("v_cvt_pk_bf16_f32 %0, %1, %2" : "=v"(r) : "v"(lo), "v"(hi)); return r; }
__device__ __forceinline__ float bflo(unsigned w) { return __uint_as_float(w << 16); }
__device__ __forceinline__ float bfhi(unsigned w) { return __uint_as_float(w & 0xffff0000u); }
__device__ __forceinline__ float silu_f(float x) { return x * __builtin_amdgcn_rcpf(1.0f + __builtin_amdgcn_exp2f(-x * LOG2E)); }
__device__ __forceinline__ unsigned pk4_fp8(float a, float b, float c, float d) { int w = __builtin_amdgcn_cvt_pk_fp8_f32(a, b, 0, false); w = __builtin_amdgcn_cvt_pk_fp8_f32(c, d, w, true); return (unsigned)w; }
__device__ __forceinline__ void unpk4_fp8(unsigned w, float& a, float& b, float& c, float& d) { const f32x2 lo = __builtin_amdgcn_cvt_pk_f32_fp8((int)w, false), hi = __builtin_amdgcn_cvt_pk_f32_fp8((int)w, true); a = lo.x; b = lo.y; c = hi.x; d = hi.y; }
constexpr float OG_SCALE = 8.0f;

__device__ __forceinline__ float wave_sum(float v) {
#pragma unroll
    for (int o = 1; o < 64; o <<= 1) v += __shfl_xor(v, o);
    return v;
}
__device__ __forceinline__ float wave_max(float v) {
#pragma unroll
    for (int o = 1; o < 64; o <<= 1) v = fmaxf(v, __shfl_xor(v, o));
    return v;
}
__device__ __forceinline__ int opaque_tid() { int t = threadIdx.x; asm volatile("" : "+v"(t)); return t; }
#define LDS_WAIT() asm volatile("s_waitcnt lgkmcnt(0)" ::: "memory")
#define VM_WAIT() asm volatile("s_waitcnt vmcnt(0)" ::: "memory")

namespace pg8 {
constexpr int BM = 256, BK = 64, HALF = 128, HTB = HALF * BK * 2, STAGE_BYTES = 8 * HTB, NXCD = 8, WGM = 8;
__host__ __device__ __forceinline__ int lds_byte(int r, int c) { const int st = (r >> 4) * 2 + (c >> 5), rr = r & 15, cc = c & 31, ob = rr * 64 + cc * 2; return st * 1024 + (ob ^ (((ob >> 9) & 1) << 5)); }
__host__ __device__ __forceinline__ void stage_rc(int b, int& R, int& C) { const int st = b / 1024, sb = b % 1024, swz = sb ^ (((sb >> 9) & 1) << 5); R = (st >> 1) * 16 + swz / 64; C = (st & 1) * 32 + (swz % 64) / 2; }
__host__ __device__ __forceinline__ int perm32(int rho) { const int n = rho >> 4, i = rho & 15; return 8 * (i >> 2) + 4 * n + (i & 3); }

struct Unit { int pm, pn; };
struct Gemm { const bf16* A; const bf16* Bt; int M, N, K; };

struct StaticOrder {
    int nM, nN, nwg, G, c;
    __host__ __device__ void init(int M, int N, int G_, int c_) { nM = M / BM; nN = N / BM; nwg = nM * nN; G = G_; c = c_; }
    __host__ __device__ __forceinline__ bool next(int i, Unit& u) const {
        const long L = (long)i * G + c; if (L >= nwg) return false;
        int wgid = (int)L; { const int q = nwg / NXCD, r = nwg % NXCD, xcd = wgid % NXCD, off = wgid / NXCD; wgid = (xcd < r ? xcd * (q + 1) : r * (q + 1) + (xcd - r) * q) + off; }
        const int nig = WGM * nN, gid = wgid / nig, fm = gid * WGM, gsz = (nM - fm) < WGM ? (nM - fm) : WGM;
        u.pm = fm + ((wgid % nig) % gsz); u.pn = (wgid % nig) / gsz; return true;
    }
    __device__ __forceinline__ void a_ready(const Unit&) const {}
    __device__ __forceinline__ void done(const Unit&) const {}
};

template <class Epi, class Sched, bool ALIGN_EPI = false, bool SP2 = false>
__device__ __forceinline__ void gemm_phase(LAS unsigned char* lds, const Gemm g, const Sched& S, const Epi& E) {
    const int tid = opaque_tid(), wid = __builtin_amdgcn_readfirstlane(tid >> 6), lane = tid & 63, wr = wid >> 2, wc = wid & 3, fr = lane & 15, fq = lane >> 4;
    const int K = g.K, nt = K / BK;
    unsigned voffA[2], voffB[2];
#pragma unroll
    for (int i = 0; i < 2; ++i) { int R, C; stage_rc(tid * 16 + i * 8192, R, C); const int Rb = Epi::PERM ? ((R & ~31) + perm32(R & 31)) : R;
        voffA[i] = (unsigned)(R * K + C) * 2u; voffB[i] = (unsigned)(Rb * K + C) * 2u; }
    const size_t kstep = (size_t)(BK * 2);
    const size_t hstep = (size_t)HALF * K * 2;
    const size_t tstep = 2 * hstep;
    const unsigned ldsw = (unsigned)wid * 1024u;
    const int aoff = lds_byte(wr * 64 + fr, fq * 8), boff = lds_byte(wc * 32 + fr, fq * 8);
#define PG8_SA(b, h) (((b) * 2 + (h)) * HTB)
#define PG8_SB(b, h) ((4 + (b) * 2 + (h)) * HTB)
#define PG8_STAGE(bufoff, gbase, voff) do { _Pragma("unroll") for (int _i = 0; _i < 2; ++_i) \
        __builtin_amdgcn_global_load_lds((const unsigned*)((const char*)(gbase) + (voff)[_i]), (LAS unsigned*)(lds + (bufoff) + ldsw + _i * 8192), 16, 0, 0); } while (0)
#define PG8_LDA(dst, b, h) do { _Pragma("unroll") for (int m = 0; m < 4; ++m) _Pragma("unroll") for (int k = 0; k < 2; ++k) dst[m][k] = *(const LAS bf16x8*)(lds + PG8_SA(b, h) + aoff + m * 2048 + k * 1024); } while (0)
#define PG8_LDB(dst, b, h) do { _Pragma("unroll") for (int n = 0; n < 2; ++n) _Pragma("unroll") for (int k = 0; k < 2; ++k) dst[n][k] = *(const LAS bf16x8*)(lds + PG8_SB(b, h) + boff + n * 2048 + k * 1024); } while (0)
#define PG8_MMA(ai, bj, At, Bt) do { __builtin_amdgcn_s_setprio(1); _Pragma("unroll") for (int m = 0; m < 4; ++m) _Pragma("unroll") for (int n = 0; n < 2; ++n) _Pragma("unroll") for (int k = 0; k < 2; ++k) \
        acc[ai][bj][m][n] = __builtin_amdgcn_mfma_f32_16x16x32_bf16(Bt[n][k], At[m][k], acc[ai][bj][m][n], 0, 0, 0); __builtin_amdgcn_s_setprio(0); } while (0)
#define PG8_WAIT_V(n) asm volatile("s_waitcnt vmcnt(" #n ")" ::: "memory")
#define PG8_WAIT_L(n) asm volatile("s_waitcnt lgkmcnt(" #n ")" ::: "memory")
#define PG8_BAR __builtin_amdgcn_s_barrier()
#define PG8_SCHED __builtin_amdgcn_sched_barrier(0)
    Unit cur, nxt; int ui = 0;
    if (!S.next(0, cur)) return;
    f32x4 acc[2][2][4][2];
#pragma unroll
    for (int a = 0; a < 2; ++a)
#pragma unroll
        for (int b = 0; b < 2; ++b)
#pragma unroll
            for (int m = 0; m < 4; ++m)
#pragma unroll
                for (int n = 0; n < 2; ++n) acc[a][b][m][n] = (f32x4){0.f, 0.f, 0.f, 0.f};
    bf16x8 At[4][2], B0[2][2], B1[2][2];
    const char* cA = (const char*)g.A + (size_t)cur.pm * tstep; const char* cB = (const char*)g.Bt + (size_t)cur.pn * tstep;
    S.a_ready(cur);
    if constexpr (SP2) {
        PG8_STAGE(PG8_SB(0, 0), cB, voffB); PG8_STAGE(PG8_SB(0, 1), cB + hstep, voffB); PG8_STAGE(PG8_SA(0, 0), cA, voffA); PG8_STAGE(PG8_SA(0, 1), cA + hstep, voffA);
        if (wr == 1) PG8_BAR;
        PG8_WAIT_V(2); PG8_BAR;
        PG8_STAGE(PG8_SB(1, 0), cB + kstep, voffB); PG8_STAGE(PG8_SA(1, 0), cA + kstep, voffA); PG8_STAGE(PG8_SB(1, 1), cB + hstep + kstep, voffB);
        PG8_WAIT_V(6); PG8_BAR;
    } else {
        PG8_STAGE(PG8_SB(0, 0), cB, voffB); PG8_STAGE(PG8_SA(0, 0), cA, voffA); PG8_STAGE(PG8_SB(0, 1), cB + hstep, voffB); PG8_STAGE(PG8_SA(0, 1), cA + hstep, voffA);
        if (wr == 1) PG8_BAR;
        PG8_WAIT_V(4); PG8_BAR;
        PG8_STAGE(PG8_SB(1, 0), cB + kstep, voffB); PG8_STAGE(PG8_SA(1, 0), cA + kstep, voffA); PG8_STAGE(PG8_SB(1, 1), cB + hstep + kstep, voffB);
        PG8_WAIT_V(6); PG8_BAR;
    }
    for (;;) {
        const bool has_next = S.next(ui + 1, nxt);
        const char* nA = has_next ? (const char*)g.A + (size_t)nxt.pm * tstep : cA; const char* nB = has_next ? (const char*)g.Bt + (size_t)nxt.pn * tstep : cB;
        for (int t = 0; t < nt; t += 2) {
            const bool last = (t == nt - 2);
            const char* a1 = cA + (size_t)(t + 1) * kstep;
            const char* a2 = last ? nA : cA + (size_t)(t + 2) * kstep; const char* b2 = last ? nB : cB + (size_t)(t + 2) * kstep;
            const char* a3 = a2 + kstep; const char* b3 = b2 + kstep;
            if (last && has_next) S.a_ready(nxt);
            if constexpr (SP2) {
            PG8_LDB(B0, 0, 0); PG8_LDB(B1, 0, 1); PG8_SCHED; PG8_LDA(At, 0, 0); PG8_STAGE(PG8_SA(1, 1), a1 + hstep, voffA);
            PG8_WAIT_V(8); PG8_WAIT_L(0); PG8_BAR; PG8_MMA(0, 0, At, B0); PG8_MMA(0, 1, At, B1); PG8_BAR; PG8_SCHED;
            PG8_LDA(At, 0, 1); PG8_STAGE(PG8_SB(0, 0), b2, voffB); PG8_STAGE(PG8_SB(0, 1), b2 + hstep, voffB); PG8_STAGE(PG8_SA(0, 0), a2, voffA);
            PG8_WAIT_V(8); PG8_WAIT_L(0); PG8_BAR; PG8_MMA(1, 0, At, B0); PG8_MMA(1, 1, At, B1); PG8_BAR; PG8_SCHED;
            PG8_LDB(B0, 1, 0); PG8_LDB(B1, 1, 1); PG8_SCHED; PG8_LDA(At, 1, 0); PG8_STAGE(PG8_SA(0, 1), a2 + hstep, voffA);
            PG8_WAIT_V(8); PG8_WAIT_L(0); PG8_BAR; PG8_MMA(0, 0, At, B0); PG8_MMA(0, 1, At, B1); PG8_BAR; PG8_SCHED;
            PG8_LDA(At, 1, 1); PG8_STAGE(PG8_SB(1, 0), b3, voffB); PG8_STAGE(PG8_SB(1, 1), b3 + hstep, voffB); PG8_STAGE(PG8_SA(1, 0), a3, voffA);
            PG8_WAIT_V(8); PG8_WAIT_L(0); PG8_BAR; PG8_MMA(1, 0, At, B0); PG8_MMA(1, 1, At, B1); PG8_BAR; PG8_SCHED;
            } else {
            PG8_LDB(B0, 0, 0); PG8_SCHED; PG8_LDA(At, 0, 0); PG8_STAGE(PG8_SA(1, 1), a1 + hstep, voffA);
            PG8_WAIT_L(8); PG8_BAR; PG8_WAIT_L(0); PG8_MMA(0, 0, At, B0); PG8_BAR; PG8_SCHED;
            PG8_LDB(B1, 0, 1); PG8_STAGE(PG8_SB(0, 0), b2, voffB);
            PG8_BAR; PG8_WAIT_L(0); PG8_MMA(0, 1, At, B1); PG8_BAR;
            PG8_LDA(At, 0, 1); PG8_STAGE(PG8_SA(0, 0), a2, voffA);
            PG8_BAR; PG8_WAIT_L(0); PG8_MMA(1, 0, At, B0); PG8_BAR; PG8_SCHED;
            PG8_STAGE(PG8_SB(0, 1), b2 + hstep, voffB);
            PG8_WAIT_V(6); PG8_BAR; PG8_MMA(1, 1, At, B1); PG8_BAR;
            PG8_LDB(B0, 1, 0); PG8_SCHED; PG8_LDA(At, 1, 0); PG8_STAGE(PG8_SA(0, 1), a2 + hstep, voffA);
            PG8_WAIT_L(8); PG8_BAR; PG8_WAIT_L(0); PG8_MMA(0, 0, At, B0); PG8_BAR; PG8_SCHED;
            PG8_LDB(B1, 1, 1); PG8_STAGE(PG8_SB(1, 0), b3, voffB);
            PG8_BAR; PG8_WAIT_L(0); PG8_MMA(0, 1, At, B1); PG8_BAR;
            PG8_LDA(At, 1, 1); PG8_STAGE(PG8_SA(1, 0), a3, voffA);
            PG8_BAR; PG8_WAIT_L(0); PG8_MMA(1, 0, At, B0); PG8_BAR; PG8_SCHED;
            PG8_STAGE(PG8_SB(1, 1), b3 + hstep, voffB);
            PG8_WAIT_V(6); PG8_BAR; PG8_MMA(1, 1, At, B1); PG8_BAR;
            }
        }
        if constexpr (ALIGN_EPI) { if (wr == 0) PG8_BAR; }
        E(acc, cur, wr, wc, fr, fq); S.done(cur);
        if (!has_next) break;
#pragma unroll
        for (int a = 0; a < 2; ++a)
#pragma unroll
            for (int b = 0; b < 2; ++b)
#pragma unroll
                for (int m = 0; m < 4; ++m)
#pragma unroll
                    for (int n = 0; n < 2; ++n) acc[a][b][m][n] = (f32x4){0.f, 0.f, 0.f, 0.f};
        cur = nxt; cA = nA; cB = nB; ++ui;
        if constexpr (ALIGN_EPI) { if (wr == 1) PG8_BAR; }
    }
    PG8_WAIT_V(0);
    if constexpr (!ALIGN_EPI) { if (wr == 0) PG8_BAR; }
    PG8_BAR;
#undef PG8_SA
#undef PG8_SB
#undef PG8_STAGE
#undef PG8_LDA
#undef PG8_LDB
#undef PG8_MMA
#undef PG8_WAIT_V
#undef PG8_WAIT_L
#undef PG8_BAR
#undef PG8_SCHED
}

#ifndef EPI_AUX
#define EPI_AUX 16
#endif
__device__ __forceinline__ __amdgpu_buffer_rsrc_t epi_rsrc(const void* base) { return __builtin_amdgcn_make_buffer_rsrc((void*)base, 0, 0x7fffffff, 0x00020000); }
__device__ __forceinline__ void epi_st16(__amdgpu_buffer_rsrc_t r, size_t elem_off, u32x4 v) { __builtin_amdgcn_raw_buffer_store_b128(v, r, (unsigned)(elem_off * 2), 0, EPI_AUX); }

__device__ __forceinline__ void epi_st8_bytes(__amdgpu_buffer_rsrc_t r, size_t byte_off, u32x2 v) { __builtin_amdgcn_raw_buffer_store_b64(v, r, (unsigned)byte_off, 0, EPI_AUX); }

__device__ __forceinline__ float row_rstd(const float* ssqp, int row, int fq) {
    const f32x4 pp = *(const f32x4*)(ssqp + (size_t)row * 16 + 4 * fq);
    float s = (pp[0] + pp[1]) + (pp[2] + pp[3]);
    s += __shfl_xor(s, 16); s += __shfl_xor(s, 32);
    return __builtin_amdgcn_rsqf(s * (1.0f / DM) + EPS_);
}

constexpr int RS_OFF = 132 * 1024;
__device__ __forceinline__ void stage_rstd(LAS unsigned char* lds, const float* ssqp, int pm) {
    const int tid = opaque_tid(), row = tid >> 1, half = tid & 1;
    const f32x4* p = (const f32x4*)(ssqp + ((size_t)pm * BM + row) * 16 + 8 * half);
    const f32x4 a = p[0], b = p[1];
    float s = ((a[0] + a[1]) + (a[2] + a[3])) + ((b[0] + b[1]) + (b[2] + b[3]));
    s += __shfl_xor(s, 1);
    if (half == 0) ((LAS float*)(lds + RS_OFF))[row] = __builtin_amdgcn_rsqf(s * (1.0f / DM) + EPS_);
    __syncthreads();
}
#define ROW_RSTD(row) ((u.pm == pm0) ? ((const LAS float*)(rsl))[(row) - pm0 * BM] : row_rstd(ssqp, (row), fq))

struct EpiIn {
    static constexpr bool PERM = true;
    bf16* O1; bf16* O2; const float* ssqp; float* lnp; int silu_hi, prod_hi; const LAS unsigned char* rsl; int pm0;
    __device__ __forceinline__ void operator()(const f32x4 (&acc)[2][2][4][2], const Unit& u, int wr, int wc, int fr, int fq) const {
        const int row0 = u.pm * BM + wr * 64 + fr, cw = wc * 32 + 8 * fq;
        if (u.pn < prod_hi) {
            const bool sl = u.pn < silu_hi;
            const __amdgpu_buffer_rsrc_t rs_ = epi_rsrc(O1);
            const size_t ob = sl ? (size_t)128 * u.pn : (size_t)(O2 - O1) + 128 * (u.pn - silu_hi);
#pragma unroll
            for (int ai = 0; ai < 2; ++ai)
#pragma unroll
                for (int m = 0; m < 4; ++m) {
                    const int row = row0 + ai * HALF + m * 16;
                    const float rstd = ROW_RSTD(row);
                    const f32x4 x0 = acc[ai][0][m][0] * rstd, x1 = acc[ai][0][m][1] * rstd; f32x4 y0 = acc[ai][1][m][0] * rstd, y1 = acc[ai][1][m][1] * rstd;
                    if (sl) {
#pragma unroll
                        for (int j = 0; j < 4; ++j) { y0[j] = silu_f(y0[j]); y1[j] = silu_f(y1[j]); }
                    }
                    u32x4 w; w.x = cvt_pk_bf16(x0[0] * y0[0], x0[1] * y0[1]); w.y = cvt_pk_bf16(x0[2] * y0[2], x0[3] * y0[3]); w.z = cvt_pk_bf16(x1[0] * y1[0], x1[1] * y1[1]); w.w = cvt_pk_bf16(x1[2] * y1[2], x1[3] * y1[3]);
                    epi_st16(rs_, ob + (size_t)row * EW + cw, w);
                }
            return;
        }
        const int tn = u.pn - prod_hi;
        const __amdgpu_buffer_rsrc_t rs2_ = epi_rsrc(O2);
#pragma unroll
        for (int ai = 0; ai < 2; ++ai)
#pragma unroll
            for (int m = 0; m < 4; ++m) {
                const int row = row0 + ai * HALF + m * 16;
                const float rstd = ROW_RSTD(row);
                const size_t rowo = (size_t)row * EW + tn * BM + cw;
                float ps = 0.f, pq = 0.f;
#pragma unroll
                for (int bj = 0; bj < 2; ++bj) {
                    const f32x4 v0 = acc[ai][bj][m][0] * rstd, v1 = acc[ai][bj][m][1] * rstd;
                    u32x4 w; w.x = cvt_pk_bf16(v0[0], v0[1]); w.y = cvt_pk_bf16(v0[2], v0[3]); w.z = cvt_pk_bf16(v1[0], v1[1]); w.w = cvt_pk_bf16(v1[2], v1[3]);
                    epi_st16(rs2_, rowo + bj * HALF, w);
                    ps += ((v0[0] + v0[1]) + (v0[2] + v0[3])) + ((v1[0] + v1[1]) + (v1[2] + v1[3]));
                    pq += ((v0[0] * v0[0] + v0[1] * v0[1]) + (v0[2] * v0[2] + v0[3] * v0[3])) + ((v1[0] * v1[0] + v1[1] * v1[1]) + (v1[2] * v1[2] + v1[3] * v1[3]));
                }
                ps += __shfl_xor(ps, 16); ps += __shfl_xor(ps, 32); pq += __shfl_xor(pq, 16); pq += __shfl_xor(pq, 32);
                if (fq == 0) *(f32x2*)(lnp + ((size_t)row * 32 + tn * 4 + wc) * 2) = (f32x2){ps, pq};
            }
    }
};

struct EpiOut {
    static constexpr bool PERM = true;
    bf16* hb; float* ssqn;
    __device__ __forceinline__ void operator()(const f32x4 (&acc)[2][2][4][2], const Unit& u, int wr, int wc, int fr, int fq) const {
        const int row0 = u.pm * BM + wr * 64 + fr, col0 = u.pn * BM + wc * 32 + 8 * fq;
        const __amdgpu_buffer_rsrc_t rsh_ = epi_rsrc(hb);
        u32x4 rv[2][4][2];
#pragma unroll
        for (int ai = 0; ai < 2; ++ai)
#pragma unroll
            for (int m = 0; m < 4; ++m)
#pragma unroll
                for (int bj = 0; bj < 2; ++bj) rv[ai][m][bj] = *(const u32x4*)(hb + (size_t)(row0 + ai * HALF + m * 16) * DM + col0 + bj * HALF);
#pragma unroll
        for (int ai = 0; ai < 2; ++ai)
#pragma unroll
            for (int m = 0; m < 4; ++m) {
                const int row = row0 + ai * HALF + m * 16;
                const size_t off = (size_t)row * DM + col0;
                float sq = 0.f;
#pragma unroll
                for (int bj = 0; bj < 2; ++bj) {
                    const u32x4 r = rv[ai][m][bj];
                    const f32x4 v0 = acc[ai][bj][m][0] + (f32x4){bflo(r.x), bfhi(r.x), bflo(r.y), bfhi(r.y)}, v1 = acc[ai][bj][m][1] + (f32x4){bflo(r.z), bfhi(r.z), bflo(r.w), bfhi(r.w)};
                    u32x4 w; w.x = cvt_pk_bf16(v0[0], v0[1]); w.y = cvt_pk_bf16(v0[2], v0[3]); w.z = cvt_pk_bf16(v1[0], v1[1]); w.w = cvt_pk_bf16(v1[2], v1[3]);
                    epi_st16(rsh_, off + bj * HALF, w);
                    sq += ((v0[0] * v0[0] + v0[1] * v0[1]) + (v0[2] * v0[2] + v0[3] * v0[3])) + ((v1[0] * v1[0] + v1[1] * v1[1]) + (v1[2] * v1[2] + v1[3] * v1[3]));
                }
                sq += __shfl_xor(sq, 16); sq += __shfl_xor(sq, 32);
                if (fq == 0) ssqn[(size_t)row * 16 + u.pn * 4 + wc] = sq;
            }
    }
};

struct EpiCin {
    static constexpr bool PERM = true;
    bf16* QKV; bf16* GATE; const float* ssqp; const float* rope; float* out; const LAS unsigned char* rsl; int pm0;
    __device__ __forceinline__ void operator()(const f32x4 (&acc)[2][2][4][2], const Unit& u, int wr, int wc, int fr, int fq) const {
        const int row0 = u.pm * BM + wr * 64 + fr;
        if (u.pn >= 72) {
            const int col0 = (u.pn - 72) * BM + wc * 32 + 8 * fq;
            const __amdgpu_buffer_rsrc_t rsg_ = epi_rsrc(GATE);
#pragma unroll
            for (int ai = 0; ai < 2; ++ai)
#pragma unroll
                for (int m = 0; m < 4; ++m) {
                    const int row = row0 + ai * HALF + m * 16;
                    const float rstd = ROW_RSTD(row);
                    const size_t rowo = (size_t)row * EW + col0;
#pragma unroll
                    for (int bj = 0; bj < 2; ++bj) {
                        const f32x4 v0 = acc[ai][bj][m][0] * rstd, v1 = acc[ai][bj][m][1] * rstd;
                        u32x2 w; w.x = pk4_fp8(silu_f(v0[0]), silu_f(v0[1]), silu_f(v0[2]), silu_f(v0[3])); w.y = pk4_fp8(silu_f(v1[0]), silu_f(v1[1]), silu_f(v1[2]), silu_f(v1[3]));
                        epi_st8_bytes(rsg_, rowo + bj * HALF, w);
                    }
                }
            return;
        }
        const int which = u.pn / 24, g = (u.pn % 24) >> 3, hp2 = u.pn & 7;
        const int dsh = 2 * g, lsh = 13 - dsh, dmask = (1 << dsh) - 1, win = 128 << dsh;
        const int b = u.pm >> 5;
        const bool do_rope = (which < 2) && (wc == 0);
        const __amdgpu_buffer_rsrc_t rsq_ = epi_rsrc(QKV);
        float ivr[4];
#pragma unroll
        for (int q = 0; q < 4; ++q) ivr[q] = __builtin_amdgcn_exp2f(-(float)(4 * fq + q) * 1.1832230355827609f - 2.651496129472319f);
#pragma unroll
        for (int ai = 0; ai < 2; ++ai)
#pragma unroll
            for (int m = 0; m < 4; ++m) {
                const int row = row0 + ai * HALF + m * 16;
                const int t = row & (SEQ_ - 1);
                const int sp = ((t & dmask) << lsh) | (t >> dsh);
                const float rstd = ROW_RSTD(row);
                f32x4 cs0 = (f32x4){1.f, 0.f, 1.f, 0.f}, cs1 = cs0;
                if (do_rope) { const float tf = (float)t;
                    const float r0 = __builtin_amdgcn_fractf(tf * ivr[0]), r1 = __builtin_amdgcn_fractf(tf * ivr[1]), r2 = __builtin_amdgcn_fractf(tf * ivr[2]), r3 = __builtin_amdgcn_fractf(tf * ivr[3]);
                    cs0 = (f32x4){__builtin_amdgcn_cosf(r0), __builtin_amdgcn_sinf(r0), __builtin_amdgcn_cosf(r1), __builtin_amdgcn_sinf(r1)};
                    cs1 = (f32x4){__builtin_amdgcn_cosf(r2), __builtin_amdgcn_sinf(r2), __builtin_amdgcn_cosf(r3), __builtin_amdgcn_sinf(r3)}; }
#pragma unroll
                for (int bj = 0; bj < 2; ++bj) {
                    const int h = 2 * hp2 + bj;
                    f32x4 v0 = acc[ai][bj][m][0] * rstd, v1 = acc[ai][bj][m][1] * rstd;
                    if (do_rope) {
                        const f32x4 a = v0, c = v1;
                        v0[0] = a[0] * cs0[0] - a[1] * cs0[1]; v0[1] = a[1] * cs0[0] + a[0] * cs0[1];
                        v0[2] = a[2] * cs0[2] - a[3] * cs0[3]; v0[3] = a[3] * cs0[2] + a[2] * cs0[3];
                        v1[0] = c[0] * cs1[0] - c[1] * cs1[1]; v1[1] = c[1] * cs1[0] + c[0] * cs1[1];
                        v1[2] = c[2] * cs1[2] - c[3] * cs1[3]; v1[3] = c[3] * cs1[2] + c[2] * cs1[3];
                    }
                    if (which == 0) {
                        u32x2 w8; w8.x = pk4_fp8(v0[0], v0[1], v0[2], v0[3]); w8.y = pk4_fp8(v1[0], v1[1], v1[2], v1[3]);
                        epi_st8_bytes(rsq_, ((((size_t)g * 2 + b) * 16 + h) * SEQ_ + sp) * 128 + wc * 32 + 8 * fq, w8);
                    } else {
                        u32x4 w; w.x = cvt_pk_bf16(v0[0], v0[1]); w.y = cvt_pk_bf16(v0[2], v0[3]); w.z = cvt_pk_bf16(v1[0], v1[1]); w.w = cvt_pk_bf16(v1[2], v1[3]);
                        epi_st16(rsq_, ((((size_t)(which * 3 + g) * 2 + b) * 16 + h) * SEQ_ + sp) * 128 + wc * 32 + 8 * fq, w);
                    }
                }
            }
    }
};
}

#define XB_TMO      128
#define XB_XCNT(j)  (256  + 64 * (j))
#define XB_XSUB(j)  (1280 + 64 * (j))
#define XB_XGEN(j)  (2304 + 64 * (j))
#define XB_TOP      3328
#define XB_TOPGEN   3392
#define XCD_BAR_WORDS 3456
#define XB_SPIN_CAP (1u << 18)

__device__ __forceinline__ unsigned xb_ld(unsigned* p)              { return __hip_atomic_load(p, __ATOMIC_RELAXED, __HIP_MEMORY_SCOPE_AGENT); }
__device__ __forceinline__ unsigned xb_add(unsigned* p, unsigned v) { return __hip_atomic_fetch_add(p, v, __ATOMIC_RELAXED, __HIP_MEMORY_SCOPE_AGENT); }
__device__ __forceinline__ unsigned xb_xcc_id() { return (unsigned)__builtin_amdgcn_s_getreg((3 << 11) | 20) & 0xFu; }
#define XB_SPIN(cond, bar) do { unsigned _sp = 0; while (cond) { __builtin_amdgcn_s_sleep(1); \
    if ((++_sp & 255u) == 0u) { if (xb_ld(&(bar)[XB_TMO])) break; if (_sp > XB_SPIN_CAP) { atomicAdd(&(bar)[XB_TMO], 1u); break; } } } } while (0)

struct XcdBarrier { unsigned* bar; unsigned x; volatile LAS unsigned* st; };

__device__ __forceinline__ XcdBarrier xcd_barrier_post(unsigned* bar, volatile LAS unsigned* st) {
    XcdBarrier b; b.bar = bar; b.x = xb_xcc_id(); b.st = st;
    if (threadIdx.x == 0) (void)xb_add(&bar[XB_XCNT(b.x)], 1u);
    return b;
}
__device__ __forceinline__ void xcd_barrier_complete(unsigned* bar, unsigned x, unsigned& nloc, unsigned& nx) {
    const unsigned G = gridDim.x * gridDim.y * gridDim.z;
    unsigned sum, cnt, mine, sp = 0u;
    for (;;) {
        sum = 0u; cnt = 0u; mine = 0u;
#pragma unroll
        for (unsigned j = 0; j < 16; ++j) { const unsigned c = xb_ld(&bar[XB_XCNT(j)]); sum += c; cnt += (c > 0u) ? 1u : 0u; mine = (j == x) ? c : mine; }
        if (sum == G) break;
        __builtin_amdgcn_s_sleep(1);
        if ((++sp & 255u) == 0u) { if (xb_ld(&bar[XB_TMO])) break; if (sp > XB_SPIN_CAP) { atomicAdd(&bar[XB_TMO], 1u); break; } }
    }
    nloc = mine > 0u ? mine : 1u; nx = cnt > 0u ? cnt : 1u;
}
__device__ __forceinline__ void xcd_barrier(const XcdBarrier& b) {
    asm volatile("s_waitcnt vmcnt(0)" ::: "memory");
    __syncthreads();
    if (threadIdx.x == 0) {
        unsigned* bar = b.bar;
        __builtin_amdgcn_s_waitcnt(0);
        unsigned nloc = b.st[0], nx = b.st[1];
        if (nloc == 0u) { xcd_barrier_complete(bar, b.x, nloc, nx); b.st[0] = nloc; b.st[1] = nx; }
        const unsigned old = xb_add(&bar[XB_XSUB(b.x)], 1u);
        const unsigned gen = old / nloc;
        if (old + 1u == (gen + 1u) * nloc) {
            __builtin_amdgcn_fence(__ATOMIC_RELEASE, "agent");
            asm volatile("s_waitcnt vmcnt(0)" ::: "memory");
            const unsigned og = xb_add(&bar[XB_TOP], 1u);
            const unsigned tg = og / nx;
            if (og + 1u == (tg + 1u) * nx) xb_add(&bar[XB_TOPGEN], 1u);
            else XB_SPIN(xb_ld(&bar[XB_TOPGEN]) == tg, bar);
            __builtin_amdgcn_fence(__ATOMIC_ACQUIRE, "agent");
            xb_add(&bar[XB_XGEN(b.x)], 1u);
            asm volatile("s_waitcnt vmcnt(0)" ::: "memory");
        } else {
            XB_SPIN(xb_ld(&bar[XB_XGEN(b.x)]) == gen, bar);
            __builtin_amdgcn_fence(__ATOMIC_ACQUIRE, "agent");
            asm volatile("s_waitcnt vmcnt(0)" ::: "memory");
        }
    }
    __syncthreads();
}

struct Args { const float* in[19]; float* out; unsigned char* ws; int ph_lo, ph_hi; };

__device__ __forceinline__ void p0_transpose_item(const float* W, int K, int N, bf16* WT, const float* scale, bool ropeperm, LAS float* scr, int kb, int nb, int lane, int sn0) {
    const int k0 = 64 * kb, n0 = 32 * nb;
    float tv[32];
#pragma unroll
    for (int i = 0; i < 32; ++i) { const int kk = 2 * i + (lane >> 5); tv[i] = W[(size_t)(k0 + kk) * N + sn0 + (lane & 31)]; }
    const float sc0 = scale ? scale[k0 + lane] : 1.0f;
#pragma unroll
    for (int i = 0; i < 32; ++i) { const int kk = 2 * i + (lane >> 5); scr[kk * 33 + (lane & 31)] = tv[i] * __shfl(sc0, kk); }
    LDS_WAIT(); asm volatile("" ::: "memory");
    const int c = lane & 7;
#pragma unroll
    for (int j = 0; j < 4; ++j) { const int n = (lane >> 3) + 8 * j; const int sn = ropeperm ? ((n >> 1) + ((n & 1) << 4)) : n; const LAS float* s = scr + (8 * c) * 33 + sn;
        u32x4 o; o.x = cvt_pk_bf16(s[0 * 33], s[1 * 33]); o.y = cvt_pk_bf16(s[2 * 33], s[3 * 33]); o.z = cvt_pk_bf16(s[4 * 33], s[5 * 33]); o.w = cvt_pk_bf16(s[6 * 33], s[7 * 33]);
        *(u32x4*)(WT + (size_t)(n0 + n) * K + k0 + 8 * c) = o; }
    LDS_WAIT(); asm volatile("" ::: "memory");
}

__device__ __forceinline__ void p0_prologue(const Args& a, LAS unsigned char* lds, int G) {
    const int tid = opaque_tid(), lane = tid & 63, wave = tid >> 6;
    unsigned char* ws = a.ws;
    LAS float* scr = (LAS float*)(lds + wave * 16384);
    const int gw = blockIdx.x * NWAVES + wave, NGW = G * NWAVES;
    constexpr int I_AIN = (DM / 64) * (N_AIN / 32), I_BIN = (DM / 64) * (N_BIN / 32), I_CIN = (DM / 64) * (N_CIN / 32), I_OUT = (EW / 64) * (DM / 32);
    constexpr int NITEMS = 2 * I_AIN + I_BIN + I_CIN + 4 * I_OUT;
    for (int it = gw; it < NITEMS; it += NGW) {
        int r = it;
        if (r < 2 * I_AIN) { const int la = r >= I_AIN; if (la) r -= I_AIN; const int nb = r % (N_AIN / 32), n0 = 32 * nb, tile = n0 >> 8, wi = n0 & 255;
            const int sn0 = tile < 16 ? (wi < 128 ? 128 * tile + wi : 2 * EW + 128 * tile + wi - 128) : EW + 256 * (tile - 16) + wi;
            p0_transpose_item(a.in[8] + (size_t)la * DM * N_AIN, DM, N_AIN, (bf16*)(ws + (la ? WS_WA_IN1 : WS_WA_IN0)), a.in[6] + (la ? 3 : 0) * DM, false, scr, r / (N_AIN / 32), nb, lane, sn0); continue; } r -= 2 * I_AIN;
        if (r < I_BIN) { const int nb = r % (N_BIN / 32), n0 = 32 * nb, tile = n0 >> 8, wi = n0 & 255, t2 = tile - 16;
            const int sn0 = tile < 16 ? (wi < 128 ? 128 * tile + wi : 3 * EW + 128 * tile + wi - 128) : (wi < 128 ? EW + 128 * t2 + wi : 2 * EW + 128 * t2 + wi - 128);
            p0_transpose_item(a.in[14], DM, N_BIN, (bf16*)(ws + WS_WB_IN), a.in[6] + 1 * DM, false, scr, r / (N_BIN / 32), nb, lane, sn0); continue; } r -= I_BIN;
        if (r < I_CIN) { const int nb = r % (N_CIN / 32);
            const bool ropeperm = (nb * 32 < 2 * 3 * EW) && ((nb & 3) == 0);
            p0_transpose_item(a.in[17], DM, N_CIN, (bf16*)(ws + WS_WC_IN), a.in[6] + 2 * DM, ropeperm, scr, r / (N_CIN / 32), nb, lane, 32 * nb); continue; } r -= I_CIN;
        const int which = r / I_OUT; r -= which * I_OUT;
        const float* src = which == 0 ? a.in[13] : (which == 1 ? a.in[13] + (size_t)EW * DM : (which == 2 ? a.in[16] : a.in[18]));
        bf16* dst = (bf16*)(ws + (which == 0 ? WS_WA_OUT0 : (which == 1 ? WS_WA_OUT1 : (which == 2 ? WS_WB_OUT : WS_WC_OUT))));
        p0_transpose_item(src, EW, DM, dst, nullptr, false, scr, r / (DM / 32), r % (DM / 32), lane, 32 * (r % (DM / 32)));
    }
    {
        const float* x = a.in[0]; bf16* hb = (bf16*)(ws + WS_HB); float* ssq0 = (float*)(ws + WS_SSQP);
        for (int m = gw; m < M_; m += NGW) {
            const f32x4* xr = (const f32x4*)(x + (size_t)m * DM) + lane;
            f32x4 v[4]; float s = 0.f;
#pragma unroll
            for (int j = 0; j < 4; ++j) { v[j] = xr[64 * j]; s += (v[j][0] * v[j][0] + v[j][1] * v[j][1]) + (v[j][2] * v[j][2] + v[j][3] * v[j][3]); }
            s = wave_sum(s);
            u32x2* o8 = (u32x2*)(hb + (size_t)m * DM) + lane;
#pragma unroll
            for (int j = 0; j < 4; ++j) { u32x2 w; w.x = cvt_pk_bf16(v[j][0], v[j][1]); w.y = cvt_pk_bf16(v[j][2], v[j][3]); o8[64 * j] = w; }
            if (lane < 16) ssq0[(size_t)m * 16 + lane] = (lane == 0) ? s : 0.f;
        }
    }
    const int gt = blockIdx.x * (NWAVES * 64) + tid, NGT = G * NWAVES * 64;
    { const float* xs = a.in[1]; float* hs = (float*)(ws + WS_HS); for (int i = gt; i < MS_ * DM; i += NGT) hs[i] = xs[i]; }
    { f32x2* rope = (f32x2*)(ws + WS_ROPE);
      for (int i = SEQ_ * 16 + gt; i < (SEQ_ + 1) * 16; i += NGT) { const int pos = i >> 4, k = i & 15;
          const float inv = (float)pow(500000.0, -(double)k / 16.0); const float ang = (float)pos * inv;
          rope[i] = (f32x2){(float)cos((double)ang), (float)sin((double)ang)}; } }
    { const float* wsrc = a.in[11]; bf16* wt = (bf16*)(ws + WS_WTRIL);
      for (int i = gt; i < 2 * 8 * 128 * 128 / 2; i += NGT) { const int e = 2 * i, ii = (e >> 7) & 127, jj = e & 127;
          const float v0 = (jj <= ii) ? wsrc[e] : 0.f, v1 = (jj + 1 <= ii) ? wsrc[e + 1] : 0.f;
          ((unsigned*)wt)[i] = cvt_pk_bf16(v0, v1); } }
}

__device__ __forceinline__ void sample_in_gemm(LAS unsigned char* lds, const float* hs, const bf16* Wt, int N, float* zs, int G) {
    const int tid = opaque_tid(), lane = tid & 63, wave = tid >> 6, fr = lane & 15, fq = lane >> 4;
    constexpr int PITCH = 2064;
    LAS float* rs = (LAS float*)(lds + 32 * PITCH);
    {
        const int row = tid >> 4, c0 = (tid & 15) * 64;
        const f32x4* src = (const f32x4*)(hs + (size_t)row * DM + c0);
        float s = 0.f;
#pragma unroll
        for (int i = 0; i < 8; ++i) { const f32x4 a0 = src[2 * i], a1 = src[2 * i + 1];
            s += ((a0[0] * a0[0] + a0[1] * a0[1]) + (a0[2] * a0[2] + a0[3] * a0[3])) + ((a1[0] * a1[0] + a1[1] * a1[1]) + (a1[2] * a1[2] + a1[3] * a1[3]));
            u32x4 w; w.x = cvt_pk_bf16(a0[0], a0[1]); w.y = cvt_pk_bf16(a0[2], a0[3]); w.z = cvt_pk_bf16(a1[0], a1[1]); w.w = cvt_pk_bf16(a1[2], a1[3]);
            *(LAS u32x4*)(lds + row * PITCH + (c0 + 8 * i) * 2) = w; }
        s += __shfl_xor(s, 1); s += __shfl_xor(s, 2); s += __shfl_xor(s, 4); s += __shfl_xor(s, 8);
        if ((tid & 15) == 0) rs[row] = __builtin_amdgcn_rsqf(s * (1.0f / DM) + EPS_);
    }
    __syncthreads();
    const int ntiles = N / 16;
    for (int nt = blockIdx.x + G * wave; nt < ntiles; nt += G * NWAVES) {
        f32x4 acc0 = (f32x4){0.f, 0.f, 0.f, 0.f}, acc1 = acc0;
        const bf16* bp = Wt + (size_t)(nt * 16 + fr) * DM + 8 * fq;
        int apo = fr * PITCH + fq * 16; asm volatile("" : "+v"(apo));
        const LAS unsigned char* ap = lds + apo;
        for (int kh = 0; kh < 2; ++kh) {
            bf16x8 bw[16];
#pragma unroll
            for (int k = 0; k < 16; ++k) bw[k] = *(const bf16x8*)(bp + 32 * (16 * kh + k));
#pragma unroll
            for (int k = 0; k < 16; ++k) {
                const bf16x8 a0 = *(const LAS bf16x8*)(ap + (16 * kh + k) * 64), a1 = *(const LAS bf16x8*)(ap + 16 * PITCH + (16 * kh + k) * 64);
                acc0 = __builtin_amdgcn_mfma_f32_16x16x32_bf16(bw[k], a0, acc0, 0, 0, 0);
                acc1 = __builtin_amdgcn_mfma_f32_16x16x32_bf16(bw[k], a1, acc1, 0, 0, 0);
            }
        }
        const float r0 = rs[fr], r1 = rs[16 + fr];
        *(f32x4*)(zs + (size_t)fr * N + nt * 16 + 4 * fq) = acc0 * r0;
        *(f32x4*)(zs + (size_t)(16 + fr) * N + nt * 16 + 4 * fq) = acc1 * r1;
    }
    __syncthreads();
}
__device__ __forceinline__ void sample_out_gemm(LAS unsigned char* lds, const bf16* ts, const bf16* Wt, float* hs, int G) {
    const int tid = opaque_tid(), lane = tid & 63, wave = tid >> 6, fr = lane & 15, fq = lane >> 4;
    LAS f32x4* red = (LAS f32x4*)lds;
    for (int nt = blockIdx.x; nt < DM / 16; nt += G) {
        f32x4 acc0 = (f32x4){0.f, 0.f, 0.f, 0.f}, acc1 = acc0;
        const bf16* bp = Wt + (size_t)(nt * 16 + fr) * EW + 256 * wave + 8 * fq;
        const bf16* ap = ts + (size_t)fr * EW + 256 * wave + 8 * fq;
        bf16x8 bw[8], a0[8], a1[8];
#pragma unroll
        for (int k = 0; k < 8; ++k) { bw[k] = *(const bf16x8*)(bp + 32 * k); a0[k] = *(const bf16x8*)(ap + 32 * k); a1[k] = *(const bf16x8*)(ap + 16 * EW + 32 * k); }
#pragma unroll
        for (int k = 0; k < 8; ++k) {
            acc0 = __builtin_amdgcn_mfma_f32_16x16x32_bf16(bw[k], a0[k], acc0, 0, 0, 0);
            acc1 = __builtin_amdgcn_mfma_f32_16x16x32_bf16(bw[k], a1[k], acc1, 0, 0, 0);
        }
        red[(wave * 2 + 0) * 64 + lane] = acc0; red[(wave * 2 + 1) * 64 + lane] = acc1;
        __syncthreads();
        if (wave < 2) {
            f32x4 sum = red[(0 * 2 + wave) * 64 + lane];
#pragma unroll
            for (int w = 1; w < 8; ++w) sum = sum + red[(w * 2 + wave) * 64 + lane];
            f32x4* p0 = (f32x4*)(hs + (size_t)(16 * wave + fr) * DM + nt * 16 + 4 * fq);
            *p0 = *p0 + sum;
        }
        __syncthreads();
    }
}

__device__ __forceinline__ void mix_a_phase(LAS unsigned char* lds, const Args& a, int layerA, int G) {
    const int tid = opaque_tid(), lane = tid & 63, wave = __builtin_amdgcn_readfirstlane(tid >> 6), fr = lane & 15, fq = lane >> 4, wr = wave >> 2, wc = wave & 3;
    unsigned char* ws = a.ws;
    const bf16* UG = (const bf16*)(ws + WS_Z); const bf16* Vb = UG + (size_t)M_ * EW; bf16* T = (bf16*)(ws + WS_T);
    const float* lnp = (const float*)(ws + WS_LNP);
    const float* lg = a.in[9] + layerA * EW; const float* lb = a.in[10] + layerA * EW;
    const float* bs = a.in[12] + layerA * 8 * 128;
    const bf16* wtril = (const bf16*)(ws + WS_WTRIL) + (size_t)layerA * 8 * 128 * 128;
    constexpr int VP = 272;
    LAS unsigned char* vT = lds;
    LAS f32x2* stat = (LAS f32x2*)(lds + 256 * VP);
    LAS unsigned char* wA = lds + 72 * 1024;
    u32x4 vraw[2][4]; f32x4 lnq[4]; u32x4 ugr[4][2]; u32x4 war[4];
    const int sj = tid >> 2, sq4 = tid & 3;
#define MIX_LOADV(uu) do { const int c_ = (uu) >> 3, g_ = (uu) & 7; \
        const f32x4* p_ = (const f32x4*)(lnp + ((size_t)(128 * c_ + sj) * 32 + sq4 * 8) * 2); \
        _Pragma("unroll") for (int i = 0; i < 4; ++i) lnq[i] = p_[i]; \
        _Pragma("unroll") for (int it = 0; it < 2; ++it) { const int item = tid + it * 512, ec = item & 31, jb = item >> 5; \
            _Pragma("unroll") for (int rr = 0; rr < 4; ++rr) vraw[it][rr] = *(const u32x4*)(Vb + (size_t)(128 * c_ + 4 * jb + rr) * EW + 256 * g_ + 8 * ec); } \
        _Pragma("unroll") for (int q = 0; q < 4; ++q) { const int idx = tid + 512 * q; war[q] = *(const u32x4*)(wtril + (size_t)g_ * 128 * 128 + (size_t)(idx >> 4) * 128 + (idx & 15) * 8); } } while (0)
#define MIX_LOADUG(uu) do { const int c_ = (uu) >> 3, g_ = (uu) & 7; \
        _Pragma("unroll") for (int m = 0; m < 4; ++m) _Pragma("unroll") for (int np = 0; np < 2; ++np) \
            ugr[m][np] = *(const u32x4*)(UG + ((size_t)128 * c_ + 64 * wr + 16 * m + fr) * EW + 256 * g_ + 64 * wc + 32 * np + 8 * fq); } while (0)
    if ((int)blockIdx.x < 1024) { MIX_LOADV((int)blockIdx.x); MIX_LOADUG((int)blockIdx.x); }
    for (int u = blockIdx.x; u < 1024; u += G) {
        const int c = u >> 3, g = u & 7, un = (u + G < 1024) ? u + G : u;
        {
#pragma unroll
            for (int q = 0; q < 4; ++q) { const int idx = tid + 512 * q; *(LAS u32x4*)(wA + (idx >> 4) * VP + (idx & 15) * 16) = war[q]; }
            float s = 0.f, ss = 0.f;
#pragma unroll
            for (int i = 0; i < 4; ++i) { const f32x4 x = lnq[i]; s += x[0] + x[2]; ss += x[1] + x[3]; }
            s += __shfl_xor(s, 1); s += __shfl_xor(s, 2); ss += __shfl_xor(ss, 1); ss += __shfl_xor(ss, 2);
            const float mean = s * (1.0f / EW); const float var = fmaxf(ss * (1.0f / EW) - mean * mean, 0.f);
            if (sq4 == 0) stat[sj] = (f32x2){mean, __builtin_amdgcn_rsqf(var + EPS_)};
        }
        __syncthreads();
#pragma unroll
        for (int it = 0; it < 2; ++it) {
            const int item = tid + it * 512, ec = item & 31, jb = item >> 5;
            const f32x4 g0 = *(const f32x4*)(lg + 256 * g + 8 * ec), g1 = *(const f32x4*)(lg + 256 * g + 8 * ec + 4);
            const f32x4 b0 = *(const f32x4*)(lb + 256 * g + 8 * ec), b1 = *(const f32x4*)(lb + 256 * g + 8 * ec + 4);
            float vals[4][8];
#pragma unroll
            for (int rr = 0; rr < 4; ++rr) {
                const int j = 4 * jb + rr;
                const u32x4 raw = vraw[it][rr];
                const f32x2 st = stat[j];
                vals[rr][0] = (bflo(raw.x) - st.x) * st.y * g0[0] + b0[0]; vals[rr][1] = (bfhi(raw.x) - st.x) * st.y * g0[1] + b0[1];
                vals[rr][2] = (bflo(raw.y) - st.x) * st.y * g0[2] + b0[2]; vals[rr][3] = (bfhi(raw.y) - st.x) * st.y * g0[3] + b0[3];
                vals[rr][4] = (bflo(raw.z) - st.x) * st.y * g1[0] + b1[0]; vals[rr][5] = (bfhi(raw.z) - st.x) * st.y * g1[1] + b1[1];
                vals[rr][6] = (bflo(raw.w) - st.x) * st.y * g1[2] + b1[2]; vals[rr][7] = (bfhi(raw.w) - st.x) * st.y * g1[3] + b1[3];
            }
#pragma unroll
            for (int q = 0; q < 8; ++q) {
                const int e = 8 * ec + q, c32 = e & 31, slot = (e & ~31) + 16 * ((c32 >> 2) & 1) + 4 * (c32 >> 3) + (c32 & 3);
                u32x2 w; w.x = cvt_pk_bf16(vals[0][q], vals[1][q]); w.y = cvt_pk_bf16(vals[2][q], vals[3][q]);
                const int gsw = ((slot >> 5) & 3) + 4 * ((slot >> 3) & 1);
                *(LAS u32x2*)(vT + slot * VP + 16 * ((jb >> 1) ^ gsw) + 8 * (jb & 1)) = w;
            }
        }
        MIX_LOADV(un);
        __syncthreads();
        f32x4 acc[4][4];
#pragma unroll
        for (int m = 0; m < 4; ++m)
#pragma unroll
            for (int n = 0; n < 4; ++n) acc[m][n] = (f32x4){0.f, 0.f, 0.f, 0.f};
        const int kmax = wr ? 4 : 2;
        for (int k = 0; k < kmax; ++k) {
            bf16x8 af[4], bfv[4];
#pragma unroll
            for (int m = 0; m < 4; ++m) af[m] = *(const LAS bf16x8*)(wA + (64 * wr + 16 * m + fr) * VP + (32 * k + 8 * fq) * 2);
#pragma unroll
            for (int n = 0; n < 4; ++n) { const int R = 64 * wc + 16 * n + fr, gsw = ((R >> 5) & 3) + 4 * ((R >> 3) & 1);
                bfv[n] = *(const LAS bf16x8*)(vT + R * VP + 16 * ((4 * k + fq) ^ gsw)); }
#pragma unroll
            for (int m = 0; m < 4; ++m)
#pragma unroll
                for (int n = 0; n < 4; ++n) acc[m][n] = __builtin_amdgcn_mfma_f32_16x16x32_bf16(bfv[n], af[m], acc[m][n], 0, 0, 0);
        }
#pragma unroll
        for (int m = 0; m < 4; ++m) {
            const int i = 64 * wr + 16 * m + fr; const size_t row = (size_t)128 * c + i;
            const float bsv = bs[g * 128 + i];
#pragma unroll
            for (int np = 0; np < 2; ++np) {
                const int e0 = 256 * g + 64 * wc + 32 * np + 8 * fq;
                const u32x4 uu = ugr[m][np];
                const f32x4 x0 = acc[m][2 * np] + bsv, x1 = acc[m][2 * np + 1] + bsv;
                u32x4 w;
                w.x = cvt_pk_bf16(bflo(uu.x) * x0[0], bfhi(uu.x) * x0[1]);
                w.y = cvt_pk_bf16(bflo(uu.y) * x0[2], bfhi(uu.y) * x0[3]);
                w.z = cvt_pk_bf16(bflo(uu.z) * x1[0], bfhi(uu.z) * x1[1]);
                w.w = cvt_pk_bf16(bflo(uu.w) * x1[2], bfhi(uu.w) * x1[3]);
                *(u32x4*)(T + row * EW + e0) = w;
            }
        }
        MIX_LOADUG(un);
        __syncthreads();
    }
#undef MIX_LOADV
#undef MIX_LOADUG
    const int gw = blockIdx.x * NWAVES + wave;
    if (gw < MS_) {
        const int b = gw; const float* zs = (const float*)(ws + WS_ZS) + (size_t)b * N_AIN;
        const float* wsrc = a.in[11] + (size_t)layerA * 8 * 128 * 128;
        f32x4 v[8]; float s = 0.f;
#pragma unroll
        for (int i = 0; i < 8; ++i) { v[i] = *(const f32x4*)(zs + 2 * EW + 256 * i + 4 * lane); s += (v[i][0] + v[i][1]) + (v[i][2] + v[i][3]); }
        const float mean = wave_sum(s) * (1.0f / EW); float q = 0.f;
#pragma unroll
        for (int i = 0; i < 8; ++i) { v[i] = v[i] - mean; q += (v[i][0] * v[i][0] + v[i][1] * v[i][1]) + (v[i][2] * v[i][2] + v[i][3] * v[i][3]); }
        const float rstd = __builtin_amdgcn_rsqf(wave_sum(q) * (1.0f / EW) + EPS_);
        float* sv = a.out + OFF_SV + ((size_t)layerA * MS_ + b) * EW; bf16* ts = (bf16*)(ws + WS_TS) + (size_t)b * EW;
#pragma unroll
        for (int i = 0; i < 8; ++i) {
            const int e = 256 * i + 4 * lane;
            const f32x4 vn = v[i] * rstd * *(const f32x4*)(lg + e) + *(const f32x4*)(lb + e);
            *(f32x4*)(sv + e) = vn;
            const float w00 = wsrc[(size_t)i * 128 * 128], b00 = bs[i * 128];
            const int pe = 256 * (e >> 7) + (e & 127);
            const f32x4 uu = *(const f32x4*)(zs + pe), gg = *(const f32x4*)(zs + pe + 128);
            u32x2 w; w.x = cvt_pk_bf16(uu[0] * (w00 * vn[0] + b00) * silu_f(gg[0]), uu[1] * (w00 * vn[1] + b00) * silu_f(gg[1]));
            w.y = cvt_pk_bf16(uu[2] * (w00 * vn[2] + b00) * silu_f(gg[2]), uu[3] * (w00 * vn[3] + b00) * silu_f(gg[3]));
            *(u32x2*)(ts + e) = w;
        }
    }
}

__device__ __forceinline__ void conv_b_phase(const Args& a, int G) {
    const int tid = opaque_tid();
    unsigned char* ws = a.ws;
    const bf16* BGG = (const bf16*)(ws + WS_Z); const bf16* P = BGG + (size_t)M_ * EW; bf16* T = (bf16*)(ws + WS_T);
    const float* cw = a.in[15];
    const int NIT = (M_ / 32) * 256;
#define UNPK8(dst, v) do { dst[0] = bflo(v.x); dst[1] = bfhi(v.x); dst[2] = bflo(v.y); dst[3] = bfhi(v.y); dst[4] = bflo(v.z); dst[5] = bfhi(v.z); dst[6] = bflo(v.w); dst[7] = bfhi(v.w); } while (0)
    for (int item = blockIdx.x * 512 + tid; item < NIT; item += G * 512) {
        const int cc = item & 255, rb = item >> 8, r0 = 32 * rb, c0 = 8 * cc;
        float w0[8], w1[8], w2[8];
#pragma unroll
        for (int q = 0; q < 8; ++q) { w0[q] = cw[c0 + q]; w1[q] = cw[EW + c0 + q]; w2[q] = cw[2 * EW + c0 + q]; }
        float p2[8], p1[8];
        if ((r0 & (SEQ_ - 1)) == 0) {
#pragma unroll
            for (int q = 0; q < 8; ++q) { p2[q] = 0.f; p1[q] = 0.f; }
        } else {
            const u32x4 pa = *(const u32x4*)(P + (size_t)(r0 - 2) * EW + c0), pb = *(const u32x4*)(P + (size_t)(r0 - 1) * EW + c0);
            UNPK8(p2, pa); UNPK8(p1, pb);
        }
#pragma unroll 8
        for (int rr = 0; rr < 32; ++rr) {
            const size_t row = (size_t)r0 + rr;
            const u32x4 bgv = *(const u32x4*)(BGG + row * EW + c0), pv = *(const u32x4*)(P + row * EW + c0);
            float p0[8], bgf[8];
            UNPK8(p0, pv); UNPK8(bgf, bgv);
            float o[8];
#pragma unroll
            for (int q = 0; q < 8; ++q) { o[q] = bgf[q] * (w0[q] * p2[q] + w1[q] * p1[q] + w2[q] * p0[q]); }
            u32x4 w; w.x = cvt_pk_bf16(o[0], o[1]); w.y = cvt_pk_bf16(o[2], o[3]); w.z = cvt_pk_bf16(o[4], o[5]); w.w = cvt_pk_bf16(o[6], o[7]);
            *(u32x4*)(T + row * EW + c0) = w;
            const int t = (int)(row & (SEQ_ - 1));
            if (t >= SEQ_ - 2) {
                float* sp = a.out + OFF_SCP + ((size_t)(row >> 13) * 2 + (t - (SEQ_ - 2))) * EW + c0;
                *(f32x4*)sp = (f32x4){p0[0], p0[1], p0[2], p0[3]}; *(f32x4*)(sp + 4) = (f32x4){p0[4], p0[5], p0[6], p0[7]};
            }
#pragma unroll
            for (int q = 0; q < 8; ++q) { p2[q] = p1[q]; p1[q] = p0[q]; }
        }
    }
#undef UNPK8
    for (int item = blockIdx.x * 512 + tid; item < MS_ * EW; item += G * 512) {
        const int b = item >> 11, c = item & (EW - 1), pc = 256 * (c >> 7) + (c & 127);
        const float* zs = (const float*)(ws + WS_ZS) + (size_t)b * N_BIN;
        const float* st = a.in[2] + (size_t)b * 2 * EW;
        const float pr0 = st[c], pr1 = st[EW + c], pn = zs[2 * EW + pc] * zs[2 * EW + pc + 128];
        const float conv = cw[c] * pr0 + cw[EW + c] * pr1 + cw[2 * EW + c] * pn;
        const float o = zs[pc] * conv * silu_f(zs[pc + 128]);
        ((bf16*)(ws + WS_TS))[(size_t)b * EW + c] = (bf16)(cvt_pk_bf16(o, 0.f) & 0xffffu);
        float* so = a.out + OFF_SCS + (size_t)b * 2 * EW; so[c] = pr1; so[EW + c] = pn;
    }
}

namespace att {
#define KSWZ(row, colB) ((row) * 256 + ((colB) ^ (((row) & 7) << 4)))
__device__ __forceinline__ int crow(int r, int hi) { return (r & 3) + 8 * (r >> 2) + 4 * hi; }
__device__ __forceinline__ int v_st(int k, int c) { const int kk = (k & ~0xC) | ((k & 4) << 1) | ((k & 8) >> 1); return ((kk >> 3) * 4 + (c >> 5)) * 512 + ((kk & 7) * 32 + (c & 31)) * 2; }
__device__ __forceinline__ int v_rd_base(int lane) { return ((lane & 3) << 3) | (((lane >> 2) & 3) << 6) | (((lane >> 4) & 1) << 5) | (((lane >> 5) & 1) << 8); }
constexpr int v_rd_off(int d0, int ks, int half) { return d0 * 512 + ks * 4096 + half * 2048; }
template <int OFF> __device__ __forceinline__ s16x4 tr_read(int vb) { s16x4 r; asm volatile("ds_read_b64_tr_b16 %0, %1 offset:%2" : "=&v"(r) : "v"(vb), "i"(OFF) : "memory"); return r; }
constexpr int SHM_T = 16384;
constexpr int OST_OFF = 4 * SHM_T, OST_PITCH = 272, OST_WAVE = 32 * OST_PITCH;
constexpr int OST8_PITCH = 144;

template <int OFF>
__device__ __forceinline__ void qkt_half(f32x16& p, int kbase, int r32, int hi, const u32x2 (&qv)[8]) {
    p = (f32x16){};
    asm volatile("" : "+v"(r32), "+v"(hi));
    const int rowb = kbase + r32 * 256, sw = (r32 & 7) << 4;
#pragma unroll
    for (int d0 = 0; d0 < 8; ++d0) {
        const bf16x8 b0 = *(const LAS bf16x8*)(uintptr_t)(unsigned)(rowb + ((((d0 & 3) * 32) + hi * 16) ^ sw) + (d0 >> 2) * 128 + OFF);
        u32x2 q_ = qv[d0]; asm volatile("" : "+v"(q_));
        float f_[8]; unpk4_fp8(q_.x, f_[0], f_[1], f_[2], f_[3]); unpk4_fp8(q_.y, f_[4], f_[5], f_[6], f_[7]);
        const u32x4 w_ = {cvt_pk_bf16(f_[0], f_[1]), cvt_pk_bf16(f_[2], f_[3]), cvt_pk_bf16(f_[4], f_[5]), cvt_pk_bf16(f_[6], f_[7])};
        p = __builtin_amdgcn_mfma_f32_32x32x16_bf16(b0, __builtin_bit_cast(bf16x8, w_), p, 0, 0, 0);
        }
}
template <int D0, int KS0, int BUFOFF> __device__ __forceinline__ void pv_half(f32x16& od, int vb, bf16x8 pa0, bf16x8 pa1) {
    const s16x4 l0 = tr_read<v_rd_off(D0, KS0, 0) + BUFOFF>(vb), h0 = tr_read<v_rd_off(D0, KS0, 1) + BUFOFF>(vb), l1 = tr_read<v_rd_off(D0, KS0 + 1, 0) + BUFOFF>(vb), h1 = tr_read<v_rd_off(D0, KS0 + 1, 1) + BUFOFF>(vb);
    asm volatile("s_waitcnt lgkmcnt(0)" ::: "memory"); __builtin_amdgcn_sched_barrier(0);
#define PKV(L, H) (bf16x8){L[0], L[1], L[2], L[3], H[0], H[1], H[2], H[3]}
    od = __builtin_amdgcn_mfma_f32_32x32x16_bf16(PKV(l0, h0), pa0, od, 0, 0, 0);
    od = __builtin_amdgcn_mfma_f32_32x32x16_bf16(PKV(l1, h1), pa1, od, 0, 0, 0);
#undef PKV
}
struct UnitInfo { int g, b, h, qbg, first, dsh; };
__device__ __forceinline__ UnitInfo decode(int U) { UnitInfo u; u.qbg = U & 31; u.h = (U >> 5) & 15; u.b = (U >> 9) & 1; u.g = U >> 10; u.dsh = 2 * u.g; u.first = ((u.qbg & ((32 >> u.dsh) - 1)) == 0) ? 1 : 0; return u; }
}

__device__ __forceinline__ void attn_c_phase(LAS unsigned char* lds, const Args& a, int G) {
    using namespace att;
    const int tid = threadIdx.x, lane = tid & 63, wave = __builtin_amdgcn_readfirstlane(tid >> 6), r32 = lane & 31, hi = lane >> 5, wp = wave >> 1;
    unsigned char* ws = a.ws;
    const bf16* QKV = (const bf16*)(ws + WS_Z); unsigned char* OG8 = ws + WS_OG; float* LSE = (float*)(ws + WS_LSE);
    LAS unsigned char* V_lds = lds; LAS unsigned char* K_lds = lds + 2 * SHM_T;
    LAS unsigned char* ost = lds + OST_OFF + wave * OST_WAVE;
    constexpr float C = ATT_SCALE * LOG2E;
    const int kbase = (int)(uintptr_t)K_lds;
    constexpr int NU = 3 * 2 * 16 * 32;
    const bool contig = (NU % G) == 0; const int upb = contig ? NU / G : (NU + G - 1) / G;
#define UNIT_ID(i) (contig ? (int)blockIdx.x * upb + (i) : (int)blockIdx.x + G * (i))
#define UNIT_OK(i) ((i) < upb && UNIT_ID(i) < NU)
    int nun = 0; for (int i = 0; i < upb; ++i) nun += UNIT_OK(i) ? 1 : 0;
#define RUN_LEN(i0_, out_) do { int n_ = 1; while ((i0_) + n_ < nun && UNIT_ID((i0_) + n_) == UNIT_ID((i0_) + n_ - 1) + 1 && !decode(UNIT_ID((i0_) + n_)).first) ++n_; out_ = n_; } while (0)
    int l_i0 = 0, l_nu = 1, l_tau = 0; const bf16* l_kp = QKV; const bf16* l_vp = QKV;
    if (nun > 0) { RUN_LEN(0, l_nu); l_tau = decode(UNIT_ID(0)).first ? 2 : 0; }
    bf16x8 ra_k0 = {}, ra_k1 = {}, ra_v0 = {}, ra_v1 = {}, rb_k0 = {}, rb_k1 = {}, rb_v0 = {}, rb_v1 = {};
#define ISSUE(K0, K1, V0, V1) do { if (l_i0 < nun) { const UnitInfo _u = decode(UNIT_ID(l_i0)); \
            const size_t _hb = (((size_t)(_u.g) * 2 + _u.b) * 16 + _u.h) * SEQ_; const long _sp = (long)256 * _u.qbg - 128 + 64 * l_tau; \
            l_kp = QKV + ((size_t)(1 * 3) * 2 * 16 * SEQ_ + _hb + _sp) * 128; l_vp = QKV + ((size_t)(2 * 3) * 2 * 16 * SEQ_ + _hb + _sp) * 128; \
            l_tau += 1; if (l_tau > 4 * l_nu + 1) { l_i0 += l_nu; if (l_i0 < nun) { RUN_LEN(l_i0, l_nu); l_tau = decode(UNIT_ID(l_i0)).first ? 2 : 0; } } } \
        int t_ = tid; asm volatile("" : "+v"(t_)); const unsigned ldoff = (unsigned)((t_ >> 4) * 256 + (t_ & 15) * 16);     \
        K0 = *(const bf16x8*)((const char*)l_kp + ldoff); K1 = *(const bf16x8*)((const char*)l_kp + 8192 + ldoff); \
        V0 = *(const bf16x8*)((const char*)l_vp + ldoff); V1 = *(const bf16x8*)((const char*)l_vp + 8192 + ldoff); } while (0)
#define SWRITE(buf, K0, K1, V0, V1) do { int t_ = tid; asm volatile("" : "+v"(t_)); const int sr_ = t_ >> 4, sc_ = (t_ & 15) * 8; \
        const int vstA = (int)(uintptr_t)V_lds + v_st(sr_, sc_), kstA = (int)(uintptr_t)K_lds + KSWZ(sr_, sc_ * 2); \
        *(LAS bf16x8*)(uintptr_t)(unsigned)(vstA + (buf) * SHM_T) = V0; *(LAS bf16x8*)(uintptr_t)(unsigned)(vstA + (buf) * SHM_T + 8192) = V1; \
        *(LAS bf16x8*)(uintptr_t)(unsigned)(kstA + (buf) * SHM_T) = K0; *(LAS bf16x8*)(uintptr_t)(unsigned)(kstA + (buf) * SHM_T + 8192) = K1; } while (0)
#define QLOAD(uidx) do { const UnitInfo _q = decode(UNIT_ID(uidx)); \
        const unsigned char* qp = (const unsigned char*)QKV + (((((size_t)_q.g) * 2 + _q.b) * 16 + _q.h) * SEQ_ + 256 * _q.qbg + 32 * wave + r32) * 128 + hi * 8; \
        _Pragma("unroll") for (int d0 = 0; d0 < 8; ++d0) qv[d0] = *(const u32x2*)(qp + d0 * 16); } while (0)
#define EPILOGUE(uidx) do { const UnitInfo _e = decode(UNIT_ID(uidx)); const float inv = OG_SCALE * __builtin_amdgcn_rcpf(l_reg); \
        _Pragma("unroll") for (int d0 = 0; d0 < 4; ++d0) _Pragma("unroll") for (int i = 0; i < 4; ++i) \
            *(LAS unsigned*)(ost + r32 * OST8_PITCH + (32 * d0 + 8 * i + 4 * hi)) = pk4_fp8(o[d0][4 * i] * inv, o[d0][4 * i + 1] * inv, o[d0][4 * i + 2] * inv, o[d0][4 * i + 3] * inv); \
        const int lsh_ = 13 - _e.dsh, lmask_ = (1 << lsh_) - 1; \
        { const int sp_ = 256 * _e.qbg + 32 * wave + r32; const int t_ = (sp_ >> lsh_) + ((sp_ & lmask_) << _e.dsh); \
            LSE[((size_t)_e.g * M_ + (size_t)_e.b * SEQ_ + t_) * 16 + _e.h] = m_reg * ATT_SCALE + __logf(l_reg); } \
        LDS_WAIT(); asm volatile("" ::: "memory"); \
        _Pragma("unroll") for (int i = 0; i < 4; ++i) { const int ch_ = lane + 64 * i, row_ = ch_ >> 3, c16_ = ch_ & 7; \
            const u32x4 w_ = *(const LAS u32x4*)(ost + row_ * OST8_PITCH + c16_ * 16); \
            const int sp_ = 256 * _e.qbg + 32 * wave + row_; const int t_ = (sp_ >> lsh_) + ((sp_ & lmask_) << _e.dsh); \
            *(u32x4*)(OG8 + ((size_t)_e.g * M_ + (size_t)_e.b * SEQ_ + t_) * EW + _e.h * 128 + c16_ * 16) = w_; } \
        LDS_WAIT(); asm volatile("" ::: "memory"); } while (0)
    if (nun > 0) {
        ISSUE(ra_k0, ra_k1, ra_v0, ra_v1); ISSUE(rb_k0, rb_k1, rb_v0, rb_v1);
        SWRITE(0, ra_k0, ra_k1, ra_v0, ra_v1);
        __syncthreads();
        u32x2 qv[8];
        float m_reg = -1e30f, l_reg = 0.f; f32x16 o[4] = {};
        int i0 = 0;
        while (i0 < nun) {
            int nu; RUN_LEN(i0, nu);
            const int tau0 = decode(UNIT_ID(i0)).first ? 2 : 0;
            QLOAD(i0);
            for (int tau = tau0; tau <= 4 * nu + 1; tau += 2) {
#pragma unroll
                for (int par = 0; par < 2; ++par) {
                    const int tt = tau + par, k = tt - wp, n = k >> 2, ph = k & 3;
                    const bool valid = (k >= 0) && (n < nu);
                    if (valid && ph == 3) {
                        EPILOGUE(i0 + n);
                        QLOAD(i0 + (n + 1 < nu ? n + 1 : n));
                        if (par == 0) ISSUE(ra_k0, ra_k1, ra_v0, ra_v1); else ISSUE(rb_k0, rb_k1, rb_v0, rb_v1);
                        if (par == 0) SWRITE(1, rb_k0, rb_k1, rb_v0, rb_v1); else SWRITE(0, ra_k0, ra_k1, ra_v0, ra_v1);
                    } else {
                        if (par == 0) ISSUE(ra_k0, ra_k1, ra_v0, ra_v1); else ISSUE(rb_k0, rb_k1, rb_v0, rb_v1);
                        if (valid) {
                            const int jj = ph + wp;
                            if (ph == 0 || tt == tau0) { m_reg = -1e30f; l_reg = 0.f;
#pragma unroll
                                for (int d = 0; d < 4; ++d) o[d] = (f32x16){}; }
#define HALF_STEP(HH, PAR) do { \
        const bool skip_ = (HH == 0) ? ((wave & 1) && ph == 0) : (!(wave & 1) && ph == 2); \
        if (!skip_) { \
            f32x16 p; qkt_half<(PAR) * SHM_T + (HH) * 8192>(p, kbase, r32, hi, qv); \
            const bool lowb_ = (ph == 0) && ((wave & 1) ? (HH == 1) : (HH == 0)); const bool upb_ = (ph == 2) && ((wave & 1) ? (HH == 1) : (HH == 0)); \
            if (lowb_ || upb_) { const int base = 64 * jj + 32 * (HH) - 32 * wave - r32 + 4 * hi; \
                _Pragma("unroll") for (int r = 0; r < 16; ++r) { const int kx = base + (r & 3) + 8 * (r >> 2); p[r] = ((unsigned)kx <= 128u) ? p[r] : -INFINITY; } } \
            float pmax = p[0]; \
            _Pragma("unroll") for (int r = 1; r < 16; ++r) pmax = fmaxf(pmax, p[r]); \
            { auto rr = __builtin_amdgcn_permlane32_swap(__float_as_uint(pmax), __float_as_uint(pmax), false, false); pmax = fmaxf(__uint_as_float(rr[0]), __uint_as_float(rr[1])); } \
            const float mn = fmaxf(m_reg, pmax); const float alpha = __builtin_amdgcn_exp2f((m_reg - mn) * C); m_reg = mn; \
            const float mnC = -mn * C; \
            _Pragma("unroll") for (int r = 0; r < 16; ++r) p[r] = __builtin_amdgcn_exp2f(fmaf(p[r], C, mnC)); \
            float ps = 0.f; \
            _Pragma("unroll") for (int r = 0; r < 16; ++r) ps += p[r]; \
            { auto rr = __builtin_amdgcn_permlane32_swap(__float_as_uint(ps), __float_as_uint(ps), false, false); ps = __uint_as_float(rr[0]) + __uint_as_float(rr[1]); } \
            l_reg = l_reg * alpha + ps; \
            if (!__all(alpha == 1.0f)) { _Pragma("unroll") for (int d = 0; d < 4; ++d) _Pragma("unroll") for (int r = 0; r < 16; ++r) o[d][r] *= alpha; } \
            bf16x8 pa0, pa1; \
            PK4(p, 0, pa0); PK4(p, 8, pa1); \
            int l_ = lane; asm volatile("" : "+v"(l_)); const int vb0 = (int)(uintptr_t)V_lds + v_rd_base(l_); \
            pv_half<0, 2 * (HH), (PAR) * SHM_T>(o[0], vb0, pa0, pa1); pv_half<1, 2 * (HH), (PAR) * SHM_T>(o[1], vb0, pa0, pa1); \
            pv_half<2, 2 * (HH), (PAR) * SHM_T>(o[2], vb0, pa0, pa1); pv_half<3, 2 * (HH), (PAR) * SHM_T>(o[3], vb0, pa0, pa1); } } while (0)
#define PK4(P, BASE, OUT) do { unsigned a0 = cvt_pk_bf16(P[BASE + 0], P[BASE + 1]), a1 = cvt_pk_bf16(P[BASE + 2], P[BASE + 3]); \
    unsigned b0 = cvt_pk_bf16(P[BASE + 4], P[BASE + 5]), b1 = cvt_pk_bf16(P[BASE + 6], P[BASE + 7]); \
    auto r0 = __builtin_amdgcn_permlane32_swap(a0, b0, false, false); auto r1 = __builtin_amdgcn_permlane32_swap(a1, b1, false, false); \
    u32x4 w = {r0[0], r1[0], r0[1], r1[1]}; OUT = __builtin_bit_cast(bf16x8, w); } while (0)
                            if (par == 0) { HALF_STEP(0, 0); HALF_STEP(1, 0); } else { HALF_STEP(0, 1); HALF_STEP(1, 1); }
#undef PK4
#undef HALF_STEP
                        }
                        if (par == 0) SWRITE(1, rb_k0, rb_k1, rb_v0, rb_v1); else SWRITE(0, ra_k0, ra_k1, ra_v0, ra_v1);
                    }
                    __syncthreads();
                }
            }
            if (wp == 3) EPILOGUE(i0 + nu - 1);
            i0 += nu;
        }
    }
    __syncthreads();
#undef ISSUE
#undef SWRITE
#undef QLOAD
#undef EPILOGUE
#undef RUN_LEN
#undef UNIT_ID
#undef UNIT_OK
}

__device__ __forceinline__ void attn_c_sample(LAS unsigned char* lds, const Args& a, int G) {
    const int tid = opaque_tid(), lane = tid & 63, wave = __builtin_amdgcn_readfirstlane(tid >> 6);
    unsigned char* ws = a.ws;
    const float* rope = (const float*)(ws + WS_ROPE) + (size_t)SEQ_ * 16 * 2;
    constexpr int TSK = 768 * 4;
    for (int pp = blockIdx.x; pp < 256; pp += G) {
        __syncthreads();
        if (wave < 6) {
            const int pr = wave / 3, g = wave - 3 * pr, P = 2 * pp + pr, b = P >> 4, h = P & 15;
            LAS float* sm = (LAS float*)(lds + wave * TSK);
            LAS float* qs = sm, *ks = sm + 128, *vs = sm + 256, *psm = sm + 384, *os = sm + 512, *misc = sm + 640;
            const float* zs = (const float*)(ws + WS_ZS) + (size_t)b * N_CIN;
            const int dil = 1 << (2 * g), win = 128 << (2 * g);
            const float* cache = a.in[3 + g] + (size_t)b * win * 4096;
            float* kvs = a.out + (g == 0 ? OFF_KV128S : (g == 1 ? OFF_KV512S : OFF_KV2048S)) + (size_t)b * 4096 + h * 128;
            {
                const int cq = g * EW + h * 128 + 2 * lane;
                const f32x2 qv = *(const f32x2*)(zs + cq), kv = *(const f32x2*)(zs + 3 * EW + cq), vv = *(const f32x2*)(zs + 6 * EW + cq);
                if (lane < 16) { const float c = rope[2 * lane], s = rope[2 * lane + 1];
                    const float q1 = qv.x * c - qv.y * s, q2 = qv.y * c + qv.x * s, k1 = kv.x * c - kv.y * s, k2 = kv.y * c + kv.x * s;
                    qs[lane] = q1; qs[lane + 16] = q2; ks[lane] = k1; ks[lane + 16] = k2; kvs[lane] = k1; kvs[lane + 16] = k2; }
                else { qs[2 * lane] = qv.x; qs[2 * lane + 1] = qv.y; ks[2 * lane] = kv.x; ks[2 * lane + 1] = kv.y; kvs[2 * lane] = kv.x; kvs[2 * lane + 1] = kv.y; }
                vs[2 * lane] = vv.x; vs[2 * lane + 1] = vv.y; kvs[2048 + 2 * lane] = vv.x; kvs[2048 + 2 * lane + 1] = vv.y;
            }
            LDS_WAIT(); asm volatile("" ::: "memory");
            const float* k0p = cache + ((size_t)(dil * lane) * 2) * 2048 + h * 128; const float* k1p = cache + ((size_t)(dil * (lane + 64)) * 2) * 2048 + h * 128;
            float s0 = 0.f, s1 = 0.f;
#pragma unroll 8
            for (int dc = 0; dc < 32; ++dc) { const f32x4 q4 = *(const LAS f32x4*)(qs + 4 * dc); const f32x4 ka = *(const f32x4*)(k0p + 4 * dc), kb = *(const f32x4*)(k1p + 4 * dc);
                s0 += (q4[0] * ka[0] + q4[1] * ka[1]) + (q4[2] * ka[2] + q4[3] * ka[3]); s1 += (q4[0] * kb[0] + q4[1] * kb[1]) + (q4[2] * kb[2] + q4[3] * kb[3]); }
            float sn = qs[2 * lane] * ks[2 * lane] + qs[2 * lane + 1] * ks[2 * lane + 1]; sn = wave_sum(sn);
            s0 *= ATT_SCALE; s1 *= ATT_SCALE; sn *= ATT_SCALE;
            const float mx = fmaxf(wave_max(fmaxf(s0, s1)), sn);
            const float e0 = __expf(s0 - mx), e1 = __expf(s1 - mx), en = __expf(sn - mx);
            const float den = wave_sum(e0 + e1) + en;
            psm[lane] = e0; psm[lane + 64] = e1;
            LDS_WAIT(); asm volatile("" ::: "memory");
            f32x2 acc = (f32x2){en * vs[2 * lane], en * vs[2 * lane + 1]};
            const float* vp = cache + 2048 + h * 128 + 2 * lane;
#pragma unroll 16
            for (int i = 0; i < 128; ++i) { const f32x2 vv = *(const f32x2*)(vp + (size_t)(dil * i) * 4096); const float pi = psm[i]; acc.x += pi * vv.x; acc.y += pi * vv.y; }
            const float rden = 1.0f / den;
            os[2 * lane] = acc.x * rden; os[2 * lane + 1] = acc.y * rden;
            if (lane == 0) misc[0] = mx + __logf(den);
        }
        __syncthreads();
        if (wave < 2) {
            const int P = 2 * pp + wave, b = P >> 4, h = P & 15;
            LAS float* s0 = (LAS float*)(lds + (3 * wave + 0) * TSK), *s1 = (LAS float*)(lds + (3 * wave + 1) * TSK), *s2 = (LAS float*)(lds + (3 * wave + 2) * TSK);
            const float l0 = s0[640], l1 = s1[640], l2 = s2[640]; const float mx = fmaxf(l0, fmaxf(l1, l2));
            const float w0 = __expf(l0 - mx), w1 = __expf(l1 - mx), w2 = __expf(l2 - mx); const float rs = 1.0f / (w0 + w1 + w2);
            const float* zs = (const float*)(ws + WS_ZS) + (size_t)b * N_CIN + 9 * EW + h * 128;
            const float oa = (w0 * s0[512 + 2 * lane] + w1 * s1[512 + 2 * lane] + w2 * s2[512 + 2 * lane]) * rs;
            const float ob = (w0 * s0[512 + 2 * lane + 1] + w1 * s1[512 + 2 * lane + 1] + w2 * s2[512 + 2 * lane + 1]) * rs;
            ((unsigned*)(ws + WS_TS))[((size_t)b * EW + h * 128) / 2 + lane] = cvt_pk_bf16(oa * silu_f(zs[2 * lane]), ob * silu_f(zs[2 * lane + 1]));
        }
    }
    __syncthreads();
}

__device__ __forceinline__ void combine_c_phase(const Args& a, int G) {
    unsigned char* ws = a.ws;
    const unsigned char* OG8 = ws + WS_OG; const float* LSE = (const float*)(ws + WS_LSE); const unsigned char* GATE8 = ws + WS_GATE; bf16* T = (bf16*)(ws + WS_T);
    const int NIT = M_ * 128;
    const int ctid = opaque_tid();
    for (int item = blockIdx.x * 512 + ctid; item < NIT; item += G * 512) {
        const int row = item >> 7, ch = item & 127, h = ch >> 3;
        const float l0 = LSE[((size_t)0 * M_ + row) * 16 + h], l1 = LSE[((size_t)1 * M_ + row) * 16 + h], l2 = LSE[((size_t)2 * M_ + row) * 16 + h];
        const size_t off = (size_t)row * EW + ch * 16;
        const u32x4 a0 = *(const u32x4*)(OG8 + off), a1 = *(const u32x4*)(OG8 + (size_t)M_ * EW + off), a2 = *(const u32x4*)(OG8 + (size_t)2 * M_ * EW + off), gg = *(const u32x4*)(GATE8 + off);
        const float mx = fmaxf(l0, fmaxf(l1, l2)); float w0 = __expf(l0 - mx), w1 = __expf(l1 - mx), w2 = __expf(l2 - mx); const float rs = (1.0f / OG_SCALE) / (w0 + w1 + w2); w0 *= rs; w1 *= rs; w2 *= rs;
        u32x4 wo[2];
#pragma unroll
        for (int q = 0; q < 4; ++q) {
            float x0[4], x1[4], x2[4], sg[4];
            unpk4_fp8(a0[q], x0[0], x0[1], x0[2], x0[3]); unpk4_fp8(a1[q], x1[0], x1[1], x1[2], x1[3]); unpk4_fp8(a2[q], x2[0], x2[1], x2[2], x2[3]); unpk4_fp8(gg[q], sg[0], sg[1], sg[2], sg[3]);
            wo[q >> 1][2 * (q & 1)] = cvt_pk_bf16((w0 * x0[0] + w1 * x1[0] + w2 * x2[0]) * sg[0], (w0 * x0[1] + w1 * x1[1] + w2 * x2[1]) * sg[1]);
            wo[q >> 1][2 * (q & 1) + 1] = cvt_pk_bf16((w0 * x0[2] + w1 * x1[2] + w2 * x2[2]) * sg[2], (w0 * x0[3] + w1 * x1[3] + w2 * x2[3]) * sg[3]);
        }
        *(u32x4*)(T + off) = wo[0]; *(u32x4*)(T + off + 8) = wo[1];
    }
    const bf16* QKV = (const bf16*)(ws + WS_Z);
    constexpr int NKV0 = 2 * 128 * 512, NKV1 = 2 * 512 * 512, NKV2 = 2 * 2048 * 512;
    for (int item = blockIdx.x * 512 + ctid; item < NKV0 + NKV1 + NKV2; item += G * 512) {
        int idx = item, g = 0; if (idx >= NKV0) { idx -= NKV0; g = 1; if (idx >= NKV1) { idx -= NKV1; g = 2; } }
        const int dsh = 2 * g, lsh = 13 - dsh, wsh = 7 + dsh, win = 1 << wsh;
        const int d8 = idx & 15, h = (idx >> 4) & 15, kv = (idx >> 8) & 1, pp = (idx >> 9) & (win - 1), b = idx >> (9 + wsh);
        const int t = SEQ_ - win + pp, sp = ((t & ((1 << dsh) - 1)) << lsh) | (t >> dsh);
        const bf16* src = QKV + ((((size_t)((1 + kv) * 3 + g) * 2 + b) * 16 + h) * SEQ_ + sp) * 128;
        float* dst = a.out + (g == 0 ? OFF_KV128P : (g == 1 ? OFF_KV512P : OFF_KV2048P)) + (size_t)idx * 8;
        f32x4 o0, o1;
        if (kv == 0 && d8 < 4) {
            const u32x4 w0 = *(const u32x4*)(src + 16 * (d8 & 1)), w1 = *(const u32x4*)(src + 16 * (d8 & 1) + 8);
            if (d8 < 2) { o0 = (f32x4){bflo(w0.x), bflo(w0.y), bflo(w0.z), bflo(w0.w)}; o1 = (f32x4){bflo(w1.x), bflo(w1.y), bflo(w1.z), bflo(w1.w)}; }
            else        { o0 = (f32x4){bfhi(w0.x), bfhi(w0.y), bfhi(w0.z), bfhi(w0.w)}; o1 = (f32x4){bfhi(w1.x), bfhi(w1.y), bfhi(w1.z), bfhi(w1.w)}; }
        } else {
            const u32x4 w0 = *(const u32x4*)(src + 8 * d8);
            o0 = (f32x4){bflo(w0.x), bfhi(w0.x), bflo(w0.y), bfhi(w0.y)}; o1 = (f32x4){bflo(w0.z), bfhi(w0.z), bflo(w0.w), bfhi(w0.w)};
        }
        *(f32x4*)dst = o0; *(f32x4*)(dst + 4) = o1;
    }
}

__device__ __forceinline__ void final_phase(const Args& a, int G) {
    const int tid = opaque_tid(), lane = tid & 63, wave = tid >> 6;
    unsigned char* ws = a.ws;
    const bf16* hbf = (const bf16*)(ws + WS_HB); const float* ssq = (const float*)(ws + WS_SSQP) + (size_t)4 * M_ * 16; const float* fw = a.in[7];
    const int gw = blockIdx.x * NWAVES + wave, NGW = G * NWAVES;
    f32x4 wv[4];
#pragma unroll
    for (int j = 0; j < 4; ++j) wv[j] = *((const f32x4*)fw + lane + 64 * j);
    for (int m = gw; m < M_ + MS_; m += NGW) {
        const bool smp = m >= M_;
        f32x4 v[4]; float s = 0.f;
        if (smp) { const f32x4* xr = (const f32x4*)((const float*)(ws + WS_HS) + (size_t)(m - M_) * DM) + lane;
#pragma unroll
            for (int j = 0; j < 4; ++j) { v[j] = xr[64 * j]; s += (v[j][0] * v[j][0] + v[j][1] * v[j][1]) + (v[j][2] * v[j][2] + v[j][3] * v[j][3]); } }
        else { const u32x2* xr = (const u32x2*)(hbf + (size_t)m * DM) + lane;
#pragma unroll
            for (int j = 0; j < 4; ++j) { const u32x2 r = xr[64 * j]; v[j] = (f32x4){bflo(r.x), bfhi(r.x), bflo(r.y), bfhi(r.y)}; } }
        if (smp) s = wave_sum(s);
        else { float p = (lane < 16) ? ssq[(size_t)m * 16 + lane] : 0.f; s = wave_sum(p); }
        const float rstd = __builtin_amdgcn_rsqf(s * (1.0f / DM) + EPS_);
        f32x4* o = (f32x4*)(a.out + (smp ? OFF_YS + (size_t)(m - M_) * DM : OFF_Y + (size_t)m * DM)) + lane;
#pragma unroll
        for (int j = 0; j < 4; ++j) o[64 * j] = v[j] * rstd * wv[j];
    }
}

__global__ void __launch_bounds__(NWAVES * 64, 2) hybrid_fwd(Args args) {
    extern __shared__ __attribute__((aligned(16))) unsigned char lds_raw[];
    LAS unsigned char* lds = (LAS unsigned char*)lds_raw;
    volatile LAS unsigned* MISC = (volatile LAS unsigned*)(lds + MISC_OFF);
    const int tid = opaque_tid();
    const int G = gridDim.x;
    unsigned char* ws = args.ws;
    unsigned* ctl = (unsigned*)(ws + WS_CTL);
    if (tid < 32) MISC[tid] = 0u;
    __syncthreads();
    XcdBarrier bar; bar.bar = ctl + CW_BAR; bar.x = 0; bar.st = nullptr;
    if (!MK_SPLIT) bar = xcd_barrier_post(ctl + CW_BAR, MISC + 8);
    const int lo = args.ph_lo, hi = args.ph_hi;
#ifndef PHASE_MASK
#define PHASE_MASK 0x7fff
#endif
#define IN(k) (lo <= (k) && (k) < hi && ((PHASE_MASK >> (k)) & 1))
#define SEAM(k) do { if (IN(k) && IN((k) + 1)) xcd_barrier(bar); } while (0)
    float* ssqp = (float*)(ws + WS_SSQP);
    bf16* HB = (bf16*)(ws + WS_HB); float* HP = (float*)(ws + WS_HP); bf16* T = (bf16*)(ws + WS_T); bf16* Z = (bf16*)(ws + WS_Z);
    float* HS = (float*)(ws + WS_HS); float* ZS = (float*)(ws + WS_ZS); bf16* TS = (bf16*)(ws + WS_TS);

#ifndef STAGGER_TICKS
#define STAGGER_TICKS 0
#endif
#define STAGGER() do { if (STAGGER_TICKS) { const unsigned long long t0_ = __builtin_amdgcn_s_memrealtime(); const unsigned long long d_ = (unsigned long long)(((unsigned)blockIdx.x >> 3) & 3u) * STAGGER_TICKS; \
        while (__builtin_amdgcn_s_memrealtime() - t0_ < d_) __builtin_amdgcn_s_sleep(8); } } while (0)
#define GEMM_IN(WOFF, NN, SSQL, LNP, SLO, SHI) do { \
        pg8::Gemm g{HB, (const bf16*)(ws + (WOFF)), M_, (NN), DM}; pg8::StaticOrder S; S.init(M_, (NN), G, (int)blockIdx.x); \
        pg8::Unit u0_; u0_.pm = -1; if (S.next(0, u0_)) pg8::stage_rstd(lds, ssqp + (size_t)(SSQL) * M_ * 16, u0_.pm); \
        pg8::EpiIn E{Z, Z + (size_t)M_ * EW, ssqp + (size_t)(SSQL) * M_ * 16, (LNP), (SLO), (SHI), lds + pg8::RS_OFF, u0_.pm}; \
        pg8::gemm_phase<pg8::EpiIn, pg8::StaticOrder, true, true>(lds, g, S, E); \
        sample_in_gemm(lds, HS, (const bf16*)(ws + (WOFF)), (NN), ZS, G); } while (0)
#define GEMM_OUT(WOFF, RES, SSQL) do { \
        pg8::Gemm g{T, (const bf16*)(ws + (WOFF)), M_, DM, EW}; pg8::StaticOrder S; S.init(M_, DM, G, (int)blockIdx.x); \
        pg8::EpiOut E{HB, ssqp + (size_t)(SSQL) * M_ * 16}; \
        pg8::gemm_phase<pg8::EpiOut, pg8::StaticOrder, true, true>(lds, g, S, E); \
        sample_out_gemm(lds, TS, (const bf16*)(ws + (WOFF)), HS, G); } while (0)
#define GEMM_CIN() do { STAGGER(); \
        pg8::Gemm g{HB, (const bf16*)(ws + WS_WC_IN), M_, N_CIN, DM}; pg8::StaticOrder S; S.init(M_, N_CIN, G, (int)blockIdx.x); \
        pg8::Unit u0_; u0_.pm = -1; if (S.next(0, u0_)) pg8::stage_rstd(lds, ssqp + (size_t)2 * M_ * 16, u0_.pm); \
        pg8::EpiCin E{Z, (bf16*)(ws + WS_GATE), ssqp + (size_t)2 * M_ * 16, (const float*)(ws + WS_ROPE), args.out, lds + pg8::RS_OFF, u0_.pm}; \
        pg8::gemm_phase<pg8::EpiCin, pg8::StaticOrder, true, true>(lds, g, S, E); \
        sample_in_gemm(lds, HS, (const bf16*)(ws + WS_WC_IN), N_CIN, ZS, G); } while (0)
#define PH0 p0_prologue(args, lds, G)
#define PH1 GEMM_IN(WS_WA_IN0, N_AIN, 0, (float*)(ws + WS_LNP), 16, 16)
#define PH2 mix_a_phase(lds, args, 0, G)
#define PH3 GEMM_OUT(WS_WA_OUT0, args.in[0], 1)
#define PH4 GEMM_IN(WS_WB_IN, N_BIN, 1, (float*)nullptr, 16, 32)
#define PH5 conv_b_phase(args, G)
#define PH6 GEMM_OUT(WS_WB_OUT, HP, 2)
#define PH7 GEMM_CIN()
#define PH8 do { attn_c_phase(lds, args, G); if ((DUPMASK >> 16) & 1) attn_c_phase(lds, args, G); attn_c_sample(lds, args, G); if ((DUPMASK >> 15) & 1) attn_c_sample(lds, args, G); } while (0)
#define PH9 combine_c_phase(args, G)
#define PH10 GEMM_OUT(WS_WC_OUT, HP, 3)
#define PH11 GEMM_IN(WS_WA_IN1, N_AIN, 3, (float*)(ws + WS_LNP), 16, 16)
#define PH12 mix_a_phase(lds, args, 1, G)
#define PH13 GEMM_OUT(WS_WA_OUT1, HP, 4)
#define PH14 final_phase(args, G)
#define RUN(k) do { if (IN(k)) { PH##k; if ((DUPMASK >> (k)) & 1) { PH##k; } } SEAM(k); } while (0)
    RUN(0);
    RUN(1); RUN(2); RUN(3);
    RUN(4); RUN(5); RUN(6);
    RUN(7); RUN(8); RUN(9); RUN(10);
    RUN(11); RUN(12); RUN(13);
    RUN(14);
#undef IN
#undef SEAM
}

extern "C" void kernel_launch(void* const* d_in, const int* in_sizes, int n_in, void* d_out, int out_size, void* d_ws, size_t ws_size, hipStream_t stream) {
    static int grid = 0;
    if (grid == 0) {
        if (n_in != 19 || (size_t)out_size != OUT_TOTAL || ws_size < WS_END) { fprintf(stderr, "kernel_launch: unexpected shapes: n_in %d out %d ws %zu\n", n_in, out_size, ws_size); grid = -1; return; }
        int dev = 0, cus = 0, per_cu = 0;
        if (hipGetDevice(&dev) != hipSuccess || hipDeviceGetAttribute(&cus, hipDeviceAttributeMultiprocessorCount, dev) != hipSuccess) { grid = -1; return; }
        if (hipFuncSetAttribute((const void*)hybrid_fwd, hipFuncAttributeMaxDynamicSharedMemorySize, LDS_BYTES) != hipSuccess) { fprintf(stderr, "kernel_launch: hipFuncSetAttribute failed\n"); grid = -1; return; }
        if (hipOccupancyMaxActiveBlocksPerMultiprocessor(&per_cu, (const void*)hybrid_fwd, NWAVES * 64, LDS_BYTES) != hipSuccess || per_cu < 1) { fprintf(stderr, "kernel_launch: occupancy query says %d\n", per_cu); }
        (void)hipGetLastError();
        grid = cus;
    }
    if (grid < 0) return;
    (void)hipMemsetAsync((char*)d_ws + WS_CTL, 0, CTL_ZERO_BYTES, stream);
    Args a{};
    for (int i = 0; i < 19; ++i) a.in[i] = (const float*)d_in[i];
    a.out = (float*)d_out; a.ws = (unsigned char*)d_ws;
#if MK_SPLIT
    for (int k = 0; k < NPH; ++k) { a.ph_lo = k; a.ph_hi = k + 1; hipLaunchKernelGGL(hybrid_fwd, dim3(grid), dim3(NWAVES * 64), LDS_BYTES, stream, a); }
#else
    a.ph_lo = 0; a.ph_hi = NPH;
    hipLaunchKernelGGL(hybrid_fwd, dim3(grid), dim3(NWAVES * 64), LDS_BYTES, stream, a);
#endif
    const hipError_t le = hipPeekAtLastError();
    if (le != hipSuccess) fprintf(stderr, "kernel_launch: launch failed: %s\n", hipGetErrorName(le));
}
```
